# Optimizing an MI355X kernel written in HIP

```python
import math
import jax, jax.numpy as jnp
from jax import lax
import numpy as np

D_MODEL = 2048
BATCH = 2
SEQ = 16384
DEPTH = 2

BRANCH_WIDTH = 1024
N_BRANCHES = 3
BLOCK_Q = 128
NORM_EPS = 1e-6
DA_HEADS = 8
DA_HEAD_DIM = 64
DA_V_DIM = 2 * DA_HEAD_DIM
ML_HEADS = 4
ML_QK_DIM = 128
ML_V_DIM = 256
ML_CONV = 4
ML_CHUNK = 64
ML_QK_WIDTH = 2 * ML_HEADS * ML_QK_DIM
DSA_HEADS = 8
DSA_LATENT = 256
DSA_V_DIM = 128
IDX_HEADS = 16
IDX_DIM = 64
IDX_TOPK_MAX = 256

IN_SPLITS = (
    DA_HEADS * 2 * DA_HEAD_DIM,
    DA_HEADS * 2 * DA_HEAD_DIM,
    DA_HEADS * DA_V_DIM,
    BRANCH_WIDTH,
    ML_QK_WIDTH,
    ML_HEADS * ML_V_DIM,
    2 * ML_HEADS,
    BRANCH_WIDTH,
    BRANCH_WIDTH,
    DSA_HEADS * DSA_LATENT,
    DSA_LATENT,
    IDX_HEADS * IDX_DIM,
    IDX_DIM,
    IDX_HEADS,
    BRANCH_WIDTH,
    N_BRANCHES * D_MODEL,
)
N_IN = sum(IN_SPLITS)

kernel_name = "hybrid_diffattn_mlstm_dsa_gated"


def rmsnorm(x, g):
    x32 = x.astype(jnp.float32)
    y = x32 * lax.rsqrt(jnp.mean(x32 * x32, axis=-1, keepdims=True) + NORM_EPS)
    return (y * g.astype(jnp.float32)).astype(x.dtype)


def to_blocks(a, n):
    b, s = a.shape[:2]
    a = a.reshape((b, s // n, n) + a.shape[2:])
    return jnp.moveaxis(a, 1, 0)


def from_blocks(a):
    a = jnp.moveaxis(a, 0, 1)
    return a.reshape((a.shape[0], a.shape[1] * a.shape[2]) + a.shape[3:])


def diff_attention(q, k, v, lam_params, norm_g, lam_init):
    b, s, _ = q.shape
    q = q.reshape(b, s, DA_HEADS, 2, DA_HEAD_DIM)
    k = k.reshape(b, s, DA_HEADS, 2, DA_HEAD_DIM)
    v = v.reshape(b, s, DA_HEADS, DA_V_DIM)
    k1, k2 = k[:, :, :, 0], k[:, :, :, 1]
    lp = lam_params.astype(jnp.float32)
    lam = jnp.exp(jnp.sum(lp[0] * lp[1])) - jnp.exp(jnp.sum(lp[2] * lp[3])) + lam_init
    scale = DA_HEAD_DIM ** -0.5
    kpos = jnp.arange(s)

    def block(args):
        i, qb = args
        qpos = i * BLOCK_Q + jnp.arange(BLOCK_Q)
        mask = kpos[None, :] <= qpos[:, None]
        s1 = jnp.einsum('bqhd,bkhd->bhqk', qb[:, :, :, 0], k1).astype(jnp.float32) * scale
        s2 = jnp.einsum('bqhd,bkhd->bhqk', qb[:, :, :, 1], k2).astype(jnp.float32) * scale
        a = (jax.nn.softmax(jnp.where(mask, s1, -jnp.inf), axis=-1)
             - lam * jax.nn.softmax(jnp.where(mask, s2, -jnp.inf), axis=-1))
        return jnp.einsum('bhqk,bkhv->bqhv', a.astype(v.dtype), v)

    nb = s // BLOCK_Q
    o = from_blocks(lax.map(block, (jnp.arange(nb), to_blocks(q, BLOCK_Q))))
    o = rmsnorm(o, norm_g) * (1.0 - lam_init)
    return o.reshape(b, s, DA_HEADS * DA_V_DIM)


def causal_conv(x, w, bias):
    kw, s = w.shape[0], x.shape[1]
    xp = jnp.pad(x, ((0, 0), (kw - 1, 0), (0, 0)))
    y = xp[:, 0:s] * w[0]
    for j in range(1, kw):
        y = y + xp[:, j:j + s] * w[j]
    return y + bias


def mlstm_chunk(carry, xs):
    C, n, m = carry
    q, k, v, logf, ig = xs
    L = q.shape[2]
    bcum = jnp.cumsum(logf, axis=-1)
    causal = jnp.tril(jnp.ones((L, L), dtype=bool))
    dmat = jnp.where(causal, bcum[..., :, None] - bcum[..., None, :] + ig[..., None, :], -jnp.inf)
    inter = bcum + m[..., None]
    m_t = jnp.maximum(jnp.max(dmat, axis=-1), inter)
    w = jnp.exp(dmat - m_t[..., None]) * jnp.einsum('bhtd,bhsd->bhts', q, k)
    decay = jnp.exp(inter - m_t)
    num = jnp.einsum('bhts,bhsv->bhtv', w, v) + decay[..., None] * jnp.einsum('bhtd,bhdv->bhtv', q, C)
    den = jnp.sum(w, axis=-1) + decay * jnp.einsum('bhtd,bhd->bht', q, n)
    h = num / jnp.maximum(jnp.abs(den), jnp.exp(-m_t))[..., None]
    b_last = bcum[..., -1]
    g = b_last[..., None] - bcum + ig
    m_new = jnp.maximum(b_last + m, jnp.max(g, axis=-1))
    wk = jnp.exp(g - m_new[..., None])
    cd = jnp.exp(b_last + m - m_new)
    C_new = cd[..., None, None] * C + jnp.einsum('bhs,bhsd,bhsv->bhdv', wk, k, v)
    n_new = cd[..., None] * n + jnp.einsum('bhs,bhsd->bhd', wk, k)
    return (C_new, n_new, m_new), h


def mlstm(qk, v, gif, o, conv_w, conv_b, gate_b, norm_g):
    b, s, _ = v.shape
    out_dtype = v.dtype
    nc = s // ML_CHUNK
    qk = jax.nn.silu(causal_conv(qk, conv_w, conv_b))
    q, k = jnp.split(qk, 2, axis=-1)

    def heads(a, d):
        a = a.reshape(b, nc, ML_CHUNK, ML_HEADS, d)
        return jnp.transpose(a, (1, 0, 3, 2, 4)).astype(jnp.float32)

    qh = heads(q, ML_QK_DIM)
    kh = heads(k, ML_QK_DIM) * (ML_QK_DIM ** -0.5)
    vh = heads(v, ML_V_DIM)
    gates = gif.reshape(b, s, 2, ML_HEADS).astype(jnp.float32) + gate_b.astype(jnp.float32)
    ig = gates[:, :, 0]
    logf = jax.nn.log_sigmoid(gates[:, :, 1])

    def gheads(a):
        return jnp.transpose(a.reshape(b, nc, ML_CHUNK, ML_HEADS), (1, 0, 3, 2))

    init = (jnp.zeros((b, ML_HEADS, ML_QK_DIM, ML_V_DIM), jnp.float32),
            jnp.zeros((b, ML_HEADS, ML_QK_DIM), jnp.float32),
            jnp.zeros((b, ML_HEADS), jnp.float32))
    _, h = lax.scan(mlstm_chunk, init, (qh, kh, vh, gheads(logf), gheads(ig)))
    h = jnp.transpose(h, (1, 0, 3, 2, 4)).reshape(b, s, ML_HEADS, ML_V_DIM)
    h = rmsnorm(h, norm_g).reshape(b, s, ML_HEADS * ML_V_DIM)
    return (h * jax.nn.sigmoid(o.astype(jnp.float32))).astype(out_dtype)


def dsa_attention(q, ckv, iq, ik, iw, kv_norm_g, ik_norm_g, w_uv):
    b, s, _ = q.shape
    topk = min(IDX_TOPK_MAX, s // 4)
    q = q.reshape(b, s, DSA_HEADS, DSA_LATENT)
    c = rmsnorm(ckv, kv_norm_g)
    iq = iq.reshape(b, s, IDX_HEADS, IDX_DIM)
    ik = rmsnorm(ik, ik_norm_g)
    iw = iw.astype(jnp.float32) * (IDX_HEADS ** -0.5)
    kpos = jnp.arange(s)

    def block(args):
        i, qb, iqb, iwb = args
        qpos = i * BLOCK_Q + jnp.arange(BLOCK_Q)
        mask = kpos[None, :] <= qpos[:, None]
        isc = jnp.einsum('bqhd,bsd->bqhs', iqb, ik).astype(jnp.float32) * (IDX_DIM ** -0.5)
        isc = jnp.einsum('bqhs,bqh->bqs', jax.nn.relu(isc), iwb)
        isc = jnp.where(mask[None], isc, -jnp.inf)
        vals, idx = lax.top_k(isc, topk)
        valid = jnp.isfinite(vals)
        c_sel = jax.vmap(lambda cb, ib: cb[ib])(c, idx)
        logits = jnp.einsum('bqhc,bqkc->bqhk', qb, c_sel).astype(jnp.float32) * (DSA_LATENT ** -0.5)
        p = jax.nn.softmax(jnp.where(valid[:, :, None, :], logits, -jnp.inf), axis=-1)
        ob = jnp.einsum('bqhk,bqkc->bqhc', p.astype(c.dtype), c_sel)
        return jnp.einsum('bqhc,hcv->bqhv', ob, w_uv)

    nb = s // BLOCK_Q
    o = lax.map(block, (jnp.arange(nb), to_blocks(q, BLOCK_Q), to_blocks(iq, BLOCK_Q), to_blocks(iw, BLOCK_Q)))
    return from_blocks(o).reshape(b, s, DSA_HEADS * DSA_V_DIM)


def setup_inputs(seed: int = 0) -> dict:
    key = jax.random.key(seed)
    ks = jax.random.split(key, 16)
    nrm = jax.random.normal
    f32 = jnp.float32
    x = nrm(ks[0], (BATCH, SEQ, D_MODEL), f32)
    pre_norm_g = 1.0 + 0.02 * nrm(ks[1], (DEPTH, D_MODEL), f32)
    w_in = nrm(ks[2], (DEPTH, D_MODEL, N_IN), f32) * (D_MODEL ** -0.5)
    da_lambda = 0.1 * nrm(ks[3], (DEPTH, 4, DA_HEAD_DIM), f32)
    da_norm_g = 1.0 + 0.02 * nrm(ks[4], (DEPTH, DA_V_DIM), f32)
    ml_conv_w = nrm(ks[5], (DEPTH, ML_CONV, ML_QK_WIDTH), f32) * (ML_CONV ** -0.5)
    ml_conv_b = 0.02 * nrm(ks[6], (DEPTH, ML_QK_WIDTH), f32)
    base = jnp.stack([jnp.zeros((ML_HEADS,), f32), jnp.linspace(3.0, 6.0, ML_HEADS, dtype=f32)])
    ml_gate_b = base[None] + 0.1 * nrm(ks[7], (DEPTH, 2, ML_HEADS), f32)
    ml_norm_g = 1.0 + 0.02 * nrm(ks[8], (DEPTH, ML_V_DIM), f32)
    dsa_kv_norm_g = 1.0 + 0.02 * nrm(ks[9], (DEPTH, DSA_LATENT), f32)
    dsa_ik_norm_g = 1.0 + 0.02 * nrm(ks[10], (DEPTH, IDX_DIM), f32)
    dsa_w_uv = nrm(ks[11], (DEPTH, DSA_HEADS, DSA_LATENT, DSA_V_DIM), f32) * (DSA_LATENT ** -0.5)
    w_branch = nrm(ks[12], (DEPTH, N_BRANCHES, BRANCH_WIDTH, D_MODEL), f32) * (BRANCH_WIDTH ** -0.5)
    w_out = nrm(ks[13], (DEPTH, D_MODEL, D_MODEL), f32) * (D_MODEL ** -0.5)
    post_norm_g = 1.0 + 0.02 * nrm(ks[14], (DEPTH, D_MODEL), f32)
    return {"x": x, "pre_norm_g": pre_norm_g, "w_in": w_in, "da_lambda": da_lambda,
            "da_norm_g": da_norm_g, "ml_conv_w": ml_conv_w, "ml_conv_b": ml_conv_b,
            "ml_gate_b": ml_gate_b, "ml_norm_g": ml_norm_g, "dsa_kv_norm_g": dsa_kv_norm_g,
            "dsa_ik_norm_g": dsa_ik_norm_g, "dsa_w_uv": dsa_w_uv, "w_branch": w_branch,
            "w_out": w_out, "post_norm_g": post_norm_g}


def reference(x, pre_norm_g, w_in, da_lambda, da_norm_g, ml_conv_w, ml_conv_b, ml_gate_b,
              ml_norm_g, dsa_kv_norm_g, dsa_ik_norm_g, dsa_w_uv, w_branch, w_out, post_norm_g):
    b, s, _ = x.shape
    split_points = [int(p) for p in np.cumsum(IN_SPLITS)[:-1]]
    for l in range(DEPTH):
        h = rmsnorm(x, pre_norm_g[l])
        proj = jnp.einsum('bsd,dn->bsn', h, w_in[l])
        (da_q, da_k, da_v, da_z, ml_qk, ml_v, ml_if, ml_o, ml_z,
         dsa_q, dsa_kv, idx_q, idx_k, idx_w, dsa_z, gates) = jnp.split(proj, split_points, axis=-1)
        lam_init = 0.8 - 0.6 * math.exp(-0.3 * l)
        y_a = diff_attention(da_q, da_k, da_v, da_lambda[l], da_norm_g[l], lam_init) * jax.nn.silu(da_z)
        y_b = mlstm(ml_qk, ml_v, ml_if, ml_o, ml_conv_w[l], ml_conv_b[l], ml_gate_b[l], ml_norm_g[l]) * jax.nn.silu(ml_z)
        y_c = dsa_attention(dsa_q, dsa_kv, idx_q, idx_k, idx_w, dsa_kv_norm_g[l], dsa_ik_norm_g[l], dsa_w_uv[l]) * jax.nn.silu(dsa_z)
        g = jax.nn.sigmoid(gates.reshape(b, s, N_BRANCHES, D_MODEL))
        mixed = (g[:, :, 0] * jnp.einsum('bsw,wd->bsd', y_a, w_branch[l, 0])
                 + g[:, :, 1] * jnp.einsum('bsw,wd->bsd', y_b, w_branch[l, 1])
                 + g[:, :, 2] * jnp.einsum('bsw,wd->bsd', y_c, w_branch[l, 2]))
        out = jnp.einsum('bsd,de->bse', mixed, w_out[l])
        x = x + rmsnorm(out, post_norm_g[l])
    return x
```

```cpp
#include <hip/hip_runtime.h>
#include <stdint.h>
#include <stdio.h>

typedef _Float16 half_t;
typedef _Float16 h8 __attribute__((ext_vector_type(8)));
typedef _Float16 h4 __attribute__((ext_vector_type(4)));
typedef float f4 __attribute__((ext_vector_type(4)));
typedef float f16v __attribute__((ext_vector_type(16)));
typedef unsigned short u16;
#define LAS __attribute__((address_space(3)))
#define DEV __device__ __forceinline__

constexpr int D_MODEL = 2048, NB = 2, SEQ = 16384, DEPTH = 2, TB = SEQ;
constexpr int N_IN_SRC = 18776, N_IN = 18944;
constexpr float NORM_EPS = 1e-6f;
constexpr float LOG2E = 1.4426950408889634f;
constexpr int NTHREADS = 512, NWAVE = 8;
constexpr int TOPK = 256;

constexpr size_t U1 = (size_t)TB * 1024 * 2;
constexpr size_t OFF_CTRL = 0;
constexpr size_t OFF_WT   = 1 << 20;
constexpr size_t OFF_WBT  = OFF_WT + (size_t)N_IN * 2048 * 2;
constexpr size_t OFF_WOT  = OFF_WBT + (size_t)3 * 2048 * 1024 * 2;
constexpr size_t OFF_WUVT = OFF_WOT + (size_t)2048 * 2048 * 2;
constexpr size_t OFF_H    = OFF_WUVT + (size_t)1024 * 512 * 2;
constexpr size_t OFF_MQKC = OFF_H;
constexpr size_t OFF_YB   = OFF_H + U1;
constexpr size_t OFF_QA   = OFF_H + 2 * U1;
constexpr size_t OFF_KA   = OFF_QA + U1;
constexpr size_t OFF_VAT  = OFF_KA + U1;
constexpr size_t OFF_MIX  = OFF_KA;
constexpr size_t OFF_ZA   = OFF_VAT + U1;
constexpr size_t OFF_MQKR = OFF_ZA + U1;
constexpr size_t OFF_MVT  = OFF_MQKR + U1;
constexpr size_t OFF_MO   = OFF_MVT + U1;
constexpr size_t OFF_MZ   = OFF_MO + U1;
constexpr size_t OFF_DQ   = OFF_MZ + U1;
constexpr size_t OFF_IQ   = OFF_DQ + 2 * U1;
constexpr size_t OFF_DZ   = OFF_IQ + U1;
constexpr size_t OFF_G    = OFF_DZ + U1;
constexpr size_t OFF_MKT  = OFF_G + 6 * U1;
constexpr size_t OFF_ST   = OFF_MKT + U1 / 2;
constexpr size_t OFF_OUTP = OFF_ST;
constexpr size_t OFF_CKV  = OFF_ST + 4 * U1;
constexpr size_t OFF_SM   = OFF_CKV + (size_t)TB * 256 * 4;
constexpr size_t OFF_C    = OFF_SM + (size_t)TB * 96 * 4;
constexpr size_t OFF_IK   = OFF_C + (size_t)TB * 256 * 2;
constexpr size_t OFF_IW   = OFF_IK + (size_t)TB * 64 * 2;
constexpr size_t OFF_MG   = OFF_IW + (size_t)TB * 16 * 4;
constexpr size_t OFF_IDX  = OFF_MG + (size_t)TB * 8 * 4;
constexpr size_t OFF_CNT  = OFF_IDX + (size_t)TB * 256 * 2;
constexpr size_t OFF_NV   = OFF_CNT + (size_t)TB * 4;
constexpr size_t OFF_DEC  = OFF_NV + (size_t)4 * 256 * 128 * 4;
constexpr size_t OFF_SS   = OFF_DEC + 4096;
constexpr size_t WS_NEED  = OFF_SS + (size_t)TB * 4;

struct Params {
    const float *x, *pre_g, *w_in, *da_lambda, *da_norm_g, *ml_conv_w, *ml_conv_b, *ml_gate_b, *ml_norm_g, *kv_norm_g, *ik_norm_g, *w_uv, *w_branch, *w_out, *post_g;
    float* out;
    char* ws;
    int ph_lo, ph_hi;
};

DEV float silu_f(float v) { return v / (1.f + __expf(-v)); }
DEV float sigm_f(float v) { return 1.f / (1.f + __expf(-v)); }
DEV float wave_sum(float v) {
#pragma unroll
    for (int o = 32; o >= 1; o >>= 1) v += __shfl_xor(v, o);
    return v;
}
DEV float gsum(float v) { v += __shfl_xor(v, 16); v += __shfl_xor(v, 32); return v; }
DEV float gmax(float v) { v = fmaxf(v, __shfl_xor(v, 16)); v = fmaxf(v, __shfl_xor(v, 32)); return v; }
DEV h8 cat44(h4 a, h4 b) { return (h8){a[0], a[1], a[2], a[3], b[0], b[1], b[2], b[3]}; }
DEV h4 toh4(f4 v) { return (h4){(half_t)v[0], (half_t)v[1], (half_t)v[2], (half_t)v[3]}; }
DEV h8 zero8() { return (h8){0, 0, 0, 0, 0, 0, 0, 0}; }
#define MFMA16(a, b, c) __builtin_amdgcn_mfma_f32_16x16x32_f16((a), (b), (c), 0, 0, 0)
#define MFMA32(a, b, c) __builtin_amdgcn_mfma_f32_32x32x16_f16((a), (b), (c), 0, 0, 0)

DEV int in_src_col(int n) {
    if (n < 6144) return n;
    if (n < 8192) return n + 8;
    if (n < 10496) return n + 8;
    if (n < 11520) return n + 8;
    if (n < 11584) return n + 8;
    if (n < 11600) return n + 8;
    if (n < 11608) return n - 11600 + 6144;
    if (n < 11776) return -1;
    if (n < 12800) return n - 11776 + 11608;
    return n - 12800 + 12632;
}
template <class F> DEV void tr_tile(half_t* dst, int Kd, int n0, int k0, F src, float* tile  ) {
    const int tid = threadIdx.x;
    __syncthreads();
#pragma unroll
    for (int j = 0; j < 8; ++j) { const int kk = (tid >> 6) + 8 * j, nn = tid & 63; tile[kk * 65 + nn] = src(k0 + kk, n0 + nn); }
    __syncthreads();
#pragma unroll
    for (int j = 0; j < 8; ++j) { const int nn = (tid >> 6) + 8 * j, kk = tid & 63; dst[(size_t)(n0 + nn) * Kd + k0 + kk] = (half_t)tile[kk * 65 + nn]; }
}
DEV void ph_weights(const Params& p, int l, char* lds) {
    float* tile = (float*)lds;
    half_t* Wt = (half_t*)(p.ws + OFF_WT); half_t* Wbt = (half_t*)(p.ws + OFF_WBT); half_t* Wot = (half_t*)(p.ws + OFF_WOT); half_t* Wuvt = (half_t*)(p.ws + OFF_WUVT);
    const float* w_in = p.w_in + (size_t)l * 2048 * N_IN_SRC;
    const float* w_br = p.w_branch + (size_t)l * 3 * 1024 * 2048;
    const float* w_out = p.w_out + (size_t)l * 2048 * 2048;
    const float* w_uv = p.w_uv + (size_t)l * 8 * 256 * 128;
    constexpr int T_IN = (N_IN / 64) * 32, T_BR = 3 * 32 * 16, T_OUT = 32 * 32, T_UV = 16 * 8;
    for (int u = blockIdx.x; u < T_IN + T_BR + T_OUT + T_UV; u += gridDim.x) {
        if (u < T_IN) { const int nt = u / 32, kt = u % 32;
            tr_tile(Wt, 2048, nt * 64, kt * 64, [&](int k, int n) { const int s = in_src_col(n); return s < 0 ? 0.f : w_in[(size_t)k * N_IN_SRC + s]; }, tile);
        } else if (u < T_IN + T_BR) { const int v = u - T_IN, i = v / 512, r = v % 512, nt = r / 16, kt = r % 16;
            const float* src = w_br + (size_t)i * 1024 * 2048;
            tr_tile(Wbt + (size_t)i * 2048 * 1024, 1024, nt * 64, kt * 64, [&](int k, int n) { return src[(size_t)k * 2048 + n]; }, tile);
        } else if (u < T_IN + T_BR + T_OUT) { const int v = u - T_IN - T_BR, nt = v / 32, kt = v % 32;
            tr_tile(Wot, 2048, nt * 64, kt * 64, [&](int k, int n) { return w_out[(size_t)k * 2048 + n]; }, tile);
        } else { const int v = u - T_IN - T_BR - T_OUT, nt = v / 8, kt = v % 8;
            tr_tile(Wuvt, 512, nt * 64, kt * 64, [&](int k, int n) { const int hh = n >> 7, vv = n & 127; const int c = k - (hh & 1) * 256; return (c >= 0 && c < 256) ? w_uv[((size_t)hh * 256 + c) * 128 + vv] : 0.f; }, tile);
        }
    }
}

DEV void ph_h(const Params& p, int l, int b) {
    const float* X = (l == 0 ? p.x : p.out) + (size_t)b * TB * 2048;
    const float* g = p.pre_g + l * 2048;
    half_t* H = (half_t*)(p.ws + OFF_H);
    const int lane = threadIdx.x & 63, wid = threadIdx.x >> 6;
    for (int t = blockIdx.x * NWAVE + wid; t < TB; t += gridDim.x * NWAVE) {
        const float* xr = X + (size_t)t * 2048; f4 v[8]; float ss = 0.f;
#pragma unroll
        for (int i = 0; i < 8; ++i) { v[i] = *(const f4*)(xr + i * 256 + lane * 4); ss += v[i][0] * v[i][0] + v[i][1] * v[i][1] + v[i][2] * v[i][2] + v[i][3] * v[i][3]; }
        ss = wave_sum(ss); const float rs = rsqrtf(ss * (1.f / 2048.f) + NORM_EPS);
#pragma unroll
        for (int i = 0; i < 8; ++i) { const f4 gg = *(const f4*)(g + i * 256 + lane * 4); *(h4*)(H + (size_t)t * 2048 + i * 256 + lane * 4) = toh4(v[i] * rs * gg); }
    }
}

template <class Epi> DEV void gemm_simple(const half_t* A, int lda, const half_t* Bt, int ldb, int M, int N, int K, int a_koff, const Epi& E) {
    const int lane = threadIdx.x & 63, wid = threadIdx.x >> 6, r = lane & 15, g = lane >> 4, wm = wid & 1, wn = wid >> 1;
    const int nM = M / 128, nN = N / 256;
    for (int u = blockIdx.x; u < nM * nN; u += gridDim.x) {
        const int pn = u / nM, pm = u % nM; const int m0 = pm * 128 + wm * 64, n0 = pn * 256 + wn * 64;
        const half_t* Ab = A + (size_t)(m0 + r) * lda + (size_t)pn * a_koff + 8 * g;
        const half_t* Bb = Bt + (size_t)(n0 + r) * ldb + 8 * g;
        f4 acc[4][4];
#pragma unroll
        for (int i = 0; i < 4; ++i)
#pragma unroll
            for (int j = 0; j < 4; ++j) acc[i][j] = (f4){0.f, 0.f, 0.f, 0.f};
        for (int k0 = 0; k0 < K; k0 += 32) {
            h8 a[4], bb[4];
#pragma unroll
            for (int i = 0; i < 4; ++i) { a[i] = *(const h8*)(Ab + (size_t)i * 16 * lda + k0); bb[i] = *(const h8*)(Bb + (size_t)i * 16 * ldb + k0); }
#pragma unroll
            for (int i = 0; i < 4; ++i)
#pragma unroll
                for (int j = 0; j < 4; ++j) acc[i][j] = MFMA16(bb[j], a[i], acc[i][j]);
        }
#pragma unroll
        for (int i = 0; i < 4; ++i)
#pragma unroll
            for (int j = 0; j < 4; ++j) E.store4(m0 + 16 * i + r, n0 + 16 * j + 4 * g, acc[i][j]);
    }
}

struct EpiIn {
    char* ws;
    DEV void store4(int row, int col, f4 v) const {
        if (col < 1024) { *(h4*)((half_t*)(ws + OFF_QA) + (size_t)row * 1024 + col) = toh4(v * (0.125f * LOG2E)); }
        else if (col < 2048) { *(h4*)((half_t*)(ws + OFF_KA) + (size_t)row * 1024 + (col - 1024)) = toh4(v); }
        else if (col < 3072) { half_t* d = (half_t*)(ws + OFF_VAT) + (size_t)(col - 2048) * TB + row;
#pragma unroll
            for (int e = 0; e < 4; ++e) d[(size_t)e * TB] = (half_t)v[e]; }
        else if (col < 4096) { *(h4*)((half_t*)(ws + OFF_ZA) + (size_t)row * 1024 + (col - 3072)) = toh4((f4){silu_f(v[0]), silu_f(v[1]), silu_f(v[2]), silu_f(v[3])}); }
        else if (col < 5120) { *(h4*)((half_t*)(ws + OFF_MQKR) + (size_t)row * 1024 + (col - 4096)) = toh4(v); }
        else if (col < 6144) { half_t* d = (half_t*)(ws + OFF_MVT) + (size_t)(col - 5120) * TB + row;
#pragma unroll
            for (int e = 0; e < 4; ++e) d[(size_t)e * TB] = (half_t)v[e]; }
        else if (col < 7168) { *(h4*)((half_t*)(ws + OFF_MO) + (size_t)row * 1024 + (col - 6144)) = toh4((f4){sigm_f(v[0]), sigm_f(v[1]), sigm_f(v[2]), sigm_f(v[3])}); }
        else if (col < 8192) { *(h4*)((half_t*)(ws + OFF_MZ) + (size_t)row * 1024 + (col - 7168)) = toh4((f4){silu_f(v[0]), silu_f(v[1]), silu_f(v[2]), silu_f(v[3])}); }
        else if (col < 10240) { *(h4*)((half_t*)(ws + OFF_DQ) + (size_t)row * 2048 + (col - 8192)) = toh4(v * (0.0625f * LOG2E)); }
        else if (col < 10496) { *(f4*)((float*)(ws + OFF_CKV) + (size_t)row * 256 + (col - 10240)) = v; }
        else if (col < 11520) { *(h4*)((half_t*)(ws + OFF_IQ) + (size_t)row * 1024 + (col - 10496)) = toh4(v); }
        else if (col < 11776) { const int c = col - 11520; if (c < 96) *(f4*)((float*)(ws + OFF_SM) + (size_t)row * 96 + c) = v; }
        else if (col < 12800) { *(h4*)((half_t*)(ws + OFF_DZ) + (size_t)row * 1024 + (col - 11776)) = toh4((f4){silu_f(v[0]), silu_f(v[1]), silu_f(v[2]), silu_f(v[3])}); }
        else { *(h4*)((half_t*)(ws + OFF_G) + (size_t)row * 6144 + (col - 12800)) = toh4((f4){sigm_f(v[0]), sigm_f(v[1]), sigm_f(v[2]), sigm_f(v[3])}); }
    }
};
struct EpiMulH {
    half_t* O; const half_t* Z; int ld;
    DEV void store4(int row, int col, f4 v) const { const h4 z = *(const h4*)(Z + (size_t)row * ld + col);
        *(h4*)(O + (size_t)row * ld + col) = toh4((f4){v[0] * (float)z[0], v[1] * (float)z[1], v[2] * (float)z[2], v[3] * (float)z[3]}); }
};
struct EpiGate {
    half_t* MIXp; const half_t* G; int goff; bool first;
    DEV void store4(int row, int col, f4 v) const { const h4 gg = *(const h4*)(G + (size_t)row * 6144 + goff + col);
        f4 o = (f4){v[0] * (float)gg[0], v[1] * (float)gg[1], v[2] * (float)gg[2], v[3] * (float)gg[3]};
        half_t* d = MIXp + (size_t)row * 2048 + col;
        if (!first) { const h4 pz = *(const h4*)d; o += (f4){(float)pz[0], (float)pz[1], (float)pz[2], (float)pz[3]}; }
        *(h4*)d = toh4(o); }
};
struct EpiOut {
    float* O; float* SS;
    DEV void store4(int row, int col, f4 v) const { *(f4*)(O + (size_t)row * 2048 + col) = v;
        float s = v[0] * v[0] + v[1] * v[1] + v[2] * v[2] + v[3] * v[3]; s = gsum(s);
        if ((threadIdx.x & 63) < 16) atomicAdd(SS + row, s); }
};

DEV void ph_post(const Params& p, int l) {
    char* ws = p.ws; const int lane = threadIdx.x & 63, wid = threadIdx.x >> 6;
    const float* CKV = (const float*)(ws + OFF_CKV); const float* SM = (const float*)(ws + OFF_SM);
    half_t* C = (half_t*)(ws + OFF_C); half_t* IK = (half_t*)(ws + OFF_IK); float* IW = (float*)(ws + OFF_IW); float* MG = (float*)(ws + OFF_MG);
    const half_t* MQKR = (const half_t*)(ws + OFF_MQKR); half_t* MQKC = (half_t*)(ws + OFF_MQKC); half_t* MKT = (half_t*)(ws + OFF_MKT); float* SS = (float*)(ws + OFF_SS);
    const float* kvg = p.kv_norm_g + l * 256; const float* ikg = p.ik_norm_g + l * 64; const float* gb = p.ml_gate_b + l * 8;
    const float* cw = p.ml_conv_w + (size_t)l * 4 * 1024; const float* cb = p.ml_conv_b + l * 1024;
    for (int t = blockIdx.x * NWAVE + wid; t < TB; t += gridDim.x * NWAVE) {
        { const f4 v = *(const f4*)(CKV + (size_t)t * 256 + lane * 4); float ss = wave_sum(v[0] * v[0] + v[1] * v[1] + v[2] * v[2] + v[3] * v[3]);
          const float rs = rsqrtf(ss * (1.f / 256.f) + NORM_EPS); const f4 gg = *(const f4*)(kvg + lane * 4); *(h4*)(C + (size_t)t * 256 + lane * 4) = toh4(v * rs * gg); }
        { f4 v = (f4){0.f, 0.f, 0.f, 0.f}; if (lane < 24) v = *(const f4*)(SM + (size_t)t * 96 + lane * 4);
          float ss = (lane < 16) ? (v[0] * v[0] + v[1] * v[1] + v[2] * v[2] + v[3] * v[3]) : 0.f; ss = wave_sum(ss);
          const float rs = rsqrtf(ss * (1.f / 64.f) + NORM_EPS);
          if (lane < 16) { const f4 gg = *(const f4*)(ikg + lane * 4); *(h4*)(IK + (size_t)t * 64 + lane * 4) = toh4(v * rs * gg); }
          else if (lane < 20) { *(f4*)(IW + (size_t)t * 16 + (lane - 16) * 4) = v * (1.f / 32.f); }
          else if (lane == 20) { const f4 bb = *(const f4*)(gb); *(f4*)(MG + (size_t)t * 8) = v + bb; }
          else if (lane == 21) { const f4 bb = *(const f4*)(gb + 4); f4 o;
#pragma unroll
              for (int e = 0; e < 4; ++e) { const float xg = v[e] + bb[e]; o[e] = fminf(xg, 0.f) - log1pf(__expf(-fabsf(xg))); }
              *(f4*)(MG + (size_t)t * 8 + 4) = o; }
          if (lane == 22) SS[t] = 0.f; }
        { const int c0 = lane * 16; float acc[16];
#pragma unroll
          for (int e = 0; e < 16; ++e) acc[e] = cb[c0 + e];
#pragma unroll
          for (int j = 0; j < 4; ++j) { const int tt = t - 3 + j; if (tt >= 0) {
              const h8 x0 = *(const h8*)(MQKR + (size_t)tt * 1024 + c0), x1 = *(const h8*)(MQKR + (size_t)tt * 1024 + c0 + 8);
#pragma unroll
              for (int e = 0; e < 8; ++e) { acc[e] += cw[j * 1024 + c0 + e] * (float)x0[e]; acc[8 + e] += cw[j * 1024 + c0 + 8 + e] * (float)x1[e]; } } }
          const float sc = (c0 >= 512) ? 0.08838834764831845f : 1.f; h8 o0, o1;
#pragma unroll
          for (int e = 0; e < 8; ++e) { o0[e] = (half_t)(silu_f(acc[e]) * sc); o1[e] = (half_t)(silu_f(acc[8 + e]) * sc); }
          *(h8*)(MQKC + (size_t)t * 1024 + c0) = o0; *(h8*)(MQKC + (size_t)t * 1024 + c0 + 8) = o1;
          if (c0 >= 512) {
#pragma unroll
              for (int e = 0; e < 8; ++e) { MKT[(size_t)(c0 - 512 + e) * TB + t] = o0[e]; MKT[(size_t)(c0 - 512 + 8 + e) * TB + t] = o1[e]; } } }
    }
}

DEV void attn_unit(const Params& p, int l, int uidx, float lam, float lam_init) {
    char* ws = p.ws; const int lane = threadIdx.x & 63, r = lane & 15, g = lane >> 4;
    const int h = uidx & 7, qt = uidx >> 3, t = qt * 16 + r;
    half_t* QA = (half_t*)(ws + OFF_QA); const half_t* KA = (const half_t*)(ws + OFF_KA); const half_t* VAT = (const half_t*)(ws + OFF_VAT); const half_t* ZA = (const half_t*)(ws + OFF_ZA);
    h8 qf[2][2];
#pragma unroll
    for (int m = 0; m < 2; ++m)
#pragma unroll
        for (int ks = 0; ks < 2; ++ks) qf[m][ks] = *(const h8*)(QA + (size_t)t * 1024 + h * 128 + m * 64 + ks * 32 + 8 * g);
    f4 o[2][8]; float mrun[2] = {-INFINITY, -INFINITY}, lpart[2] = {0.f, 0.f};
#pragma unroll
    for (int m = 0; m < 2; ++m)
#pragma unroll
        for (int d = 0; d < 8; ++d) o[m][d] = (f4){0.f, 0.f, 0.f, 0.f};
    const int nkb = (qt * 16 + 15) / 32 + 1;
    for (int kb = 0; kb < nkb; ++kb) {
        const int k0 = kb * 32; const bool diag = (k0 + 31 > qt * 16);
        h8 pb[2];
#pragma unroll
        for (int m = 0; m < 2; ++m) {
            f4 s[2];
#pragma unroll
            for (int st = 0; st < 2; ++st) { s[st] = (f4){0.f, 0.f, 0.f, 0.f};
#pragma unroll
                for (int ks = 0; ks < 2; ++ks) { const h8 kf = *(const h8*)(KA + (size_t)(k0 + st * 16 + r) * 1024 + h * 128 + m * 64 + ks * 32 + 8 * g); s[st] = MFMA16(kf, qf[m][ks], s[st]); }
                if (diag) {
#pragma unroll
                    for (int e = 0; e < 4; ++e) if (k0 + st * 16 + 4 * g + e > t) s[st][e] = -INFINITY; } }
            float mx = fmaxf(fmaxf(fmaxf(s[0][0], s[0][1]), fmaxf(s[0][2], s[0][3])), fmaxf(fmaxf(s[1][0], s[1][1]), fmaxf(s[1][2], s[1][3])));
            mx = gmax(mx); const float mn = fmaxf(mrun[m], mx); const float sc = exp2f(mrun[m] - mn); mrun[m] = mn;
            float ps = 0.f; f4 pp[2];
#pragma unroll
            for (int st = 0; st < 2; ++st)
#pragma unroll
                for (int e = 0; e < 4; ++e) { pp[st][e] = exp2f(s[st][e] - mn); ps += pp[st][e]; }
            lpart[m] = lpart[m] * sc + ps;
#pragma unroll
            for (int d = 0; d < 8; ++d) o[m][d] *= sc;
            pb[m] = cat44(toh4(pp[0]), toh4(pp[1]));
        }
#pragma unroll
        for (int d = 0; d < 8; ++d) { const half_t* vp = VAT + (size_t)(h * 128 + d * 16 + r) * TB + k0 + 4 * g;
            const h8 va = cat44(*(const h4*)vp, *(const h4*)(vp + 16));
            o[0][d] = MFMA16(va, pb[0], o[0][d]); o[1][d] = MFMA16(va, pb[1], o[1][d]); }
    }
    const float l0 = gsum(lpart[0]), l1 = gsum(lpart[1]); const float i0 = 1.f / l0, i1 = lam / l1;
    float ss = 0.f;
#pragma unroll
    for (int d = 0; d < 8; ++d) { o[0][d] = o[0][d] * i0 - o[1][d] * i1; ss += o[0][d][0] * o[0][d][0] + o[0][d][1] * o[0][d][1] + o[0][d][2] * o[0][d][2] + o[0][d][3] * o[0][d][3]; }
    ss = gsum(ss); const float rs = rsqrtf(ss * (1.f / 128.f) + NORM_EPS) * (1.f - lam_init);
    const float* ng = p.da_norm_g + l * 128;
#pragma unroll
    for (int d = 0; d < 8; ++d) { const int dv = d * 16 + 4 * g; const f4 gg = *(const f4*)(ng + dv); const h4 z = *(const h4*)(ZA + (size_t)t * 1024 + h * 128 + dv);
        *(h4*)(QA + (size_t)t * 1024 + h * 128 + dv) = toh4((f4){o[0][d][0] * rs * gg[0] * (float)z[0], o[0][d][1] * rs * gg[1] * (float)z[1], o[0][d][2] * rs * gg[2] * (float)z[2], o[0][d][3] * rs * gg[3] * (float)z[3]}); }
}
DEV void ph_attn(const Params& p, int l) {
    const int lane = threadIdx.x & 63, wid = threadIdx.x >> 6;
    const float* lp = p.da_lambda + l * 256;
    const float a = wave_sum(lp[lane] * lp[64 + lane]), bq = wave_sum(lp[128 + lane] * lp[192 + lane]);
    const float lam_init = 0.8f - 0.6f * expf(-0.3f * (float)l); const float lam = expf(a) - expf(bq) + lam_init;
    const int nw = gridDim.x * NWAVE;
    for (int j = wid * gridDim.x + blockIdx.x; j < 4096; j += nw) { attn_unit(p, l, j, lam, lam_init); attn_unit(p, l, 8191 - j, lam, lam_init); }
}

DEV float chunk_scan(const float* MG, int hh, int c, float& ig) {
    const int lane = threadIdx.x & 63; const int t = c * 64 + lane;
    ig = MG[(size_t)t * 8 + hh]; float a = MG[(size_t)t * 8 + 4 + hh];
#pragma unroll
    for (int o = 1; o < 64; o <<= 1) { const float u = __shfl_up(a, o); if (lane >= o) a += u; }
    return a;
}
DEV void ph_ml_state(const Params& p) {
    char* ws = p.ws; const int lane = threadIdx.x & 63, wid = threadIdx.x >> 6, r = lane & 15, g = lane >> 4;
    const float* MG = (const float*)(ws + OFF_MG); const half_t* MVT = (const half_t*)(ws + OFF_MVT); const half_t* MKT = (const half_t*)(ws + OFF_MKT);
    float* ST = (float*)(ws + OFF_ST); float* NV = (float*)(ws + OFF_NV); float* DEC = (float*)(ws + OFF_DEC);
    for (int u = blockIdx.x; u < 1024; u += gridDim.x) {
        const int hh = u >> 8, c = u & 255; float ig; const float a = chunk_scan(MG, hh, c, ig); const float a63 = __shfl(a, 63); const float w = __expf(a63 - a + ig);
        f4 acc[2][8];
#pragma unroll
        for (int i = 0; i < 2; ++i)
#pragma unroll
            for (int j = 0; j < 8; ++j) acc[i][j] = (f4){0.f, 0.f, 0.f, 0.f};
#pragma unroll
        for (int ks = 0; ks < 2; ++ks) {
            float wj[8];
#pragma unroll
            for (int e = 0; e < 8; ++e) wj[e] = __shfl(w, 32 * ks + 8 * g + e);
            h8 va[2];
#pragma unroll
            for (int vt = 0; vt < 2; ++vt) { const h8 x = *(const h8*)(MVT + (size_t)(hh * 256 + wid * 32 + vt * 16 + r) * TB + c * 64 + 32 * ks + 8 * g);
#pragma unroll
                for (int e = 0; e < 8; ++e) va[vt][e] = (half_t)((float)x[e] * wj[e]); }
#pragma unroll
            for (int dt = 0; dt < 8; ++dt) { const h8 kb = *(const h8*)(MKT + (size_t)(hh * 128 + dt * 16 + r) * TB + c * 64 + 32 * ks + 8 * g);
                acc[0][dt] = MFMA16(va[0], kb, acc[0][dt]); acc[1][dt] = MFMA16(va[1], kb, acc[1][dt]); }
        }
#pragma unroll
        for (int vt = 0; vt < 2; ++vt)
#pragma unroll
            for (int dt = 0; dt < 8; ++dt)
#pragma unroll
                for (int e = 0; e < 4; ++e) ST[((size_t)(hh * 256 + c) * 256 + wid * 32 + vt * 16 + 4 * g + e) * 128 + dt * 16 + r] = acc[vt][dt][e];
        { const int d = wid * 16 + r; const half_t* kp = MKT + (size_t)(hh * 128 + d) * TB + c * 64 + 16 * g; const h8 k0 = *(const h8*)kp, k1 = *(const h8*)(kp + 8); float s = 0.f;
#pragma unroll
          for (int e = 0; e < 8; ++e) { s += (float)k0[e] * __shfl(w, 16 * g + e); s += (float)k1[e] * __shfl(w, 16 * g + 8 + e); }
          s = gsum(s); if (g == 0) NV[(size_t)(hh * 256 + c) * 128 + d] = s; }
        if (threadIdx.x == 0) DEC[hh * 256 + c] = __expf(a63);
    }
}
DEV void ph_ml_scan(const Params& p) {
    char* ws = p.ws; float* ST = (float*)(ws + OFF_ST); float* NV = (float*)(ws + OFF_NV); const float* DEC = (const float*)(ws + OFF_DEC);
    const int nthr = gridDim.x * NTHREADS;
    for (int e0 = blockIdx.x * NTHREADS + threadIdx.x; e0 < 4 * 32768 + 512; e0 += nthr) {
        float* base; size_t stride; int hh;
        if (e0 < 4 * 32768) { hh = e0 >> 15; base = ST + (size_t)hh * 256 * 32768 + (e0 & 32767); stride = 32768; }
        else { const int q = e0 - 4 * 32768; hh = q >> 7; base = NV + (size_t)hh * 256 * 128 + (q & 127); stride = 128; }
        float S = 0.f;
        for (int c0 = 0; c0 < 256; c0 += 8) { float tmp[8];
#pragma unroll
            for (int i = 0; i < 8; ++i) tmp[i] = base[(size_t)(c0 + i) * stride];
#pragma unroll
            for (int i = 0; i < 8; ++i) { base[(size_t)(c0 + i) * stride] = S; S = DEC[hh * 256 + c0 + i] * S + tmp[i]; } }
    }
}
DEV void ph_ml_out(const Params& p, int l) {
    char* ws = p.ws; const int lane = threadIdx.x & 63, wid = threadIdx.x >> 6, r = lane & 15, g = lane >> 4;
    const float* MG = (const float*)(ws + OFF_MG); const half_t* MVT = (const half_t*)(ws + OFF_MVT); const half_t* MQKC = (const half_t*)(ws + OFF_MQKC);
    const float* ST = (const float*)(ws + OFF_ST); const float* NV = (const float*)(ws + OFF_NV);
    const half_t* MO = (const half_t*)(ws + OFF_MO); const half_t* MZ = (const half_t*)(ws + OFF_MZ); half_t* YB = (half_t*)(ws + OFF_YB);
    const float* ng = p.ml_norm_g + l * 256;
    for (int uu = blockIdx.x * NWAVE + wid; uu < 4096; uu += gridDim.x * NWAVE) {
        const int cu = uu >> 2, j = uu & 3, hh = cu >> 8, c = cu & 255; const int t = c * 64 + 16 * j + r;
        float ig; const float a = chunk_scan(MG, hh, c, ig); const float a_t = __shfl(a, 16 * j + r); const float ea = __expf(a_t);
        h8 qf[4];
#pragma unroll
        for (int ks = 0; ks < 4; ++ks) qf[ks] = *(const h8*)(MQKC + (size_t)t * 1024 + hh * 128 + 32 * ks + 8 * g);
        f4 acc[16];
#pragma unroll
        for (int vt = 0; vt < 16; ++vt) { acc[vt] = (f4){0.f, 0.f, 0.f, 0.f};
#pragma unroll
            for (int ks = 0; ks < 4; ++ks) { const float* sp = ST + ((size_t)cu * 256 + vt * 16 + r) * 128 + 32 * ks + 8 * g; const f4 s0 = *(const f4*)sp, s1 = *(const f4*)(sp + 4);
                const h8 sa = (h8){(half_t)s0[0], (half_t)s0[1], (half_t)s0[2], (half_t)s0[3], (half_t)s1[0], (half_t)s1[1], (half_t)s1[2], (half_t)s1[3]};
                acc[vt] = MFMA16(sa, qf[ks], acc[vt]); }
            acc[vt] *= ea; }
        float den = 0.f;
        { const float* np = NV + (size_t)cu * 128 + 32 * g; const half_t* qp = MQKC + (size_t)t * 1024 + hh * 128 + 32 * g;
#pragma unroll
          for (int m = 0; m < 4; ++m) { const h8 q8 = *(const h8*)(qp + 8 * m);
#pragma unroll
              for (int e = 0; e < 8; ++e) den += (float)q8[e] * np[8 * m + e]; }
          den *= ea; }
        for (int kb = 0; kb <= (j >> 1); ++kb) {
            f4 wv[2];
#pragma unroll
            for (int st = 0; st < 2; ++st) { f4 gacc = (f4){0.f, 0.f, 0.f, 0.f}; const int s_row = c * 64 + 32 * kb + 16 * st + r;
#pragma unroll
                for (int ks = 0; ks < 4; ++ks) { const h8 kf = *(const h8*)(MQKC + (size_t)s_row * 1024 + 512 + hh * 128 + 32 * ks + 8 * g); gacc = MFMA16(kf, qf[ks], gacc); }
#pragma unroll
                for (int e = 0; e < 4; ++e) { const int si = 32 * kb + 16 * st + 4 * g + e; const float a_s = __shfl(a, si), ig_s = __shfl(ig, si);
                    wv[st][e] = (si <= 16 * j + r) ? gacc[e] * __expf(a_t - a_s + ig_s) : 0.f; den += wv[st][e]; } }
            const h8 pb = cat44(toh4(wv[0]), toh4(wv[1]));
#pragma unroll
            for (int vt = 0; vt < 16; ++vt) { const half_t* vp = MVT + (size_t)(hh * 256 + vt * 16 + r) * TB + c * 64 + 32 * kb + 4 * g;
                acc[vt] = MFMA16(cat44(*(const h4*)vp, *(const h4*)(vp + 16)), pb, acc[vt]); }
        }
        den = gsum(den); const float inv = 1.f / fmaxf(fabsf(den), 1.f); float ss = 0.f;
#pragma unroll
        for (int vt = 0; vt < 16; ++vt) { acc[vt] *= inv; ss += acc[vt][0] * acc[vt][0] + acc[vt][1] * acc[vt][1] + acc[vt][2] * acc[vt][2] + acc[vt][3] * acc[vt][3]; }
        ss = gsum(ss); const float rs = rsqrtf(ss * (1.f / 256.f) + NORM_EPS);
#pragma unroll
        for (int vt = 0; vt < 16; ++vt) { const int v = vt * 16 + 4 * g; const f4 gg = *(const f4*)(ng + v); const size_t off = (size_t)t * 1024 + hh * 256 + v; const h4 o4 = *(const h4*)(MO + off), z4 = *(const h4*)(MZ + off);
            *(h4*)(YB + off) = toh4((f4){acc[vt][0] * rs * gg[0] * (float)o4[0] * (float)z4[0], acc[vt][1] * rs * gg[1] * (float)o4[1] * (float)z4[1], acc[vt][2] * rs * gg[2] * (float)o4[2] * (float)z4[2], acc[vt][3] * rs * gg[3] * (float)o4[3] * (float)z4[3]}); }
    }
}

constexpr int CAP = 512;
constexpr int IDX_WAVE_LDS = 2 * CAP * 4 + 2 * CAP * 2 + 256 * 4;
DEV unsigned f2key(float v) { const unsigned b = __float_as_uint(v); return b ^ ((b >> 31) ? 0xffffffffu : 0x80000000u); }
DEV float key2f(unsigned u) { const unsigned b = (u >> 31) ? (u ^ 0x80000000u) : ~u; return __uint_as_float(b); }
DEV float prune(float* val, u16* idx, unsigned* hist, int n) {
    const int lane = threadIdx.x & 63;
    unsigned u[8]; u16 id[8];
#pragma unroll
    for (int i = 0; i < 8; ++i) { const int e = lane + 64 * i; const bool ok = e < n; u[i] = ok ? f2key(val[e]) : 0u; id[i] = ok ? idx[e] : (u16)0; }
    unsigned prefix = 0u, mask = 0u; int want = TOPK;
    for (int shift = 24; shift >= 0; shift -= 8) {
#pragma unroll
        for (int i = 0; i < 4; ++i) hist[lane + 64 * i] = 0u;
        __builtin_amdgcn_fence(__ATOMIC_RELEASE, "wavefront"); __builtin_amdgcn_wave_barrier();
#pragma unroll
        for (int i = 0; i < 8; ++i) { const int e = lane + 64 * i; if (e < n && (u[i] & mask) == prefix) atomicAdd(&hist[(u[i] >> shift) & 255u], 1u); }
        __builtin_amdgcn_fence(__ATOMIC_ACQ_REL, "wavefront"); __builtin_amdgcn_wave_barrier();
        const unsigned c0 = hist[4 * lane], c1 = hist[4 * lane + 1], c2 = hist[4 * lane + 2], c3 = hist[4 * lane + 3];
        const unsigned mine = c0 + c1 + c2 + c3; unsigned above = mine;
#pragma unroll
        for (int o = 1; o < 64; o <<= 1) { const unsigned t = __shfl_down(above, o); if (lane + o < 64) above += t; }
        above -= mine;
        const bool here = (above < (unsigned)want) && (above + mine >= (unsigned)want);
        int bsel = 0; unsigned cab = 0;
        if (here) { unsigned cum = above; if (cum + c3 >= (unsigned)want) { bsel = 4 * lane + 3; cab = cum; } else { cum += c3; if (cum + c2 >= (unsigned)want) { bsel = 4 * lane + 2; cab = cum; } else { cum += c2; if (cum + c1 >= (unsigned)want) { bsel = 4 * lane + 1; cab = cum; } else { cum += c1; bsel = 4 * lane; cab = cum; } } } }
        const unsigned long long bal = __ballot(here); const int src = __ffsll((long long)bal) - 1;
        bsel = __shfl(bsel, src); cab = __shfl(cab, src);
        prefix |= ((unsigned)bsel) << shift; mask |= 0xffu << shift; want -= (int)cab;
        __builtin_amdgcn_wave_barrier();
    }
    int kept = 0, eqseen = 0;
#pragma unroll
    for (int i = 0; i < 8; ++i) { const int e = lane + 64 * i; const bool ok = e < n; const bool gt = ok && u[i] > prefix, eq = ok && u[i] == prefix;
        const unsigned long long beq = __ballot(eq); const unsigned long long lt = (1ull << lane) - 1ull;
        const int erank = eqseen + __popcll(beq & lt); const bool keep = gt || (eq && erank < want); eqseen += __popcll(beq);
        const unsigned long long bk = __ballot(keep); const int pos = kept + __popcll(bk & lt); kept += __popcll(bk);
        if (keep) { val[pos] = key2f(u[i]); idx[pos] = id[i]; } }
    __builtin_amdgcn_fence(__ATOMIC_ACQ_REL, "wavefront"); __builtin_amdgcn_wave_barrier();
    return key2f(prefix);
}
DEV void ph_index(const Params& p, char* lds) {
    char* ws = p.ws; const int lane = threadIdx.x & 63, wid = threadIdx.x >> 6, c32 = lane & 31, hi = lane >> 5;
    const half_t* IQ = (const half_t*)(ws + OFF_IQ); const half_t* IK = (const half_t*)(ws + OFF_IK); const float* IW = (const float*)(ws + OFF_IW);
    u16* IDX = (u16*)(ws + OFF_IDX); int* CNT = (int*)(ws + OFF_CNT);
    char* my = lds + wid * IDX_WAVE_LDS; float* val = (float*)my; u16* idxb = (u16*)(my + 2 * CAP * 4); unsigned* hist = (unsigned*)(my + 2 * CAP * 4 + 2 * CAP * 2);
    const int nw = gridDim.x * NWAVE;
    for (int j0 = wid * gridDim.x + blockIdx.x; j0 < 4096; j0 += nw) {
#pragma unroll 1
        for (int rep = 0; rep < 2; ++rep) {
            const int uq = rep == 0 ? j0 : 8191 - j0; const int tq0 = uq * 2;
            const int aq = tq0 + ((c32 >> 2) & 1), ah = (c32 & 3) + 4 * (c32 >> 3);
            h8 af[4];
#pragma unroll
            for (int s = 0; s < 4; ++s) af[s] = *(const h8*)(IQ + (size_t)aq * 1024 + ah * 64 + 16 * s + 8 * hi);
            const int tmine = tq0 + hi; float iw[16];
#pragma unroll
            for (int e = 0; e < 16; e += 4) { const f4 w4 = *(const f4*)(IW + (size_t)tmine * 16 + e); iw[e] = w4[0]; iw[e + 1] = w4[1]; iw[e + 2] = w4[2]; iw[e + 3] = w4[3]; }
            float* myval = val + hi * CAP; u16* myidx = idxb + hi * CAP;
            float tau = -INFINITY; int cnt = 0;
            const int nkt = (tq0 + 1) / 32 + 1;
            for (int kt = 0; kt < nkt; ++kt) {
                const int key = kt * 32 + c32;
                f16v acc = {0.f, 0.f, 0.f, 0.f, 0.f, 0.f, 0.f, 0.f, 0.f, 0.f, 0.f, 0.f, 0.f, 0.f, 0.f, 0.f};
#pragma unroll
                for (int s = 0; s < 4; ++s) { const h8 bf = *(const h8*)(IK + (size_t)key * 64 + 16 * s + 8 * hi); acc = MFMA32(af[s], bf, acc); }
                float v = 0.f;
#pragma unroll
                for (int e = 0; e < 16; ++e) v += fmaxf(acc[e], 0.f) * iw[e];
                const bool cand = (key <= tmine) && (v > tau);
                const unsigned long long bal = __ballot(cand); const unsigned m32 = hi ? (unsigned)(bal >> 32) : (unsigned)bal;
                const int pos = cnt + __popc(m32 & ((1u << c32) - 1u));
                if (cand) { myval[pos] = v; myidx[pos] = (u16)key; }
                cnt += __popc(m32);
                __builtin_amdgcn_fence(__ATOMIC_ACQ_REL, "wavefront"); __builtin_amdgcn_wave_barrier();
                const int n0 = __shfl(cnt, 0), n1 = __shfl(cnt, 32);
                if (n0 > CAP - 32) { const float tn = prune(val, idxb, hist, n0); if (hi == 0) { tau = tn; cnt = TOPK; } }
                if (n1 > CAP - 32) { const float tn = prune(val + CAP, idxb + CAP, hist, n1); if (hi == 1) { tau = tn; cnt = TOPK; } }
            }
            int n0 = __shfl(cnt, 0), n1 = __shfl(cnt, 32);
            if (n0 > TOPK) { prune(val, idxb, hist, n0); n0 = TOPK; }
            if (n1 > TOPK) { prune(val + CAP, idxb + CAP, hist, n1); n1 = TOPK; }
#pragma unroll
            for (int i = 0; i < 4; ++i) { const int e = lane + 64 * i; IDX[(size_t)tq0 * 256 + e] = (e < n0) ? idxb[e] : (u16)0; IDX[(size_t)(tq0 + 1) * 256 + e] = (e < n1) ? idxb[CAP + e] : (u16)0; }
            if (lane == 0) { CNT[tq0] = n0; CNT[tq0 + 1] = n1; }
            __builtin_amdgcn_fence(__ATOMIC_ACQ_REL, "wavefront"); __builtin_amdgcn_wave_barrier();
        }
    }
}

constexpr int SP_LD = 264;
constexpr int SP_WAVE_LDS = 32 * SP_LD * 2;
DEV h4 tr_read4(unsigned addr) { h4 r; asm volatile("ds_read_b64_tr_b16 %0, %1\n\ts_waitcnt lgkmcnt(0)" : "=&v"(r) : "v"(addr) : "memory"); return r; }
DEV void ph_sparse(const Params& p, char* lds) {
    char* ws = p.ws; const int lane = threadIdx.x & 63, wid = threadIdx.x >> 6, r = lane & 15, g = lane >> 4;
    half_t* DQ = (half_t*)(ws + OFF_DQ); const half_t* C = (const half_t*)(ws + OFF_C); const u16* IDX = (const u16*)(ws + OFF_IDX); const int* CNT = (const int*)(ws + OFF_CNT);
    half_t* tile = (half_t*)(lds + wid * SP_WAVE_LDS); const unsigned tile_addr = (unsigned)(uintptr_t)tile;
    for (int t = blockIdx.x * NWAVE + wid; t < TB; t += gridDim.x * NWAVE) {
        const int n = CNT[t];
        h8 qf[8];
#pragma unroll
        for (int ks = 0; ks < 8; ++ks) qf[ks] = (r < 8) ? *(const h8*)(DQ + (size_t)t * 2048 + r * 256 + 32 * ks + 8 * g) : zero8();
        f4 ob[16];
#pragma unroll
        for (int ct = 0; ct < 16; ++ct) ob[ct] = (f4){0.f, 0.f, 0.f, 0.f};
        float mrun = -INFINITY, lpart = 0.f;
        const int nkb = (n + 31) >> 5;
        for (int kb = 0; kb < nkb; ++kb) {
            __builtin_amdgcn_fence(__ATOMIC_ACQ_REL, "wavefront"); __builtin_amdgcn_wave_barrier();
#pragma unroll
            for (int i = 0; i < 16; ++i) { const int ch = lane + 64 * i, row = ch >> 5, c16 = ch & 31; const int ks_ = 32 * kb + row;
                const int id = (ks_ < n) ? (int)IDX[(size_t)t * 256 + ks_] : 0;
                *(h8*)(tile + row * SP_LD + c16 * 8) = *(const h8*)(C + (size_t)id * 256 + c16 * 8); }
            __builtin_amdgcn_fence(__ATOMIC_ACQ_REL, "wavefront"); __builtin_amdgcn_wave_barrier();
            asm volatile("s_waitcnt vmcnt(0) lgkmcnt(0)" ::: "memory");
            f4 s[2];
#pragma unroll
            for (int st = 0; st < 2; ++st) { s[st] = (f4){0.f, 0.f, 0.f, 0.f};
#pragma unroll
                for (int ks = 0; ks < 8; ++ks) { const h8 a = *(const h8*)(tile + (16 * st + r) * SP_LD + 32 * ks + 8 * g); s[st] = MFMA16(a, qf[ks], s[st]); }
#pragma unroll
                for (int e = 0; e < 4; ++e) if (32 * kb + 16 * st + 4 * g + e >= n) s[st][e] = -INFINITY; }
            float mx = fmaxf(fmaxf(fmaxf(s[0][0], s[0][1]), fmaxf(s[0][2], s[0][3])), fmaxf(fmaxf(s[1][0], s[1][1]), fmaxf(s[1][2], s[1][3])));
            mx = gmax(mx); const float mn = fmaxf(mrun, mx); const float sc = exp2f(mrun - mn); mrun = mn;
            float ps = 0.f; f4 pp[2];
#pragma unroll
            for (int st = 0; st < 2; ++st)
#pragma unroll
                for (int e = 0; e < 4; ++e) { pp[st][e] = exp2f(s[st][e] - mn); ps += pp[st][e]; }
            lpart = lpart * sc + ps;
            const h8 pb = cat44(toh4(pp[0]), toh4(pp[1]));
            const unsigned a0 = tile_addr + (unsigned)(((4 * g + (r >> 2)) * SP_LD + 4 * (r & 3)) * 2);
#pragma unroll
            for (int ct = 0; ct < 16; ++ct) { const h4 lo = tr_read4(a0 + ct * 32), hi4 = tr_read4(a0 + 16 * SP_LD * 2 + ct * 32);
                ob[ct] = ob[ct] * sc; ob[ct] = MFMA16(cat44(lo, hi4), pb, ob[ct]); }
        }
        const float inv = 1.f / gsum(lpart);
        if (r < 8) {
#pragma unroll
            for (int ct = 0; ct < 16; ++ct) *(h4*)(DQ + (size_t)t * 2048 + r * 256 + 16 * ct + 4 * g) = toh4(ob[ct] * inv); }
    }
}

DEV void ph_final(const Params& p, int l, int b) {
    const float* X = (l == 0 ? p.x : p.out) + (size_t)b * TB * 2048; float* O = p.out + (size_t)b * TB * 2048;
    const float* OUTP = (const float*)(p.ws + OFF_OUTP); const float* SS = (const float*)(p.ws + OFF_SS); const float* g = p.post_g + l * 2048;
    const int lane = threadIdx.x & 63, wid = threadIdx.x >> 6;
    for (int t = blockIdx.x * NWAVE + wid; t < TB; t += gridDim.x * NWAVE) {
        const float rs = rsqrtf(SS[t] * (1.f / 2048.f) + NORM_EPS);
#pragma unroll
        for (int i = 0; i < 8; ++i) { const size_t off = (size_t)t * 2048 + i * 256 + lane * 4; const f4 xv = *(const f4*)(X + off), ov = *(const f4*)(OUTP + off), gg = *(const f4*)(g + i * 256 + lane * 4);
            *(f4*)(O + off) = xv + ov * rs * gg; }
    }
}

constexpr int LDS_BYTES = 8 * SP_WAVE_LDS;
template <int PH> __global__ void __launch_bounds__(NTHREADS, 2) fwd_ph(Params p, int l, int b) {
    extern __shared__ __attribute__((aligned(16))) char lds[];
    char* ws = p.ws;
    if constexpr (PH == 100) ph_weights(p, l, lds);
    if constexpr (PH == 0) ph_h(p, l, b);
    if constexpr (PH == 1) { EpiIn E{ws}; gemm_simple((const half_t*)(ws + OFF_H), 2048, (const half_t*)(ws + OFF_WT), 2048, TB, N_IN, 2048, 0, E); }
    if constexpr (PH == 2) ph_post(p, l);
    if constexpr (PH == 3) ph_attn(p, l);
    if constexpr (PH == 4) ph_ml_state(p);
    if constexpr (PH == 5) ph_ml_scan(p);
    if constexpr (PH == 6) ph_ml_out(p, l);
    if constexpr (PH == 7) ph_index(p, lds);
    if constexpr (PH == 8) ph_sparse(p, lds);
    if constexpr (PH == 9) { EpiMulH E{(half_t*)(ws + OFF_IQ), (const half_t*)(ws + OFF_DZ), 1024}; gemm_simple((const half_t*)(ws + OFF_DQ), 2048, (const half_t*)(ws + OFF_WUVT), 512, TB, 1024, 512, 512, E); }
    if constexpr (PH == 10) {
        const half_t* Y[3] = {(const half_t*)(ws + OFF_QA), (const half_t*)(ws + OFF_YB), (const half_t*)(ws + OFF_IQ)};
#pragma unroll
        for (int i = 0; i < 3; ++i) { EpiGate E{(half_t*)(ws + OFF_MIX), (const half_t*)(ws + OFF_G), i * 2048, i == 0};
            gemm_simple(Y[i], 1024, (const half_t*)(ws + OFF_WBT) + (size_t)i * 2048 * 1024, 1024, TB, 2048, 1024, 0, E); } }
    if constexpr (PH == 11) { EpiOut E{(float*)(ws + OFF_OUTP), (float*)(ws + OFF_SS)}; gemm_simple((const half_t*)(ws + OFF_MIX), 2048, (const half_t*)(ws + OFF_WOT), 2048, TB, 2048, 2048, 0, E); }
    if constexpr (PH == 12) ph_final(p, l, b);
}
template <int PH> static void launch_ph(const Params& p, int l, int b, hipStream_t stream) {
    static bool attr_set = false;
    if (!attr_set) { (void)hipFuncSetAttribute((const void*)fwd_ph<PH>, hipFuncAttributeMaxDynamicSharedMemorySize, LDS_BYTES); attr_set = true; }
    hipLaunchKernelGGL(fwd_ph<PH>, dim3(256), dim3(NTHREADS), LDS_BYTES, stream, p, l, b);
}

extern "C" void kernel_launch(void* const* d_in, const int* in_sizes, int n_in, void* d_out, int out_size, void* d_ws, size_t ws_size, hipStream_t stream) {
    (void)in_sizes; (void)n_in; (void)out_size;
    if (ws_size < WS_NEED) { fprintf(stderr, "workspace too small: %zu < %zu\n", ws_size, (size_t)WS_NEED); return; }
    Params p{};
    p.x = (const float*)d_in[0]; p.pre_g = (const float*)d_in[1]; p.w_in = (const float*)d_in[2]; p.da_lambda = (const float*)d_in[3]; p.da_norm_g = (const float*)d_in[4];
    p.ml_conv_w = (const float*)d_in[5]; p.ml_conv_b = (const float*)d_in[6]; p.ml_gate_b = (const float*)d_in[7]; p.ml_norm_g = (const float*)d_in[8];
    p.kv_norm_g = (const float*)d_in[9]; p.ik_norm_g = (const float*)d_in[10]; p.w_uv = (const float*)d_in[11]; p.w_branch = (const float*)d_in[12]; p.w_out = (const float*)d_in[13]; p.post_g = (const float*)d_in[14];
    p.out = (float*)d_out; p.ws = (char*)d_ws;
    for (int l = 0; l < DEPTH; ++l) {
        launch_ph<100>(p, l, 0, stream);
        for (int b = 0; b < NB; ++b) {
            launch_ph<0>(p, l, b, stream); launch_ph<1>(p, l, b, stream); launch_ph<2>(p, l, b, stream); launch_ph<3>(p, l, b, stream);
            launch_ph<4>(p, l, b, stream); launch_ph<5>(p, l, b, stream); launch_ph<6>(p, l, b, stream); launch_ph<7>(p, l, b, stream);
            launch_ph<8>(p, l, b, stream); launch_ph<9>(p, l, b, stream); launch_ph<10>(p, l, b, stream); launch_ph<11>(p, l, b, stream);
            launch_ph<12>(p, l, b, stream);
        }
    }
}
```

```cpp
#include <hip/hip_runtime.h>
#include <stdint.h>
#include <stdio.h>

typedef _Float16 half_t;
typedef _Float16 h8 __attribute__((ext_vector_type(8)));
typedef _Float16 h4 __attribute__((ext_vector_type(4)));
typedef float f4 __attribute__((ext_vector_type(4)));
typedef float f16v __attribute__((ext_vector_type(16)));
typedef unsigned short u16;
#define LAS __attribute__((address_space(3)))
#define DEV __device__ __forceinline__

constexpr int D_MODEL = 2048, NB = 2, SEQ = 16384, DEPTH = 2, TB = SEQ;
constexpr int N_IN_SRC = 18776, N_IN = 18944;
constexpr int N16 = 16 * 256, N8 = 58 * 256;
constexpr float NORM_EPS = 1e-6f;
constexpr float LOG2E = 1.4426950408889634f;
constexpr int NTHREADS = 512, NWAVE = 8;
constexpr int TOPK = 256;

constexpr size_t U1 = (size_t)TB * 1024 * 2;
constexpr size_t OFF_CTRL = 0;
constexpr size_t OFF_WT   = 1 << 20;
constexpr size_t OFF_WT8  = OFF_WT + (size_t)N16 * 2048 * 2;
constexpr size_t OFF_WS8  = OFF_WT8 + (size_t)N8 * 2048;
constexpr size_t OFF_WBT  = (OFF_WS8 + (size_t)N8 * 4 + 4095) / 4096 * 4096;
constexpr size_t OFF_WOT  = OFF_WBT + (size_t)3 * 2048 * 1024 * 2;
constexpr size_t OFF_WUVT = OFF_WOT + (size_t)2048 * 2048 * 2;
constexpr size_t OFF_H    = OFF_WUVT + (size_t)1024 * 512 * 2;

constexpr size_t OFF_QA   = OFF_H + 2 * U1;
constexpr size_t OFF_KA   = OFF_QA + U1;
constexpr size_t OFF_VAT  = OFF_KA + U1;
constexpr size_t OFF_MIX  = OFF_KA;
constexpr size_t OFF_ST16 = OFF_KA;
constexpr size_t OFF_ZA   = OFF_VAT + U1;
constexpr size_t OFF_MQKR = OFF_ZA + U1;
constexpr size_t OFF_MVT  = OFF_MQKR + U1;
constexpr size_t OFF_MO   = OFF_MVT + U1;
constexpr size_t OFF_MZ   = OFF_MO + U1;
constexpr size_t OFF_DQ   = OFF_MZ + U1;
constexpr size_t OFF_IQ   = OFF_DQ + 2 * U1;
constexpr size_t OFF_DZ   = OFF_IQ + U1;
constexpr size_t OFF_G    = OFF_DZ + U1;
constexpr size_t OFF_ST   = OFF_G + 3 * U1;
constexpr size_t OFF_OUTP = OFF_ST;

constexpr size_t OFF_CKV  = OFF_ST + 4 * U1;
constexpr size_t OFF_SM   = OFF_CKV + (size_t)TB * 256 * 4;
constexpr size_t OFF_C    = OFF_SM + (size_t)TB * 96 * 4;
constexpr size_t OFF_IK   = OFF_C + (size_t)TB * 256 * 2;
constexpr size_t OFF_IW   = OFF_IK + (size_t)TB * 64 * 2;
constexpr size_t OFF_MG   = OFF_IW + (size_t)TB * 16 * 4;
constexpr size_t OFF_IDX  = OFF_MG + (size_t)TB * 8 * 4;
constexpr size_t OFF_CNT  = OFF_IDX + (size_t)TB * 256 * 2;
constexpr size_t OFF_NV   = OFF_CNT + (size_t)TB * 4;
constexpr size_t OFF_DEC  = OFF_NV + (size_t)4 * 256 * 128 * 4;
constexpr size_t OFF_SS   = OFF_DEC + 4096;
constexpr size_t OFF_OA0  = OFF_SS + (size_t)TB * 4;
constexpr size_t OFF_OA1  = OFF_OA0 + U1;
constexpr size_t OFF_MQKC = OFF_OA1 + U1;
constexpr size_t OFF_YB   = OFF_MQKR;
constexpr size_t OFF_H8   = OFF_MQKC + U1;
constexpr size_t OFF_HS   = OFF_H8 + U1;
constexpr size_t OFF_X1H  = OFF_HS + (size_t)TB * 4;
constexpr size_t WS_NEED  = OFF_X1H + (size_t)NB * TB * 2048 * 2;

struct Params {
    const float *x, *pre_g, *w_in, *da_lambda, *da_norm_g, *ml_conv_w, *ml_conv_b, *ml_gate_b, *ml_norm_g, *kv_norm_g, *ik_norm_g, *w_uv, *w_branch, *w_out, *post_g;
    float* out;
    char* ws;
    int ph_lo, ph_hi;
};

DEV int lv(int v) { asm volatile("" : "+v"(v)); return v; }
DEV int ls(int v) { asm volatile("" : "+s"(v)); return v; }
DEV int lane_id_v() { int l; asm volatile("v_mbcnt_lo_u32_b32 %0, -1, 0\n\tv_mbcnt_hi_u32_b32 %0, -1, %0" : "=v"(l)); return l; }
#define TID_DECL const int tidx = lv((ls(wv) << 6) | lane_id_v()); const int bidx = ls((int)blockIdx.x); const int nblk = ls((int)gridDim.x); (void)tidx; (void)bidx; (void)nblk;
DEV float silu_f(float v) { return v * __builtin_amdgcn_rcpf(1.f + __expf(-v)); }
DEV float sigm_f(float v) { return __builtin_amdgcn_rcpf(1.f + __expf(-v)); }
DEV float shi(float v, int src) { return __int_as_float(__builtin_amdgcn_ds_bpermute(src << 2, __float_as_int(v))); }
DEV int shi(int v, int src) { return __builtin_amdgcn_ds_bpermute(src << 2, v); }
DEV unsigned shi(unsigned v, int src) { return (unsigned)__builtin_amdgcn_ds_bpermute(src << 2, (int)v); }
DEV float shx(int lane, float v, int m) { return shi(v, lane ^ m); }
DEV float wave_sum(int lane, float v) {
#pragma unroll
    for (int o = 32; o >= 1; o >>= 1) v += shx(lane, v, o);
    return v;
}
DEV float gsum(int lane, float v) { v += shx(lane, v, 16); v += shx(lane, v, 32); return v; }
DEV float gmax(int lane, float v) { v = fmaxf(v, shx(lane, v, 16)); v = fmaxf(v, shx(lane, v, 32)); return v; }
DEV h8 cat44(h4 a, h4 b) { return (h8){a[0], a[1], a[2], a[3], b[0], b[1], b[2], b[3]}; }
DEV h4 toh4(f4 v) { return (h4){(half_t)v[0], (half_t)v[1], (half_t)v[2], (half_t)v[3]}; }
DEV h8 zero8() { return (h8){0, 0, 0, 0, 0, 0, 0, 0}; }
#define MFMA16(a, b, c) __builtin_amdgcn_mfma_f32_16x16x32_f16((a), (b), (c), 0, 0, 0)
#define MFMA32(a, b, c) __builtin_amdgcn_mfma_f32_32x32x16_f16((a), (b), (c), 0, 0, 0)

DEV int in_src_col(int n) {
    if (n < 2048) return n;
    if (n < 2304) return n - 2048 + 10248;
    if (n < 3328) return n - 2304 + 10504;
    if (n < 3584) { const int c = n - 3328; return c < 64 ? 11528 + c : c < 80 ? 11592 + (c - 64) : c < 88 ? 6144 + (c - 80) : -1; }
    return n - 3584 + 8200;
}
DEV int in_src_col8(int n) {
    if (n < 1024) return 3072 + n;
    if (n < 2048) return 6152 + (n - 1024);
    if (n < 3072) return 7176 + (n - 2048);
    if (n < 4096) return 11608 + (n - 3072);
    if (n < 5120) return 2048 + (n - 4096);
    if (n < 6144) return n;
    if (n < 7168) return 4096 + (n - 6144);
    if (n < 13312) return 12632 + (n - 7168);
    return 8200 + 512 + (n - 13312);
}
template <class F> DEV void tr_tile(half_t* dst, int Kd, int n0, int k0, F src, LAS float* tile  , int tidx) {
    const int tid = tidx;
    __syncthreads();
#pragma unroll
    for (int j = 0; j < 8; ++j) { const int kk = (tid >> 6) + 8 * j, nn = tid & 63; tile[kk * 65 + nn] = src(k0 + kk, n0 + nn); }
    __syncthreads();
#pragma unroll
    for (int j = 0; j < 8; ++j) { const int nn = (tid >> 6) + 8 * j, kk = tid & 63; dst[(size_t)(n0 + nn) * Kd + k0 + kk] = (half_t)tile[kk * 65 + nn]; }
}
DEV void ph_weights(const Params& p, int l, LAS char* lds, int wv) {
    TID_DECL
    LAS float* tile = (LAS float*)lds;
    half_t* Wt = (half_t*)(p.ws + OFF_WT); half_t* Wbt = (half_t*)(p.ws + OFF_WBT); half_t* Wot = (half_t*)(p.ws + OFF_WOT); half_t* Wuvt = (half_t*)(p.ws + OFF_WUVT);
    const float* w_in = p.w_in + (size_t)l * 2048 * N_IN_SRC;
    const float* w_br = p.w_branch + (size_t)l * 3 * 1024 * 2048;
    const float* w_out = p.w_out + (size_t)l * 2048 * 2048;
    const float* w_uv = p.w_uv + (size_t)l * 8 * 256 * 128;
    constexpr int T_I8 = N8 / 64, T_IN = (N16 / 64) * 32, T_BR = 3 * 32 * 16, T_OUT = 32 * 32, T_UV = 16 * 8;
    for (int u0 = bidx; u0 < T_I8 + T_IN + T_BR + T_OUT + T_UV; u0 += nblk) {
        if (u0 < T_I8) {
            const int n0 = u0 * 64, nn = tidx & 63, kg = tidx >> 6; const int s = in_src_col8(n0 + nn);
            LAS float* red = tile + 64 * 65;
            float mx = 0.f;
            for (int kk = kg; kk < 2048; kk += 8) mx = fmaxf(mx, fabsf(w_in[(size_t)kk * N_IN_SRC + s]));
            __syncthreads(); red[kg * 64 + nn] = mx; __syncthreads();
            if (tidx < 64) { float m = red[nn];
#pragma unroll
                for (int j = 1; j < 8; ++j) m = fmaxf(m, red[j * 64 + nn]);
                red[512 + nn] = m > 0.f ? 127.f / m : 0.f; ((float*)(p.ws + OFF_WS8))[n0 + nn] = m * (1.f / 127.f); }
            __syncthreads();
            const float inv = red[512 + nn];
            unsigned char* W8 = (unsigned char*)(p.ws + OFF_WT8);
            for (int kt = 0; kt < 32; ++kt) {
                __syncthreads();
#pragma unroll
                for (int j = 0; j < 8; ++j) { const int kk = kg + 8 * j; tile[kk * 65 + nn] = w_in[(size_t)(kt * 64 + kk) * N_IN_SRC + s] * inv; }
                __syncthreads();
                const int n2 = tidx >> 3, kq = tidx & 7; unsigned w0 = 0u, w1 = 0u;
#pragma unroll
                for (int j = 0; j < 4; ++j) { w0 |= ((unsigned)(int)__builtin_rintf(tile[(8 * kq + j) * 65 + n2]) & 255u) << (8 * j); w1 |= ((unsigned)(int)__builtin_rintf(tile[(8 * kq + 4 + j) * 65 + n2]) & 255u) << (8 * j); }
                *(uint2*)(W8 + (size_t)(n0 + n2) * 2048 + kt * 64 + 8 * kq) = make_uint2(w0, w1);
            }
            continue;
        }
        const int u = u0 - T_I8;
        if (u < T_IN) { const int nt = u / 32, kt = u % 32;
            tr_tile(Wt, 2048, nt * 64, kt * 64, [&](int k, int n) { const int s = in_src_col(n); return s < 0 ? 0.f : w_in[(size_t)k * N_IN_SRC + s]; }, tile, tidx);
        } else if (u < T_IN + T_BR) { const int v = u - T_IN, i = v / 512, r = v % 512, nt = r / 16, kt = r % 16;
            const float* src = w_br + (size_t)i * 1024 * 2048;
            tr_tile(Wbt + (size_t)i * 2048 * 1024, 1024, nt * 64, kt * 64, [&](int k, int n) { return src[(size_t)k * 2048 + n]; }, tile, tidx);
        } else if (u < T_IN + T_BR + T_OUT) { const int v = u - T_IN - T_BR, nt = v / 32, kt = v % 32;
            tr_tile(Wot, 2048, nt * 64, kt * 64, [&](int k, int n) { return w_out[(size_t)k * 2048 + n]; }, tile, tidx);
        } else { const int v = u - T_IN - T_BR - T_OUT, nt = v / 8, kt = v % 8;
            tr_tile(Wuvt, 512, nt * 64, kt * 64, [&](int k, int n) { const int hh = n >> 7, vv = n & 127; const int c = k - (hh & 1) * 256; return (c >= 0 && c < 256) ? w_uv[((size_t)hh * 256 + c) * 128 + vv] : 0.f; }, tile, tidx);
        }
    }
}

DEV void ph_h(const Params& p, int l, int b, int wv) {
    TID_DECL
    const float* X = p.x + (size_t)b * TB * 2048; const half_t* XH = (const half_t*)(p.ws + OFF_X1H) + (size_t)b * TB * 2048;
    const float* g = p.pre_g + l * 2048;
    half_t* H = (half_t*)(p.ws + OFF_H); unsigned char* H8 = (unsigned char*)(p.ws + OFF_H8); float* HS = (float*)(p.ws + OFF_HS);
    const int lane = tidx & 63, wid = tidx >> 6;
    for (int t = bidx * NWAVE + wid; t < TB; t += nblk * NWAVE) {
        const float* xr = X + (size_t)t * 2048; f4 v[8]; float ss = 0.f;
#pragma unroll
        for (int i = 0; i < 8; ++i) { if (l == 0) v[i] = *(const f4*)(xr + i * 256 + lane * 4); else { const h4 xh = *(const h4*)(XH + (size_t)t * 2048 + i * 256 + lane * 4); v[i] = (f4){(float)xh[0], (float)xh[1], (float)xh[2], (float)xh[3]}; }
            ss += v[i][0] * v[i][0] + v[i][1] * v[i][1] + v[i][2] * v[i][2] + v[i][3] * v[i][3]; }
        ss = wave_sum(lane, ss); const float rs = rsqrtf(ss * (1.f / 2048.f) + NORM_EPS);
#pragma unroll
        for (int i = 0; i < 8; ++i) { const f4 gg = *(const f4*)(g + i * 256 + lane * 4); v[i] = v[i] * rs * gg; *(h4*)(H + (size_t)t * 2048 + i * 256 + lane * 4) = toh4(v[i]); }
        float mx = 0.f;
#pragma unroll
        for (int i = 0; i < 8; ++i) mx = fmaxf(fmaxf(mx, fmaxf(fabsf(v[i][0]), fabsf(v[i][1]))), fmaxf(fabsf(v[i][2]), fabsf(v[i][3])));
#pragma unroll
        for (int o = 32; o >= 1; o >>= 1) mx = fmaxf(mx, shx(lane, mx, o));
        const float inv = mx > 0.f ? 127.f / mx : 0.f;
#pragma unroll
        for (int i = 0; i < 8; ++i) { unsigned w = 0u;
#pragma unroll
            for (int e = 0; e < 4; ++e) w |= ((unsigned)(int)__builtin_rintf(v[i][e] * inv) & 255u) << (8 * e);
            *(unsigned*)(H8 + (size_t)t * 2048 + i * 256 + lane * 4) = w; }
        if (lane == 0) HS[t] = mx * (1.f / 127.f);
    }
}

template <class Epi> DEV void gemm_simple(const half_t* A, int lda, const half_t* Bt, int ldb, int M, int N, int K, int a_koff, const Epi& E, int wv) {
    TID_DECL
    const int lane = tidx & 63, wid = tidx >> 6, r = lane & 15, g = lane >> 4, wm = wid & 1, wn = wid >> 1;
    const int nM = M / 128, nN = N / 256;
    for (int u = bidx; u < nM * nN; u += nblk) {
        const int pn = u / nM, pm = u % nM; const int m0 = pm * 128 + wm * 64, n0 = pn * 256 + wn * 64;
        const half_t* Ab = A + (size_t)(m0 + r) * lda + (size_t)pn * a_koff + 8 * g;
        const half_t* Bb = Bt + (size_t)(n0 + r) * ldb + 8 * g;
        f4 acc[4][4];
#pragma unroll
        for (int i = 0; i < 4; ++i)
#pragma unroll
            for (int j = 0; j < 4; ++j) acc[i][j] = (f4){0.f, 0.f, 0.f, 0.f};
        for (int k0 = 0; k0 < K; k0 += 32) {
            h8 a[4], bb[4];
#pragma unroll
            for (int i = 0; i < 4; ++i) { a[i] = *(const h8*)(Ab + (size_t)i * 16 * lda + k0); bb[i] = *(const h8*)(Bb + (size_t)i * 16 * ldb + k0); }
#pragma unroll
            for (int i = 0; i < 4; ++i)
#pragma unroll
                for (int j = 0; j < 4; ++j) acc[i][j] = MFMA16(bb[j], a[i], acc[i][j]);
        }
#pragma unroll
        for (int i = 0; i < 4; ++i)
#pragma unroll
            for (int j = 0; j < 4; ++j) E.store4(m0 + 16 * i + r, n0 + 16 * j + 4 * g, acc[i][j]);
    }
}

struct EpiIn {
    char* ws; int pn_base;
    static constexpr bool HAS_TILE = true;
    template <int SEG> DEV void st(int row, int c, f4 v) const {
        if constexpr (SEG == 0) *(h4*)((half_t*)(ws + OFF_QA) + (size_t)row * 1024 + c) = toh4(v * (0.125f * LOG2E));
        else if constexpr (SEG == 1) *(h4*)((half_t*)(ws + OFF_KA) + (size_t)row * 1024 + c) = toh4(v);
        else if constexpr (SEG == 2) *(h4*)((half_t*)(ws + OFF_VAT) + (size_t)row * 1024 + c) = toh4(v);
        else if constexpr (SEG == 3) *(h4*)((half_t*)(ws + OFF_ZA) + (size_t)row * 1024 + c) = toh4((f4){silu_f(v[0]), silu_f(v[1]), silu_f(v[2]), silu_f(v[3])});
        else if constexpr (SEG == 4) *(h4*)((half_t*)(ws + OFF_MQKR) + (size_t)row * 1024 + c) = toh4(v);
        else if constexpr (SEG == 5) { half_t* d = (half_t*)(ws + OFF_MVT) + (size_t)c * TB + row;
#pragma unroll
            for (int e = 0; e < 4; ++e) d[(size_t)e * TB] = (half_t)v[e]; }
        else if constexpr (SEG == 6) *(h4*)((half_t*)(ws + OFF_MO) + (size_t)row * 1024 + c) = toh4((f4){sigm_f(v[0]), sigm_f(v[1]), sigm_f(v[2]), sigm_f(v[3])});
        else if constexpr (SEG == 7) *(h4*)((half_t*)(ws + OFF_MZ) + (size_t)row * 1024 + c) = toh4((f4){silu_f(v[0]), silu_f(v[1]), silu_f(v[2]), silu_f(v[3])});
        else if constexpr (SEG == 8) *(h4*)((half_t*)(ws + OFF_DQ) + (size_t)row * 2048 + c) = toh4(v * (0.0625f * LOG2E));
        else if constexpr (SEG == 9) *(f4*)((float*)(ws + OFF_CKV) + (size_t)row * 256 + c) = v;
        else if constexpr (SEG == 10) *(h4*)((half_t*)(ws + OFF_IQ) + (size_t)row * 1024 + c) = toh4(v);
        else if constexpr (SEG == 11) { if (c < 96) *(f4*)((float*)(ws + OFF_SM) + (size_t)row * 96 + c) = v; }
        else if constexpr (SEG == 12) *(h4*)((half_t*)(ws + OFF_DZ) + (size_t)row * 1024 + c) = toh4((f4){silu_f(v[0]), silu_f(v[1]), silu_f(v[2]), silu_f(v[3])});
        else *(h4*)((half_t*)(ws + OFF_G) + (size_t)row * 6144 + c) = toh4((f4){sigm_f(v[0]), sigm_f(v[1]), sigm_f(v[2]), sigm_f(v[3])});
    }
    DEV static h8 pack8(f4 a, f4 b) { return (h8){(half_t)a[0], (half_t)a[1], (half_t)a[2], (half_t)a[3], (half_t)b[0], (half_t)b[1], (half_t)b[2], (half_t)b[3]}; }
    DEV static f4 silu4(f4 v) { return (f4){silu_f(v[0]), silu_f(v[1]), silu_f(v[2]), silu_f(v[3])}; }
    DEV static f4 sigm4(f4 v) { return (f4){sigm_f(v[0]), sigm_f(v[1]), sigm_f(v[2]), sigm_f(v[3])}; }
    template <int SEG> DEV void st8(int row, int c, f4 a, f4 b) const {
        if constexpr (SEG == 0) __builtin_nontemporal_store(pack8(a * (0.125f * LOG2E), b * (0.125f * LOG2E)), (h8*)((half_t*)(ws + OFF_QA) + (size_t)row * 1024 + c));
        else if constexpr (SEG == 1) __builtin_nontemporal_store(pack8(a, b), (h8*)((half_t*)(ws + OFF_KA) + (size_t)row * 1024 + c));
        else if constexpr (SEG == 2) __builtin_nontemporal_store(pack8(a, b), (h8*)((half_t*)(ws + OFF_VAT) + (size_t)row * 1024 + c));
        else if constexpr (SEG == 3) __builtin_nontemporal_store(pack8(silu4(a), silu4(b)), (h8*)((half_t*)(ws + OFF_ZA) + (size_t)row * 1024 + c));
        else if constexpr (SEG == 4) __builtin_nontemporal_store(pack8(a, b), (h8*)((half_t*)(ws + OFF_MQKR) + (size_t)row * 1024 + c));
        else if constexpr (SEG == 5) __builtin_nontemporal_store(pack8(a, b), (h8*)((half_t*)(ws + OFF_MVT) + (size_t)row * 1024 + c));
        else if constexpr (SEG == 6) __builtin_nontemporal_store(pack8(sigm4(a), sigm4(b)), (h8*)((half_t*)(ws + OFF_MO) + (size_t)row * 1024 + c));
        else if constexpr (SEG == 7) __builtin_nontemporal_store(pack8(silu4(a), silu4(b)), (h8*)((half_t*)(ws + OFF_MZ) + (size_t)row * 1024 + c));
        else if constexpr (SEG == 8) __builtin_nontemporal_store(pack8(a * (0.0625f * LOG2E), b * (0.0625f * LOG2E)), (h8*)((half_t*)(ws + OFF_DQ) + (size_t)row * 2048 + c));
        else if constexpr (SEG == 10) __builtin_nontemporal_store(pack8(a, b), (h8*)((half_t*)(ws + OFF_IQ) + (size_t)row * 1024 + c));
        else if constexpr (SEG == 12) __builtin_nontemporal_store(pack8(silu4(a), silu4(b)), (h8*)((half_t*)(ws + OFF_DZ) + (size_t)row * 1024 + c));
        else if constexpr (SEG == 13) { const f4 sa = sigm4(a) * 255.f, sb = sigm4(b) * 255.f; typedef unsigned u32x2_t __attribute__((ext_vector_type(2)));
            unsigned w0 = 0u, w1 = 0u;
            w0 = __builtin_amdgcn_cvt_pk_u8_f32(sa[0], 0, w0); w0 = __builtin_amdgcn_cvt_pk_u8_f32(sa[1], 1, w0); w0 = __builtin_amdgcn_cvt_pk_u8_f32(sa[2], 2, w0); w0 = __builtin_amdgcn_cvt_pk_u8_f32(sa[3], 3, w0);
            w1 = __builtin_amdgcn_cvt_pk_u8_f32(sb[0], 0, w1); w1 = __builtin_amdgcn_cvt_pk_u8_f32(sb[1], 1, w1); w1 = __builtin_amdgcn_cvt_pk_u8_f32(sb[2], 2, w1); w1 = __builtin_amdgcn_cvt_pk_u8_f32(sb[3], 3, w1);
            __builtin_nontemporal_store((u32x2_t){w0, w1}, (u32x2_t*)((unsigned char*)(ws + OFF_G) + (size_t)row * 6144 + c)); }
        else { st<SEG>(row, c, a); st<SEG>(row, c + 4, b); }
    }
    template <int SEG> DEV void run(const f4 (&acc)[2][2][4][2], int row0, int c0) const {
#pragma unroll
        for (int ai = 0; ai < 2; ++ai)
#pragma unroll
            for (int m = 0; m < 4; ++m) { const int row = row0 + ai * 128 + m * 16;
                st8<SEG>(row, c0, acc[ai][0][m][0], acc[ai][0][m][1]); st8<SEG>(row, c0 + 128, acc[ai][1][m][0], acc[ai][1][m][1]); }
    }
    DEV void tile(const f4 (&acc)[2][2][4][2], int pm, int pn, int wr, int wc, int fr, int fq) const {
        const int t = __builtin_amdgcn_readfirstlane(pn) + pn_base; const int row0 = pm * 256 + wr * 64 + fr, cw = wc * 32 + 8 * fq;
        if (t < 4) run<0>(acc, row0, t * 256 + cw); else if (t < 8) run<1>(acc, row0, (t - 4) * 256 + cw); else if (t < 9) run<9>(acc, row0, cw);
        else if (t < 13) run<10>(acc, row0, (t - 9) * 256 + cw); else if (t < 14) run<11>(acc, row0, cw); else run<8>(acc, row0, (t - 14) * 256 + cw);
    }
};
struct EpiIn8 {
    char* ws; int pn_base;
    static constexpr bool HAS_TILE = true;
    DEV static f4 cvt(const f4& a, const f4& s) { return (f4){(float)__float_as_int(a[0]) * s[0], (float)__float_as_int(a[1]) * s[1], (float)__float_as_int(a[2]) * s[2], (float)__float_as_int(a[3]) * s[3]}; }
    template <int SEG> DEV void run(const f4 (&acc)[2][2][4][2], int row0, int c0, int cg) const {
        const EpiIn e{ws, 0}; const float* HS = (const float*)(ws + OFF_HS); const float* WS8 = (const float*)(ws + OFF_WS8);
        const f4 s00 = *(const f4*)(WS8 + cg), s01 = *(const f4*)(WS8 + cg + 4), s10 = *(const f4*)(WS8 + cg + 128), s11 = *(const f4*)(WS8 + cg + 132);
#pragma unroll
        for (int ai = 0; ai < 2; ++ai)
#pragma unroll
            for (int m = 0; m < 4; ++m) { const int row = row0 + ai * 128 + m * 16; const float hs = HS[row];
                e.template st8<SEG>(row, c0, cvt(acc[ai][0][m][0], s00 * hs), cvt(acc[ai][0][m][1], s01 * hs)); e.template st8<SEG>(row, c0 + 128, cvt(acc[ai][1][m][0], s10 * hs), cvt(acc[ai][1][m][1], s11 * hs)); }
    }
    DEV void tile(const f4 (&acc)[2][2][4][2], int pm, int pn, int wr, int wc, int fr, int fq) const {
        const int t = __builtin_amdgcn_readfirstlane(pn) + pn_base; const int row0 = pm * 256 + wr * 64 + fr, cw = wc * 32 + 8 * fq, cg = t * 256 + cw;
        if (t < 4) run<3>(acc, row0, t * 256 + cw, cg); else if (t < 8) run<6>(acc, row0, (t - 4) * 256 + cw, cg); else if (t < 12) run<7>(acc, row0, (t - 8) * 256 + cw, cg);
        else if (t < 16) run<12>(acc, row0, (t - 12) * 256 + cw, cg); else if (t < 20) run<2>(acc, row0, (t - 16) * 256 + cw, cg); else if (t < 24) run<5>(acc, row0, (t - 20) * 256 + cw, cg);
        else if (t < 28) run<4>(acc, row0, (t - 24) * 256 + cw, cg); else if (t < 52) run<13>(acc, row0, (t - 28) * 256 + cw, cg); else run<8>(acc, row0, (t - 50) * 256 + cw, cg);
    }
};
struct EpiMulH {
    static constexpr bool HAS_TILE = false;
    half_t* O; const half_t* Z; int ld;
    DEV void store8(int row, int col, f4 v0, f4 v1) const { const h8 z = *(const h8*)(Z + (size_t)row * ld + col);
        *(h8*)(O + (size_t)row * ld + col) = (h8){(half_t)(v0[0] * (float)z[0]), (half_t)(v0[1] * (float)z[1]), (half_t)(v0[2] * (float)z[2]), (half_t)(v0[3] * (float)z[3]),
                                                   (half_t)(v1[0] * (float)z[4]), (half_t)(v1[1] * (float)z[5]), (half_t)(v1[2] * (float)z[6]), (half_t)(v1[3] * (float)z[7])}; }
};
struct EpiGate {
    static constexpr bool HAS_TILE = false;
    half_t* MIXp; const unsigned char* G; int goff; bool first;
    DEV void store8(int row, int col, f4 v0, f4 v1) const { typedef unsigned u32x2_t __attribute__((ext_vector_type(2)));
        const u32x2_t gw = *(const u32x2_t*)(G + (size_t)row * 6144 + goff + col);
        float o[8];
#pragma unroll
        for (int e = 0; e < 4; ++e) { o[e] = v0[e] * ((float)((gw[0] >> (8 * e)) & 255u) * (1.f / 255.f)); o[4 + e] = v1[e] * ((float)((gw[1] >> (8 * e)) & 255u) * (1.f / 255.f)); }
        half_t* d = MIXp + (size_t)row * 2048 + col;
        if (!first) { const h8 pz = *(const h8*)d;
#pragma unroll
            for (int e = 0; e < 8; ++e) o[e] += (float)pz[e]; }
        h8 r8;
#pragma unroll
        for (int e = 0; e < 8; ++e) r8[e] = (half_t)o[e];
        *(h8*)d = r8; }
};
struct EpiOut {
    static constexpr bool HAS_TILE = false;
    half_t* O;
    DEV void store8(int row, int col, f4 v0, f4 v1) const {
        *(h8*)(O + (size_t)row * 2048 + col) = (h8){(half_t)v0[0], (half_t)v0[1], (half_t)v0[2], (half_t)v0[3], (half_t)v1[0], (half_t)v1[1], (half_t)v1[2], (half_t)v1[3]}; }
};

namespace pg8 {
#define PG8_LAS __attribute__((address_space(3)))
typedef unsigned short bf16_t;
typedef _Float16 bf16x8 __attribute__((ext_vector_type(8)));
typedef float f32x4 __attribute__((ext_vector_type(4)));
typedef unsigned u32x4 __attribute__((ext_vector_type(4)));
constexpr int BM = 256, BK = 64, HALF = 128, HTB = HALF * BK * 2  , STAGE_BYTES = 8 * HTB, NXCD = 8, WGM = 8;

__host__ __device__ __forceinline__ int lds_byte(int r, int c) { const int st = (r >> 4) * 2 + (c >> 5), rr = r & 15, cc = c & 31, ob = rr * 64 + cc * 2; return st * 1024 + (ob ^ (((ob >> 9) & 1) << 5)); }
__host__ __device__ __forceinline__ void stage_rc(int b, int& R, int& C) { const int st = b / 1024, sb = b % 1024, swz = sb ^ (((sb >> 9) & 1) << 5); R = (st >> 1) * 16 + swz / 64; C = (st & 1) * 32 + (swz % 64) / 2; }
__host__ __device__ __forceinline__ int perm32(int rho) { const int n = rho >> 4, i = rho & 15; return 8 * (i >> 2) + 4 * n + (i & 3); }

struct Unit { int pm, pn; };
struct Gemm { const bf16_t* A; const bf16_t* Bt; int M, N, K; int lda, a_koff; };

struct StaticOrder {
    int nM, nN, nwg, G, c;
    __host__ __device__ void init(int M, int N, int G_, int c_) { nM = M / BM; nN = N / BM; nwg = nM * nN; G = G_; c = c_; }
    __host__ __device__ bool next(int i, Unit& u) const {
        const long L = (long)i * G + c; if (L >= nwg) return false;
        int wgid = (int)L; { const int q = nwg / NXCD, r = nwg % NXCD, xcd = wgid % NXCD, off = wgid / NXCD; wgid = (xcd < r ? xcd * (q + 1) : r * (q + 1) + (xcd - r) * q) + off; }
        const int nig = WGM * nN, gid = wgid / nig, fm = gid * WGM, gsz = (nM - fm) < WGM ? (nM - fm) : WGM;
        u.pm = fm + ((wgid % nig) % gsz); u.pn = (wgid % nig) / gsz; return true;
    }
    __device__ __forceinline__ void a_ready(const Unit&) const {}
    __device__ __forceinline__ void done(const Unit&) const {}
};
typedef int i32x4 __attribute__((ext_vector_type(4)));
template <class Epi, class Sched, bool ALIGN_EPI = false, bool SP2 = false, bool I8 = false>
__device__ __forceinline__ void gemm_phase(PG8_LAS unsigned char* lds, const Gemm g, const Sched& S, const Epi& E, const int tid) {
    const int wid = __builtin_amdgcn_readfirstlane(tid >> 6), lane = tid & 63, wr = wid >> 2, wc = wid & 3, fr = lane & 15, fq = lane >> 4;
    const int K = g.K, nt = K / BK;
    unsigned voffA[2], voffB[2];
#pragma unroll
    for (int i = 0; i < 2; ++i) { int R, C; stage_rc(tid * 16 + i * 8192, R, C); const int Rb = Epi::PERM ? ((R & ~31) + perm32(R & 31)) : R;
        voffA[i] = (unsigned)(R * g.lda + C) * 2u; voffB[i] = (unsigned)(Rb * K + C) * 2u; }
    const size_t kstep = (size_t)(BK * 2);
    const size_t hstepA = (size_t)HALF * g.lda * 2, tstepA = 2 * hstepA, akoff = (size_t)g.a_koff * 2;
    const size_t hstep = (size_t)HALF * K * 2;
    const size_t tstep = 2 * hstep;
    const unsigned ldsw = (unsigned)wid * 1024u;
    const int aoff = lds_byte(wr * 64 + fr, fq * 8), boff = lds_byte(wc * 32 + fr, fq * 8);
#define PG8_SA(b, h) (((b) * 2 + (h)) * HTB)
#define PG8_SB(b, h) ((4 + (b) * 2 + (h)) * HTB)
#define PG8_STAGE(bufoff, gbase, voff) do { _Pragma("unroll") for (int _i = 0; _i < 2; ++_i) \
        __builtin_amdgcn_global_load_lds((const unsigned*)((const char*)(gbase) + (voff)[_i]), (PG8_LAS unsigned*)(lds + (bufoff) + ldsw + _i * 8192), 16, 0, 0); } while (0)
#define PG8_LDA(dst, b, h) do { _Pragma("unroll") for (int m = 0; m < 4; ++m) _Pragma("unroll") for (int k = 0; k < 2; ++k) dst[m][k] = *(const PG8_LAS bf16x8*)(lds + PG8_SA(b, h) + aoff + m * 2048 + k * 1024); } while (0)
#define PG8_LDB(dst, b, h) do { _Pragma("unroll") for (int n = 0; n < 2; ++n) _Pragma("unroll") for (int k = 0; k < 2; ++k) dst[n][k] = *(const PG8_LAS bf16x8*)(lds + PG8_SB(b, h) + boff + n * 2048 + k * 1024); } while (0)
#define PG8_MMA(ai, bj, At, Bt) do { __builtin_amdgcn_s_setprio(1); _Pragma("unroll") for (int m = 0; m < 4; ++m) _Pragma("unroll") for (int n = 0; n < 2; ++n) _Pragma("unroll") for (int k = 0; k < 2; ++k) \
        { if constexpr (I8) acc[ai][bj][m][n] = __builtin_bit_cast(f32x4, __builtin_amdgcn_mfma_i32_16x16x64_i8(__builtin_bit_cast(i32x4, Bt[n][k]), __builtin_bit_cast(i32x4, At[m][k]), __builtin_bit_cast(i32x4, acc[ai][bj][m][n]), 0, 0, 0)); \
          else acc[ai][bj][m][n] = __builtin_amdgcn_mfma_f32_16x16x32_f16(Bt[n][k], At[m][k], acc[ai][bj][m][n], 0, 0, 0); } __builtin_amdgcn_s_setprio(0); } while (0)
#define PG8_WAIT_V(n) asm volatile("s_waitcnt vmcnt(" #n ")" ::: "memory")
#define PG8_WAIT_L(n) asm volatile("s_waitcnt lgkmcnt(" #n ")" ::: "memory")
#define PG8_BAR __builtin_amdgcn_s_barrier()
#define PG8_SCHED __builtin_amdgcn_sched_barrier(0)
    Unit cur, nxt; int ui = 0;
    if (!S.next(0, cur)) return;
    f32x4 acc[2][2][4][2];
#pragma unroll
    for (int a = 0; a < 2; ++a)
#pragma unroll
        for (int b = 0; b < 2; ++b)
#pragma unroll
            for (int m = 0; m < 4; ++m)
#pragma unroll
                for (int n = 0; n < 2; ++n) acc[a][b][m][n] = (f32x4){0.f, 0.f, 0.f, 0.f};
    bf16x8 At[4][2], B0[2][2], B1[2][2];
    const char* cA = (const char*)g.A + (size_t)cur.pm * tstepA + (size_t)cur.pn * akoff; const char* cB = (const char*)g.Bt + (size_t)cur.pn * tstep;
    S.a_ready(cur);
    if constexpr (SP2) {
        PG8_STAGE(PG8_SB(0, 0), cB, voffB); PG8_STAGE(PG8_SB(0, 1), cB + hstep, voffB); PG8_STAGE(PG8_SA(0, 0), cA, voffA); PG8_STAGE(PG8_SA(0, 1), cA + hstepA, voffA);
        if (wr == 1) PG8_BAR;
        PG8_WAIT_V(2); PG8_BAR;
        PG8_STAGE(PG8_SB(1, 0), cB + kstep, voffB); PG8_STAGE(PG8_SA(1, 0), cA + kstep, voffA); PG8_STAGE(PG8_SB(1, 1), cB + hstep + kstep, voffB);
        PG8_WAIT_V(6); PG8_BAR;
    } else {
        PG8_STAGE(PG8_SB(0, 0), cB, voffB); PG8_STAGE(PG8_SA(0, 0), cA, voffA); PG8_STAGE(PG8_SB(0, 1), cB + hstep, voffB); PG8_STAGE(PG8_SA(0, 1), cA + hstepA, voffA);
        if (wr == 1) PG8_BAR;
        PG8_WAIT_V(4); PG8_BAR;
        PG8_STAGE(PG8_SB(1, 0), cB + kstep, voffB); PG8_STAGE(PG8_SA(1, 0), cA + kstep, voffA); PG8_STAGE(PG8_SB(1, 1), cB + hstep + kstep, voffB);
        PG8_WAIT_V(6); PG8_BAR;
    }
    for (;;) {
        const bool has_next = S.next(ui + 1, nxt);
        const char* nA = has_next ? (const char*)g.A + (size_t)nxt.pm * tstepA + (size_t)nxt.pn * akoff : cA; const char* nB = has_next ? (const char*)g.Bt + (size_t)nxt.pn * tstep : cB;
        for (int t = 0; t < nt; t += 2) {
            const bool last = (t == nt - 2);
            const char* a1 = cA + (size_t)(t + 1) * kstep;
            const char* a2 = last ? nA : cA + (size_t)(t + 2) * kstep; const char* b2 = last ? nB : cB + (size_t)(t + 2) * kstep;
            const char* a3 = a2 + kstep; const char* b3 = b2 + kstep;
            if (last && has_next) S.a_ready(nxt);
            if constexpr (SP2) {
            PG8_LDB(B0, 0, 0); PG8_LDB(B1, 0, 1); PG8_SCHED; PG8_LDA(At, 0, 0); PG8_STAGE(PG8_SA(1, 1), a1 + hstepA, voffA);
            PG8_WAIT_V(8); PG8_WAIT_L(0); PG8_BAR; PG8_MMA(0, 0, At, B0); PG8_MMA(0, 1, At, B1); PG8_BAR; PG8_SCHED;
            PG8_LDA(At, 0, 1); PG8_STAGE(PG8_SB(0, 0), b2, voffB); PG8_STAGE(PG8_SB(0, 1), b2 + hstep, voffB); PG8_STAGE(PG8_SA(0, 0), a2, voffA);
            PG8_WAIT_V(8); PG8_WAIT_L(0); PG8_BAR; PG8_MMA(1, 0, At, B0); PG8_MMA(1, 1, At, B1); PG8_BAR; PG8_SCHED;
            PG8_LDB(B0, 1, 0); PG8_LDB(B1, 1, 1); PG8_SCHED; PG8_LDA(At, 1, 0); PG8_STAGE(PG8_SA(0, 1), a2 + hstepA, voffA);
            PG8_WAIT_V(8); PG8_WAIT_L(0); PG8_BAR; PG8_MMA(0, 0, At, B0); PG8_MMA(0, 1, At, B1); PG8_BAR; PG8_SCHED;
            PG8_LDA(At, 1, 1); PG8_STAGE(PG8_SB(1, 0), b3, voffB); PG8_STAGE(PG8_SB(1, 1), b3 + hstep, voffB); PG8_STAGE(PG8_SA(1, 0), a3, voffA);
            PG8_WAIT_V(8); PG8_WAIT_L(0); PG8_BAR; PG8_MMA(1, 0, At, B0); PG8_MMA(1, 1, At, B1); PG8_BAR; PG8_SCHED;
            } else {
            PG8_LDB(B0, 0, 0); PG8_SCHED; PG8_LDA(At, 0, 0); PG8_STAGE(PG8_SA(1, 1), a1 + hstepA, voffA);
            PG8_WAIT_L(8); PG8_BAR; PG8_WAIT_L(0); PG8_MMA(0, 0, At, B0); PG8_BAR; PG8_SCHED;
            PG8_LDB(B1, 0, 1); PG8_STAGE(PG8_SB(0, 0), b2, voffB);
            PG8_BAR; PG8_WAIT_L(0); PG8_MMA(0, 1, At, B1); PG8_BAR;
            PG8_LDA(At, 0, 1); PG8_STAGE(PG8_SA(0, 0), a2, voffA);
            PG8_BAR; PG8_WAIT_L(0); PG8_MMA(1, 0, At, B0); PG8_BAR; PG8_SCHED;
            PG8_STAGE(PG8_SB(0, 1), b2 + hstep, voffB);
            PG8_WAIT_V(6); PG8_BAR; PG8_MMA(1, 1, At, B1); PG8_BAR;
            PG8_LDB(B0, 1, 0); PG8_SCHED; PG8_LDA(At, 1, 0); PG8_STAGE(PG8_SA(0, 1), a2 + hstepA, voffA);
            PG8_WAIT_L(8); PG8_BAR; PG8_WAIT_L(0); PG8_MMA(0, 0, At, B0); PG8_BAR; PG8_SCHED;
            PG8_LDB(B1, 1, 1); PG8_STAGE(PG8_SB(1, 0), b3, voffB);
            PG8_BAR; PG8_WAIT_L(0); PG8_MMA(0, 1, At, B1); PG8_BAR;
            PG8_LDA(At, 1, 1); PG8_STAGE(PG8_SA(1, 0), a3, voffA);
            PG8_BAR; PG8_WAIT_L(0); PG8_MMA(1, 0, At, B0); PG8_BAR; PG8_SCHED;
            PG8_STAGE(PG8_SB(1, 1), b3 + hstep, voffB);
            PG8_WAIT_V(6); PG8_BAR; PG8_MMA(1, 1, At, B1); PG8_BAR;
            }
        }
        if constexpr (ALIGN_EPI) { if (wr == 0) PG8_BAR; }
        if constexpr (!Epi::AFTER_DRAIN) { E(acc, cur, wr, wc, fr, fq); S.done(cur); }
        if (!has_next) break;
#pragma unroll
        for (int a = 0; a < 2; ++a)
#pragma unroll
            for (int b = 0; b < 2; ++b)
#pragma unroll
                for (int m = 0; m < 4; ++m)
#pragma unroll
                    for (int n = 0; n < 2; ++n) acc[a][b][m][n] = (f32x4){0.f, 0.f, 0.f, 0.f};
        cur = nxt; cA = nA; cB = nB; ++ui;
        if constexpr (ALIGN_EPI) { if (wr == 1) PG8_BAR; }
    }
    PG8_WAIT_V(0);
    if constexpr (!ALIGN_EPI) { if (wr == 0) PG8_BAR; }
    PG8_BAR;
    if constexpr (Epi::AFTER_DRAIN) { E.fused(acc, cur, wr, wc, fr, fq, lds, wid, lane); S.done(cur); }
#undef PG8_SA
#undef PG8_SB
#undef PG8_STAGE
#undef PG8_LDA
#undef PG8_LDB
#undef PG8_MMA
#undef PG8_WAIT_V
#undef PG8_WAIT_L
#undef PG8_BAR
#undef PG8_SCHED
}
}

template <class E4> struct EpiAdapt { static constexpr bool PERM = true, AFTER_DRAIN = false; E4 e;
    DEV void rowgrp(int row, int col, const pg8::f32x4& a00, const pg8::f32x4& a01, const pg8::f32x4& a10, const pg8::f32x4& a11) const {
        e.store8(row, col, a00, a01); e.store8(row, col + 128, a10, a11); }
    DEV void operator()(const pg8::f32x4 (&acc)[2][2][4][2], const pg8::Unit& u, int wr, int wc, int fr, int fq) const {
        if constexpr (E4::HAS_TILE) { e.tile(acc, u.pm, u.pn, wr, wc, fr, fq); }
        else {
        const int row0 = u.pm * 256 + wr * 64 + fr, col0 = u.pn * 256 + wc * 32 + 8 * fq;
#define EA_RG(ai, m) rowgrp(row0 + (ai) * 128 + (m) * 16, col0, acc[ai][0][m][0], acc[ai][0][m][1], acc[ai][1][m][0], acc[ai][1][m][1])
        EA_RG(0, 0); EA_RG(0, 1); EA_RG(0, 2); EA_RG(0, 3); EA_RG(1, 0); EA_RG(1, 1); EA_RG(1, 2); EA_RG(1, 3);
#undef EA_RG
        }
    }
};
template <class E4, bool I8 = false> DEV void gemm8(const half_t* A, const half_t* Bt, int M, int N, int K, const E4& e, LAS char* lds, int wv, int lda = 0, int a_koff = 0) {
    TID_DECL
    const pg8::Gemm g{(const pg8::bf16_t*)A, (const pg8::bf16_t*)Bt, M, N, K, lda ? lda : K, a_koff};
    pg8::StaticOrder S; S.init(M, N, nblk, bidx);
    const EpiAdapt<E4> E{e};
    pg8::gemm_phase<EpiAdapt<E4>, pg8::StaticOrder, true, true, I8>((LAS unsigned char*)lds, g, S, E, tidx);
}

DEV void ph_post(const Params& p, int l, int wv) {
    TID_DECL
    char* ws = p.ws; const int lane = tidx & 63, wid = tidx >> 6;
    const float* CKV = (const float*)(ws + OFF_CKV); const float* SM = (const float*)(ws + OFF_SM);
    half_t* C = (half_t*)(ws + OFF_C); half_t* IK = (half_t*)(ws + OFF_IK); float* IW = (float*)(ws + OFF_IW); float* MG = (float*)(ws + OFF_MG);
    const half_t* MQKR = (const half_t*)(ws + OFF_MQKR); half_t* MQKC = (half_t*)(ws + OFF_MQKC);
    const float* kvg = p.kv_norm_g + l * 256; const float* ikg = p.ik_norm_g + l * 64; const float* gb = p.ml_gate_b + l * 8;
    const float* cw = p.ml_conv_w + (size_t)l * 4 * 1024; const float* cb = p.ml_conv_b + l * 1024;
    for (int t = bidx * NWAVE + wid; t < TB; t += nblk * NWAVE) {
        { const f4 v = *(const f4*)(CKV + (size_t)t * 256 + lane * 4); float ss = wave_sum(lane, v[0] * v[0] + v[1] * v[1] + v[2] * v[2] + v[3] * v[3]);
          const float rs = rsqrtf(ss * (1.f / 256.f) + NORM_EPS); const f4 gg = *(const f4*)(kvg + lane * 4); *(h4*)(C + (size_t)t * 256 + lane * 4) = toh4(v * rs * gg); }
        { f4 v = (f4){0.f, 0.f, 0.f, 0.f}; if (lane < 24) v = *(const f4*)(SM + (size_t)t * 96 + lane * 4);
          float ss = (lane < 16) ? (v[0] * v[0] + v[1] * v[1] + v[2] * v[2] + v[3] * v[3]) : 0.f; ss = wave_sum(lane, ss);
          const float rs = rsqrtf(ss * (1.f / 64.f) + NORM_EPS);
          if (lane < 16) { const f4 gg = *(const f4*)(ikg + lane * 4);
              *(h4*)(IK + ((((size_t)(t >> 5) * 4 + (lane >> 2)) * 2 + ((lane >> 1) & 1)) * 32 + (t & 31)) * 8 + (lane & 1) * 4) = toh4(v * rs * gg); }
          else if (lane < 20) { *(f4*)(IW + (size_t)t * 16 + (lane - 16) * 4) = v * (1.f / 32.f); }
          else if (lane == 20) { const f4 bb = *(const f4*)(gb); *(f4*)(MG + (size_t)t * 8) = v + bb; }
          else if (lane == 21) { const f4 bb = *(const f4*)(gb + 4); f4 o;
#pragma unroll
              for (int e = 0; e < 4; ++e) { const float xg = v[e] + bb[e]; o[e] = fminf(xg, 0.f) - log1pf(__expf(-fabsf(xg))); }
              *(f4*)(MG + (size_t)t * 8 + 4) = o; }
        }
        { const int c0 = lane * 16; float acc[16];
#pragma unroll
          for (int e = 0; e < 16; ++e) acc[e] = cb[c0 + e];
#pragma unroll
          for (int j = 0; j < 4; ++j) { const int tt = t - 3 + j; if (tt >= 0) {
              const h8 x0 = *(const h8*)(MQKR + (size_t)tt * 1024 + c0), x1 = *(const h8*)(MQKR + (size_t)tt * 1024 + c0 + 8);
#pragma unroll
              for (int e = 0; e < 8; ++e) { acc[e] += cw[j * 1024 + c0 + e] * (float)x0[e]; acc[8 + e] += cw[j * 1024 + c0 + 8 + e] * (float)x1[e]; } } }
          const float sc = (c0 >= 512) ? 0.08838834764831845f : 1.f; h8 o0, o1;
#pragma unroll
          for (int e = 0; e < 8; ++e) { o0[e] = (half_t)(silu_f(acc[e]) * sc); o1[e] = (half_t)(silu_f(acc[8 + e]) * sc); }
          *(h8*)(MQKC + (size_t)t * 1024 + c0) = o0; *(h8*)(MQKC + (size_t)t * 1024 + c0 + 8) = o1;
        }
    }
}

namespace attn_body {
using bf16=_Float16;
using bf16x8=__attribute__((ext_vector_type(8)))short;
using s16x4=__attribute__((ext_vector_type(4)))short;
using f32x16=__attribute__((ext_vector_type(16)))float;
using u32x4=__attribute__((ext_vector_type(4)))unsigned;
using h8v=__attribute__((ext_vector_type(8)))_Float16;
#define MFMA_H(a,b,c,x,y,z) __builtin_amdgcn_mfma_f32_32x32x16_f16(__builtin_bit_cast(h8v,(a)),__builtin_bit_cast(h8v,(b)),(c),x,y,z)
constexpr int BATCH=1,NHEAD=16,SEQ=16384,D=64,DM=NHEAD*D;
constexpr int NW=8,QBLK=32,QB=QBLK*NW,KVBLK=64,NQB=SEQ/QB;
constexpr int ATTN_PITCH=DM, ATTN_UNIT_ROWS=QB;
__device__ __forceinline__ int crow(int r,int hi){return (r&3)+8*(r>>2)+4*hi;}
#define SBAR() __builtin_amdgcn_sched_barrier(0)
__device__ __forceinline__ void cmask(f32x16&p0,f32x16&p1,int jb,int qrel_in,int hi){
  const float NEG=-INFINITY; int kb=64*jb+4*hi, qrel=qrel_in; asm volatile("":"+v"(kb),"+v"(qrel));
  #pragma unroll
  for(int r=0;r<16;++r){int kv=kb+(r&3)+8*(r>>2); if(kv>qrel)p0[r]=NEG; if(kv+32>qrel)p1[r]=NEG;}
}

constexpr int NSLOT=3, SLOTB=8192;
constexpr int LDS_K=0, LDS_V=NSLOT*SLOTB, LDS_WS=2*NSLOT*SLOTB, LDS_OST=LDS_WS+NW*64*4, LDS_BYTES=LDS_OST+NW*4096;
constexpr float C2=0.125f*1.4426950408889634f;
__device__ __forceinline__ void glds16(const void*gsrc,unsigned lds_dst){unsigned keep;
  asm volatile("s_mov_b32 %0, m0\n\ts_mov_b32 m0, %2\n\ts_nop 0\n\tglobal_load_lds_dwordx4 %1, off\n\ts_mov_b32 m0, %0":"=&s"(keep):"v"(gsrc),"s"(lds_dst):"memory");}
__device__ __forceinline__ float max3f(float a,float b,float c){float r;asm("v_max3_f32 %0, %1, %2, %3":"=v"(r):"v"(a),"v"(b),"v"(c));return r;}
__device__ __forceinline__ float max2f(float a,float b){float r;asm("v_max_f32_e32 %0, %1, %2":"=v"(r):"v"(a),"v"(b));return r;}
__device__ __forceinline__ float fadd_s(float a,float b){float r;asm("v_add_f32_e32 %0, %1, %2":"=v"(r):"v"(a),"v"(b));return r;}
__device__ __forceinline__ float fsub_s(float a,float b){float r;asm("v_sub_f32_e32 %0, %1, %2":"=v"(r):"v"(a),"v"(b));return r;}
typedef float f32x2_t __attribute__((ext_vector_type(2))); typedef _Float16 bf16x2_t __attribute__((ext_vector_type(2)));
__device__ __forceinline__ unsigned cvtpk_s(float lo,float hi){f32x2_t v={lo,hi};bf16x2_t b=__builtin_convertvector(v,bf16x2_t);return __builtin_bit_cast(unsigned,b);}
#define WAIT_BAR(N) asm volatile("s_waitcnt vmcnt(" #N ") lgkmcnt(0)\n\ts_barrier":::"memory")

__device__ __forceinline__ void qkt(f32x16&p0,f32x16&p1,const char*Kslot,const bf16x8*qr,const f32x16&negm,int r32,int hi){
  const char*kb=Kslot+hi*1024+r32*16;
  #pragma unroll
  for(int d0=0;d0<4;++d0){
    const bf16x8 b0=*reinterpret_cast<const bf16x8*>(kb+d0*2048);
    const bf16x8 b1=*reinterpret_cast<const bf16x8*>(kb+d0*2048+512);
    if(d0==0){p0=MFMA_H(b0,qr[0],negm,0,0,0);p1=MFMA_H(b1,qr[0],negm,0,0,0);}
    else{p0=MFMA_H(b0,qr[d0],p0,0,0,0);p1=MFMA_H(b1,qr[d0],p1,0,0,0);}}
}
typedef __attribute__((address_space(3))) const char* lds_cptr;
typedef short v4i16_t __attribute__((ext_vector_type(4)));
__device__ __forceinline__ void kload8(bf16x8*kf,lds_cptr kp){
  kf[0]=*(const __attribute__((address_space(3))) bf16x8*)(kp);      kf[1]=*(const __attribute__((address_space(3))) bf16x8*)(kp+512);
  kf[2]=*(const __attribute__((address_space(3))) bf16x8*)(kp+2048); kf[3]=*(const __attribute__((address_space(3))) bf16x8*)(kp+2560);
  kf[4]=*(const __attribute__((address_space(3))) bf16x8*)(kp+4096); kf[5]=*(const __attribute__((address_space(3))) bf16x8*)(kp+4608);
  kf[6]=*(const __attribute__((address_space(3))) bf16x8*)(kp+6144); kf[7]=*(const __attribute__((address_space(3))) bf16x8*)(kp+6656);
}
__device__ __forceinline__ void kload2(bf16x8*kf,lds_cptr kp,int j){ kf[2*j]=*(const __attribute__((address_space(3))) bf16x8*)(kp+j*2048); kf[2*j+1]=*(const __attribute__((address_space(3))) bf16x8*)(kp+j*2048+512); }
__device__ __forceinline__ s16x4 vtr(lds_cptr p){ return __builtin_bit_cast(s16x4,__builtin_amdgcn_ds_read_tr16_b64_v4i16((__attribute__((address_space(3))) v4i16_t*)p)); }
__device__ __forceinline__ float rowmax(const f32x16&p0,const f32x16&p1){
  float a=max3f(p0[0],p0[1],p1[0]),b=max3f(p0[2],p0[3],p1[1]);a=max3f(a,p1[2],p1[3]);
  #pragma unroll
  for(int r=4;r<16;r+=4){a=max3f(a,p0[r],p0[r+1]);b=max3f(b,p0[r+2],p0[r+3]);a=max3f(a,p1[r],p1[r+1]);b=max3f(b,p1[r+2],p1[r+3]);}
  const float m=max2f(a,b);
  auto rr=__builtin_amdgcn_permlane32_swap(__float_as_uint(m),__float_as_uint(m),false,false);
  return max2f(__uint_as_float(rr[0]),__uint_as_float(rr[1]));
}
__device__ __forceinline__ void pv(f32x16*o,int vb,bf16x8 pa0,bf16x8 pa1,bf16x8 pa2,bf16x8 pa3){
  #pragma unroll
  for(int d0=0;d0<2;++d0){s16x4 lo[4],hi[4];
    #pragma unroll
    for(int ks=0;ks<4;++ks){
      asm volatile("ds_read_b64_tr_b16 %0,%1 offset:%c2":"=&v"(lo[ks]):"v"(vb),"i"(d0*4096+ks*1024):"memory");
      asm volatile("ds_read_b64_tr_b16 %0,%1 offset:%c2":"=&v"(hi[ks]):"v"(vb),"i"(d0*4096+ks*1024+512):"memory");}
    asm volatile("s_waitcnt lgkmcnt(0)":::"memory");SBAR();
    #define PK(k) (bf16x8){lo[k][0],lo[k][1],lo[k][2],lo[k][3],hi[k][0],hi[k][1],hi[k][2],hi[k][3]}
    o[d0]=MFMA_H(pa0,PK(0),o[d0],0,0,0);
    o[d0]=MFMA_H(pa1,PK(1),o[d0],0,0,0);
    o[d0]=MFMA_H(pa2,PK(2),o[d0],0,0,0);
    o[d0]=MFMA_H(pa3,PK(3),o[d0],0,0,0);
    #undef PK
  }
}

#ifndef ATTN_STORE16
#define ATTN_STORE16(p,v) (*(u32x4*)(p)=(v))
#endif
template<int THRL> __device__ __forceinline__ void attn_unit(int b,int h,int qb,const bf16*Q,const bf16*__restrict__ K,const bf16*__restrict__ V,bf16*O,char*shm,const int wv_in,const int vhalf){
  int tid=(wv_in<<6)|lane_id_v();
  const int lane=tid&63,r32=lane&31,hi=lane>>5; const int wid=__builtin_amdgcn_readfirstlane(tid>>6);
  const long rowbase=(long)b*SEQ; const int q0=qb*QB;
  const bf16*Qw=Q+(rowbase+q0+wid*QBLK)*DM+h*D;
  const bf16*Kh=K+rowbase*DM+h*D,*Vh=V+rowbase*DM+(h>>1)*128+vhalf*64;
  const unsigned lds0=(unsigned)(uintptr_t)shm;
  float*wsf=(float*)(shm+LDS_WS)+wid*64;
  const bf16*ksrc=Kh+(long)lane*DM+wid*8;
  const bf16*vsrc=Vh+(long)(16*(wid&3)+(lane>>2))*DM+(wid>>2)*32+(lane&3)*8;
  const unsigned kdst=lds0+LDS_K+wid*1024, vdst=lds0+LDS_V+wid*1024;
  #define DMA_K(t,slot) glds16(ksrc+(long)(t)*KVBLK*DM,(unsigned)__builtin_amdgcn_readfirstlane(kdst+(slot)))
  #define DMA_V(t,slot) glds16(vsrc+(long)(t)*KVBLK*DM,(unsigned)__builtin_amdgcn_readfirstlane(vdst+(slot)))
  const int vb0=(int)(lds0+LDS_V)+((lane>>4)&1)*32+(lane&3)*8+(4*hi+((lane&15)>>2))*64;
  const char*Kbase=shm+LDS_K; bf16x8 kf[8];
  const lds_cptr shm3=(lds_cptr)shm; const lds_cptr kp0=shm3+LDS_K+hi*1024+r32*16; const lds_cptr vp0=shm3+LDS_V+((lane>>4)&1)*32+(lane&3)*8+(4*hi+((lane&15)>>2))*64;
  const int NT=(q0+QB)/KVBLK;
  DMA_K(0,0);DMA_V(0,0);DMA_K(1,SLOTB);
  bf16x8 qr[4];
  #pragma unroll
  for(int d0=0;d0<4;++d0)qr[d0]=*reinterpret_cast<const bf16x8*>(&Qw[(long)r32*DM+d0*16+hi*8]);
  float mhat=0.f,l_reg=0.f;f32x16 o[2];o[0]=f32x16{};o[1]=f32x16{};f32x16 negm=f32x16{};asm volatile("":"+v"(negm));
  const int qrel=wid*QBLK+r32;
  #define CMASK(P0,P1,t) do{int jb_=(t)-(NT-4); if(jb_>=0)cmask(P0,P1,jb_,qrel,hi);}while(0)
  bool resc=false;
  #define START(P0,P1) do{ const float rm=rowmax(P0,P1); resc=false; \
    { const float dl=rm; mhat=fadd_s(mhat,dl); \
      _Pragma("unroll") for(int r=0;r<16;++r){P0[r]=fsub_s(P0[r],dl);P1[r]=fsub_s(P1[r],dl);} \
      _Pragma("unroll") for(int r=0;r<16;++r)negm[r]=-mhat; asm volatile("":"+v"(negm)); } \
    _Pragma("unroll") for(int r=0;r<16;++r)P0[r]=__builtin_amdgcn_exp2f(P0[r]); }while(0)
  #define RESC() do{ if(resc){ asm volatile("s_waitcnt lgkmcnt(0)":::"memory"); \
      _Pragma("unroll") for(int d_=0;d_<2;++d_) _Pragma("unroll") for(int r=0;r<16;++r)o[d_][r]*=wsf[crow(r,hi)]; } }while(0)
  f32x16 pA0,pA1,pB0,pB1;
  int sl_prev=0,sl_cur=0,sl_next=SLOTB;
  #define ROT() do{sl_prev=sl_cur;sl_cur=sl_next;sl_next=(sl_next==(NSLOT-1)*SLOTB)?0:sl_next+SLOTB;}while(0)
  DMA_K(2,2*SLOTB);
  WAIT_BAR(3);
  qkt(pA0,pA1,Kbase,qr,negm,r32,hi);asm volatile("s_nop 15\n\ts_nop 7":"+v"(pA0),"+v"(pA1));CMASK(pA0,pA1,0);
  START(pA0,pA1);
  _Pragma("unroll") for(int r=0;r<16;++r)pA1[r]=__builtin_amdgcn_exp2f(pA1[r]);
  WAIT_BAR(0);
  DMA_K(3,0);DMA_V(1,SLOTB);
  ROT();
  kload8(kf,kp0+sl_cur);
  WAIT_BAR(2);
  s16x4 vlo[8],vhi[8]; u32x4 pw0,pw1,pw2,pw3;
  #define PKW(P,B) cvtpk_s(P[B],P[B+1])
  #define PAF(k) __builtin_bit_cast(bf16x8,pw##k)
  #define VFR(i) (bf16x8){vlo[i][0],vlo[i][1],vlo[i][2],vlo[i][3],vhi[i][0],vhi[i][1],vhi[i][2],vhi[i][3]}
  #define PIN(x) asm volatile("":"+v"(x))
  #define MX3(a,b,c) __builtin_fmaxf(__builtin_fmaxf((a),(b)),(c))
  #define GAPA(MF,A0,A1,A2,A3,W0,W1,PW) do{ MF; sacc+=A0; sacc+=A1; sacc+=A2; sacc+=A3; PIN(sacc); W0; W1; PIN(PW); SBAR(); }while(0)
  #define EX(v) __builtin_amdgcn_exp2f(v)
  #define GAPB(MF,X,B) do{ MF; X[B]=EX(X[B]); X[B+1]=EX(X[B+1]); X[B+2]=EX(X[B+2]); X[B+3]=EX(X[B+3]); PIN(X); SBAR(); }while(0)
  #define VRD(i) do{ vlo[i]=vtr(vp_+(((i)>>2)*4096+((i)&3)*1024)); vhi[i]=vtr(vp_+(((i)>>2)*4096+((i)&3)*1024+512)); }while(0)
  #define KRD(G,j) do{ if(G){ kload2(kf,kp0+sl_next,j); SBAR(); } }while(0)
  #define STEP(C0,C1,P0,P1,t,GK,GV,GL) do{ SBAR(); \
    const lds_cptr vp_=vp0+sl_prev; \
    VRD(0); SBAR(); float sacc=(P0[0]+P0[1]); \
    GAPA(C0=MFMA_H(kf[0],qr[0],negm,0,0,0), P0[2],P0[3],P0[4],P0[5],     pw0[0]=PKW(P0,0), pw0[1]=PKW(P0,2), pw0); \
    VRD(4); SBAR(); GAPA(C1=MFMA_H(kf[1],qr[0],negm,0,0,0), P0[6],P0[7],P0[8],P0[9],     pw0[2]=PKW(P0,4), pw0[3]=PKW(P0,6), pw0); \
    VRD(1); SBAR(); GAPA(C0=MFMA_H(kf[2],qr[1],C0,0,0,0),   P0[10],P0[11],P0[12],P0[13], pw1[0]=PKW(P0,8), pw1[1]=PKW(P0,10), pw1); \
    VRD(5); SBAR(); GAPA(C1=MFMA_H(kf[3],qr[1],C1,0,0,0),   P0[14],P0[15],P1[0],P1[1],   pw1[2]=PKW(P0,12),pw1[3]=PKW(P0,14), pw1); \
    VRD(2); SBAR(); GAPA(C0=MFMA_H(kf[4],qr[2],C0,0,0,0),   P1[2],P1[3],P1[4],P1[5],     pw2[0]=PKW(P1,0), pw2[1]=PKW(P1,2), pw2); \
    VRD(6); SBAR(); GAPA(C1=MFMA_H(kf[5],qr[2],C1,0,0,0),   P1[6],P1[7],P1[8],P1[9],     pw2[2]=PKW(P1,4), pw2[3]=PKW(P1,6), pw2); \
    VRD(3); SBAR(); GAPA(C0=MFMA_H(kf[6],qr[3],C0,0,0,0),   P1[10],P1[11],P1[12],P1[13], pw3[0]=PKW(P1,8), pw3[1]=PKW(P1,10), pw3); \
    VRD(7); SBAR(); GAPA(C1=MFMA_H(kf[7],qr[3],C1,0,0,0),   P1[14],P1[15],0.f,0.f,       pw3[2]=PKW(P1,12),pw3[3]=PKW(P1,14), pw3); \
    l_reg+=sacc; \
    if(GK){DMA_K((t)+3,sl_cur);} if(GV){DMA_V((t)+1,sl_next);} \
    CMASK(C0,C1,t); \
    { float a=MX3(C0[0],C0[1],C1[0]),b=MX3(C0[2],C0[3],C1[1]); a=MX3(a,C1[2],C1[3]); \
      _Pragma("unroll") for(int r=4;r<16;r+=4){a=MX3(a,C0[r],C0[r+1]);b=MX3(b,C0[r+2],C0[r+3]);a=MX3(a,C1[r],C1[r+1]);b=MX3(b,C1[r+2],C1[r+3]);} \
      float rm=__builtin_fmaxf(a,b); { auto rr=__builtin_amdgcn_permlane32_swap(__float_as_uint(rm),__float_as_uint(rm),false,false); rm=__builtin_fmaxf(__uint_as_float(rr[0]),__uint_as_float(rr[1])); } \
      resc=false; \
      if(__builtin_expect(__any(rm>(float)THRL),0)){ const float dl=__builtin_fmaxf(rm,0.f); mhat+=dl; \
        _Pragma("unroll") for(int r=0;r<16;++r){C0[r]-=dl;C1[r]-=dl;} \
        _Pragma("unroll") for(int r=0;r<16;++r)negm[r]=-mhat; asm volatile("":"+v"(negm)); \
        const float f=__builtin_amdgcn_exp2f(-dl); l_reg*=f; { const int le_=lane_id_v(); if(le_<32)wsf[le_]=f; } resc=true; } } \
    SBAR(); \
    GAPB(o[0]=MFMA_H(PAF(0),VFR(0),o[0],0,0,0), C0,0); \
    GAPB(o[1]=MFMA_H(PAF(0),VFR(4),o[1],0,0,0), C0,4); \
    KRD(GL,0); GAPB(o[0]=MFMA_H(PAF(1),VFR(1),o[0],0,0,0), C0,8); \
    KRD(GL,1); GAPB(o[1]=MFMA_H(PAF(1),VFR(5),o[1],0,0,0), C0,12); \
    KRD(GL,2); GAPB(o[0]=MFMA_H(PAF(2),VFR(2),o[0],0,0,0), C1,0); \
    KRD(GL,3); GAPB(o[1]=MFMA_H(PAF(2),VFR(6),o[1],0,0,0), C1,4); \
    GAPB(o[0]=MFMA_H(PAF(3),VFR(3),o[0],0,0,0), C1,8); \
    GAPB(o[1]=MFMA_H(PAF(3),VFR(7),o[1],0,0,0), C1,12); \
    }while(0)
  int t=1;
  #undef CMASK
  #define CMASK(P0,P1,t) do{}while(0)
  for(;t+5<NT;t+=2){
    STEP(pB0,pB1,pA0,pA1,t,true,true,true);     WAIT_BAR(2); RESC(); ROT();
    STEP(pA0,pA1,pB0,pB1,t+1,true,true,true);   WAIT_BAR(2); RESC(); ROT();
  }
  #undef CMASK
  #define CMASK(P0,P1,t) do{int jb_=(t)-(NT-4); if(jb_>=0)cmask(P0,P1,jb_,qrel,hi);}while(0)
  #define ENDW(tt) do{ if((tt)+3<NT){WAIT_BAR(2);} else if((tt)+2<NT){WAIT_BAR(1);} else {WAIT_BAR(0);} }while(0)
  for(;t+1<NT;t+=2){
    STEP(pB0,pB1,pA0,pA1,t,(t+3<NT),(t+1<NT),(t+1<NT));       ENDW(t);   RESC(); ROT();
    STEP(pA0,pA1,pB0,pB1,t+1,(t+4<NT),(t+2<NT),(t+2<NT));     ENDW(t+1); RESC(); ROT();
  }
  STEP(pB0,pB1,pA0,pA1,NT-1,false,false,false); RESC();
  { float sacc=pB0[0]+pB0[1]; _Pragma("unroll") for(int r=2;r<16;++r)sacc+=pB0[r]; _Pragma("unroll") for(int r=0;r<16;++r)sacc+=pB1[r]; l_reg+=sacc;
    pw0=(u32x4){PKW(pB0,0),PKW(pB0,2),PKW(pB0,4),PKW(pB0,6)};pw1=(u32x4){PKW(pB0,8),PKW(pB0,10),PKW(pB0,12),PKW(pB0,14)};pw2=(u32x4){PKW(pB1,0),PKW(pB1,2),PKW(pB1,4),PKW(pB1,6)};pw3=(u32x4){PKW(pB1,8),PKW(pB1,10),PKW(pB1,12),PKW(pB1,14)};
    SBAR(); pv(o,vb0+sl_cur,PAF(0),PAF(1),PAF(2),PAF(3)); }
  #undef PKW
  #undef PAF
  #undef VFR
  #undef PIN
  #undef MX3
  #undef GAPA
  #undef GAPB
  #undef EX
  #undef VRD
  #undef KRD
  #undef STEP
  #undef ENDW
  {auto rr=__builtin_amdgcn_permlane32_swap(__float_as_uint(l_reg),__float_as_uint(l_reg),false,false);l_reg=__uint_as_float(rr[0])+__uint_as_float(rr[1]);}
  if(hi==0)wsf[32+r32]=l_reg;asm volatile("s_waitcnt lgkmcnt(0)":::"memory");
  int tide=(wv_in<<6)|lane_id_v();
  const int lane_e=tide&63,r32_e=lane_e&31,hi_e=lane_e>>5;
  float rli[16];
  #pragma unroll
  for(int r=0;r<16;++r)rli[r]=__builtin_amdgcn_rcpf(wsf[32+crow(r,hi_e)]);
  bf16*Ow=O+(rowbase+q0+wid*QBLK)*DM+h*D;
  { bf16*stg=(bf16*)(shm+LDS_OST)+wid*2048;
    #pragma unroll
    for(int r=0;r<16;++r){const int orow=crow(r,hi_e);
      #pragma unroll
      for(int d0=0;d0<2;++d0)stg[orow*64+d0*32+r32_e]=(bf16)(o[d0][r]*rli[r]);}
    asm volatile("s_waitcnt lgkmcnt(0)":::"memory");
    #pragma unroll
    for(int i=0;i<4;++i){const int row=i*8+(lane_e>>3),ch=lane_e&7; const u32x4 v=*(const u32x4*)(stg+row*64+ch*8); ATTN_STORE16(Ow+(long)row*DM+ch*8,v);} }
  asm volatile("s_waitcnt lgkmcnt(0)\n\ts_barrier":::"memory");
  #undef DMA_K
  #undef DMA_V
  #undef CMASK
  #undef START
  #undef RESC
  #undef ROT
}
constexpr int ATTN_LDS_BYTES=LDS_BYTES;
struct AttnTensors { const bf16* Q; const bf16* K; const bf16* V; bf16* O; };
struct AttnUnit { int bh; int qb; };
struct StaticOrder {
  int vcu;
  __device__ __forceinline__ explicit StaticOrder(int grid,int block):vcu((block%8)*(grid/8)+block/8){}
  __device__ __forceinline__ bool next(int i,AttnUnit&u)const{ if(i>=4)return false; const int s=vcu&15; u.bh=vcu>>4; u.qb=(i==0)?s:(i==1)?31-s:(i==2)?32+s:63-s; return true; }
  __device__ __forceinline__ void a_ready(const AttnUnit&)const{}
  __device__ __forceinline__ void done(const AttnUnit&)const{}
};
template<class Sched,int THRL=8> __device__ __forceinline__ void attn_phase(char*lds,const AttnTensors&T,const Sched&S,const int wv_in,const int vhalf){
  AttnUnit u;
  for(int i=0;S.next(i,u);++i){ S.a_ready(u); attn_unit<THRL>(u.bh/NHEAD,u.bh%NHEAD,u.qb,T.Q,T.K,T.V,T.O,lds,wv_in,vhalf); S.done(u); }
}
#undef SBAR
#undef WAIT_BAR
}
namespace attn128 {
using namespace attn_body;
#define SBAR() __builtin_amdgcn_sched_barrier(0)
#define WAIT_BAR(N) asm volatile("s_waitcnt vmcnt(" #N ") lgkmcnt(0)\n\ts_barrier":::"memory")
constexpr int VSLOTB=16384, OPITCH=2048;
constexpr int L_K=0, L_V=NSLOT*SLOTB, L_WS=L_V+NSLOT*VSLOTB, L_OST=L_WS+NW*64*4, L_BYTES=L_OST+NW*4096;
typedef __attribute__((address_space(3))) char* lds_ptr;
__device__ __forceinline__ void pv128(f32x16*o,int vb,bf16x8 pa0,bf16x8 pa1,bf16x8 pa2,bf16x8 pa3){
  #pragma unroll
  for(int d0=0;d0<4;++d0){s16x4 lo[4],hi[4];
    #pragma unroll
    for(int ks=0;ks<4;++ks){
      asm volatile("ds_read_b64_tr_b16 %0,%1 offset:%c2":"=&v"(lo[ks]):"v"(vb),"i"(d0*4096+ks*1024):"memory");
      asm volatile("ds_read_b64_tr_b16 %0,%1 offset:%c2":"=&v"(hi[ks]):"v"(vb),"i"(d0*4096+ks*1024+512):"memory");}
    asm volatile("s_waitcnt lgkmcnt(0)":::"memory");SBAR();
    #define PK(k) (bf16x8){lo[k][0],lo[k][1],lo[k][2],lo[k][3],hi[k][0],hi[k][1],hi[k][2],hi[k][3]}
    o[d0]=MFMA_H(pa0,PK(0),o[d0],0,0,0);
    o[d0]=MFMA_H(pa1,PK(1),o[d0],0,0,0);
    o[d0]=MFMA_H(pa2,PK(2),o[d0],0,0,0);
    o[d0]=MFMA_H(pa3,PK(3),o[d0],0,0,0);
    #undef PK
  }
}
template<int THRL> __device__ __forceinline__ void attn_unit(int h,int qb,const bf16*Q,const bf16*__restrict__ K,const bf16*__restrict__ V,bf16*O,char*shm,const int wv_in){
  int tid=(wv_in<<6)|lane_id_v();
  const int lane=tid&63,r32=lane&31,hi=lane>>5; const int wid=__builtin_amdgcn_readfirstlane(tid>>6);
  const int q0=qb*QB;
  const bf16*Qw=Q+(long)(q0+wid*QBLK)*DM+h*D;
  const bf16*Kh=K+h*D,*Vh=V+(h>>1)*128;
  const unsigned lds0=(unsigned)(uintptr_t)shm;
  float*wsf=(float*)(shm+L_WS)+wid*64;
  const bf16*ksrc=Kh+(long)lane*DM+wid*8;
  const bf16*vsrc=Vh+(long)(16*(wid&3)+(lane>>2))*DM+(wid>>2)*32+(lane&3)*8;
  const unsigned kdst=lds0+L_K+wid*1024, vdst=lds0+L_V+wid*1024;
  #define DMA_K(t,slot) glds16(ksrc+(long)(t)*KVBLK*DM,(unsigned)__builtin_amdgcn_readfirstlane(kdst+(slot)))
  #define DMA_V(t,slot) do{ glds16(vsrc+(long)(t)*KVBLK*DM,(unsigned)__builtin_amdgcn_readfirstlane(vdst+2*(slot))); glds16(vsrc+(long)(t)*KVBLK*DM+64,(unsigned)__builtin_amdgcn_readfirstlane(vdst+2*(slot)+8192)); }while(0)
  const int vb0=(int)(lds0+L_V)+((lane>>4)&1)*32+(lane&3)*8+(4*hi+((lane&15)>>2))*64;
  const char*Kbase=shm+L_K; bf16x8 kf[8];
  const lds_cptr shm3=(lds_cptr)shm; const lds_cptr kp0=shm3+L_K+hi*1024+r32*16; const lds_cptr vp0=shm3+L_V+((lane>>4)&1)*32+(lane&3)*8+(4*hi+((lane&15)>>2))*64;
  const lds_cptr qp=shm3+L_OST+wid*4096+lane*16;
  #define QLD(d0) (*(const __attribute__((address_space(3))) bf16x8*)(qp+(d0)*1024))
  const int NT=(q0+QB)/KVBLK;
  DMA_K(0,0);DMA_V(0,0);DMA_K(1,SLOTB);
  float mhat=0.f,l_reg=0.f;f32x16 o[4];o[0]=f32x16{};o[1]=f32x16{};o[2]=f32x16{};o[3]=f32x16{};
  const f32x16 zero16=f32x16{}; f32x16 negm=f32x16{};asm volatile("":"+v"(negm));
  const int qrel=wid*QBLK+r32;
  #define CMASK(P0,P1,t) do{int jb_=(t)-(NT-4); if(jb_>=0)cmask(P0,P1,jb_,qrel,hi);}while(0)
  bool resc=false;
  #define START(P0,P1) do{ const float rm=rowmax(P0,P1); resc=false; \
    { const float dl=rm; mhat=fadd_s(mhat,dl); \
      _Pragma("unroll") for(int r=0;r<16;++r){P0[r]=fsub_s(P0[r],dl);P1[r]=fsub_s(P1[r],dl);} \
      _Pragma("unroll") for(int r=0;r<16;++r)negm[r]=-mhat; asm volatile("":"+v"(negm)); } \
    _Pragma("unroll") for(int r=0;r<16;++r)P0[r]=__builtin_amdgcn_exp2f(P0[r]); }while(0)
  #define RESC() do{ if(resc){ asm volatile("s_waitcnt lgkmcnt(0)":::"memory"); \
      _Pragma("unroll") for(int d_=0;d_<4;++d_) _Pragma("unroll") for(int r=0;r<16;++r)o[d_][r]*=wsf[crow(r,hi)]; } }while(0)
  f32x16 pA0,pA1,pB0,pB1;
  int sl_prev=0,sl_cur=0,sl_next=SLOTB;
  #define ROT() do{sl_prev=sl_cur;sl_cur=sl_next;sl_next=(sl_next==(NSLOT-1)*SLOTB)?0:sl_next+SLOTB;}while(0)
  {
    bf16x8 qr[4];
    #pragma unroll
    for(int d0=0;d0<4;++d0)qr[d0]=*reinterpret_cast<const bf16x8*>(&Qw[(long)r32*DM+d0*16+hi*8]);
    DMA_K(2,2*SLOTB);
    WAIT_BAR(4);
    qkt(pA0,pA1,Kbase,qr,zero16,r32,hi);asm volatile("s_nop 15\n\ts_nop 7":"+v"(pA0),"+v"(pA1));CMASK(pA0,pA1,0);
    #pragma unroll
    for(int d0=0;d0<4;++d0)*(__attribute__((address_space(3))) bf16x8*)((lds_ptr)qp+d0*1024)=qr[d0];
  }
  START(pA0,pA1);
  _Pragma("unroll") for(int r=0;r<16;++r)pA1[r]=__builtin_amdgcn_exp2f(pA1[r]);
  WAIT_BAR(0);
  DMA_K(3,0);DMA_V(1,SLOTB);
  ROT();
  kload8(kf,kp0+sl_cur);
  WAIT_BAR(3);
  s16x4 vlo[8],vhi[8]; u32x4 pw0,pw1,pw2,pw3;
  #define PKW(P,B) cvtpk_s(P[B],P[B+1])
  #define PAF(k) __builtin_bit_cast(bf16x8,pw##k)
  #define VFR(i) (bf16x8){vlo[i][0],vlo[i][1],vlo[i][2],vlo[i][3],vhi[i][0],vhi[i][1],vhi[i][2],vhi[i][3]}
  #define PIN(x) asm volatile("":"+v"(x))
  #define MX3(a,b,c) __builtin_fmaxf(__builtin_fmaxf((a),(b)),(c))
  #define GAPA(MF,A0,A1,A2,A3,W0,W1,PW) do{ MF; sacc+=A0; sacc+=A1; sacc+=A2; sacc+=A3; PIN(sacc); W0; W1; PIN(PW); SBAR(); }while(0)
  #define EX(v) __builtin_amdgcn_exp2f(v)
  #define GAPB(MF,X,B) do{ MF; X[B]=EX(X[B]); X[B+1]=EX(X[B+1]); PIN(X); SBAR(); }while(0)
  #define VRD(i) do{ vlo[i]=vtr(vp_+(((i)>>2)*4096+((i)&3)*1024)); vhi[i]=vtr(vp_+(((i)>>2)*4096+((i)&3)*1024+512)); }while(0)
  #define VRD2(i) do{ vlo[i]=vtr(vp_+((2+((i)>>2))*4096+((i)&3)*1024)); vhi[i]=vtr(vp_+((2+((i)>>2))*4096+((i)&3)*1024+512)); SBAR(); }while(0)
  #define KRD(G,j) do{ if(G){ kload2(kf,kp0+sl_next,j); SBAR(); } }while(0)
  #define STEP(C0,C1,P0,P1,t,GK,GV,GL) do{ SBAR(); \
    const lds_cptr vp_=vp0+2*sl_prev; \
    const bf16x8 q0_=QLD(0),q1_=QLD(1),q2_=QLD(2),q3_=QLD(3); \
    VRD(0); SBAR(); float sacc=(P0[0]+P0[1]); \
    GAPA(C0=MFMA_H(kf[0],q0_,negm,0,0,0), P0[2],P0[3],P0[4],P0[5],     pw0[0]=PKW(P0,0), pw0[1]=PKW(P0,2), pw0); \
    VRD(4); SBAR(); GAPA(C1=MFMA_H(kf[1],q0_,negm,0,0,0), P0[6],P0[7],P0[8],P0[9],     pw0[2]=PKW(P0,4), pw0[3]=PKW(P0,6), pw0); \
    VRD(1); SBAR(); GAPA(C0=MFMA_H(kf[2],q1_,C0,0,0,0),   P0[10],P0[11],P0[12],P0[13], pw1[0]=PKW(P0,8), pw1[1]=PKW(P0,10), pw1); \
    VRD(5); SBAR(); GAPA(C1=MFMA_H(kf[3],q1_,C1,0,0,0),   P0[14],P0[15],P1[0],P1[1],   pw1[2]=PKW(P0,12),pw1[3]=PKW(P0,14), pw1); \
    VRD(2); SBAR(); GAPA(C0=MFMA_H(kf[4],q2_,C0,0,0,0),   P1[2],P1[3],P1[4],P1[5],     pw2[0]=PKW(P1,0), pw2[1]=PKW(P1,2), pw2); \
    VRD(6); SBAR(); GAPA(C1=MFMA_H(kf[5],q2_,C1,0,0,0),   P1[6],P1[7],P1[8],P1[9],     pw2[2]=PKW(P1,4), pw2[3]=PKW(P1,6), pw2); \
    VRD(3); SBAR(); GAPA(C0=MFMA_H(kf[6],q3_,C0,0,0,0),   P1[10],P1[11],P1[12],P1[13], pw3[0]=PKW(P1,8), pw3[1]=PKW(P1,10), pw3); \
    VRD(7); SBAR(); GAPA(C1=MFMA_H(kf[7],q3_,C1,0,0,0),   P1[14],P1[15],0.f,0.f,       pw3[2]=PKW(P1,12),pw3[3]=PKW(P1,14), pw3); \
    l_reg+=sacc; \
    if(GK){DMA_K((t)+3,sl_cur);} if(GV){DMA_V((t)+1,sl_next);} \
    CMASK(C0,C1,t); \
    { float a=MX3(C0[0],C0[1],C1[0]),b=MX3(C0[2],C0[3],C1[1]); a=MX3(a,C1[2],C1[3]); \
      _Pragma("unroll") for(int r=4;r<16;r+=4){a=MX3(a,C0[r],C0[r+1]);b=MX3(b,C0[r+2],C0[r+3]);a=MX3(a,C1[r],C1[r+1]);b=MX3(b,C1[r+2],C1[r+3]);} \
      float rm=__builtin_fmaxf(a,b); { auto rr=__builtin_amdgcn_permlane32_swap(__float_as_uint(rm),__float_as_uint(rm),false,false); rm=__builtin_fmaxf(__uint_as_float(rr[0]),__uint_as_float(rr[1])); } \
      resc=false; \
      if(__builtin_expect(__any(rm>(float)THRL),0)){ const float dl=__builtin_fmaxf(rm,0.f); mhat+=dl; \
        _Pragma("unroll") for(int r=0;r<16;++r){C0[r]-=dl;C1[r]-=dl;} \
        _Pragma("unroll") for(int r=0;r<16;++r)negm[r]=-mhat; asm volatile("":"+v"(negm)); \
        const float f=__builtin_amdgcn_exp2f(-dl); l_reg*=f; { const int le_=lane_id_v(); if(le_<32)wsf[le_]=f; } resc=true; } } \
    SBAR(); \
    GAPB(o[0]=MFMA_H(PAF(0),VFR(0),o[0],0,0,0), C0,0);  VRD2(0); \
    GAPB(o[1]=MFMA_H(PAF(0),VFR(4),o[1],0,0,0), C0,2);  VRD2(4); \
    KRD(GL,0); GAPB(o[0]=MFMA_H(PAF(1),VFR(1),o[0],0,0,0), C0,4);  VRD2(1); \
    KRD(GL,1); GAPB(o[1]=MFMA_H(PAF(1),VFR(5),o[1],0,0,0), C0,6);  VRD2(5); \
    KRD(GL,2); GAPB(o[0]=MFMA_H(PAF(2),VFR(2),o[0],0,0,0), C0,8);  VRD2(2); \
    KRD(GL,3); GAPB(o[1]=MFMA_H(PAF(2),VFR(6),o[1],0,0,0), C0,10); VRD2(6); \
    GAPB(o[0]=MFMA_H(PAF(3),VFR(3),o[0],0,0,0), C0,12); VRD2(3); \
    GAPB(o[1]=MFMA_H(PAF(3),VFR(7),o[1],0,0,0), C0,14); VRD2(7); \
    GAPB(o[2]=MFMA_H(PAF(0),VFR(0),o[2],0,0,0), C1,0); \
    GAPB(o[3]=MFMA_H(PAF(0),VFR(4),o[3],0,0,0), C1,2); \
    GAPB(o[2]=MFMA_H(PAF(1),VFR(1),o[2],0,0,0), C1,4); \
    GAPB(o[3]=MFMA_H(PAF(1),VFR(5),o[3],0,0,0), C1,6); \
    GAPB(o[2]=MFMA_H(PAF(2),VFR(2),o[2],0,0,0), C1,8); \
    GAPB(o[3]=MFMA_H(PAF(2),VFR(6),o[3],0,0,0), C1,10); \
    GAPB(o[2]=MFMA_H(PAF(3),VFR(3),o[2],0,0,0), C1,12); \
    GAPB(o[3]=MFMA_H(PAF(3),VFR(7),o[3],0,0,0), C1,14); \
    }while(0)
  int t=1;
  #undef CMASK
  #define CMASK(P0,P1,t) do{}while(0)
  for(;t+5<NT;t+=2){
    STEP(pB0,pB1,pA0,pA1,t,true,true,true);     WAIT_BAR(3); RESC(); ROT();
    STEP(pA0,pA1,pB0,pB1,t+1,true,true,true);   WAIT_BAR(3); RESC(); ROT();
  }
  #undef CMASK
  #define CMASK(P0,P1,t) do{int jb_=(t)-(NT-4); if(jb_>=0)cmask(P0,P1,jb_,qrel,hi);}while(0)
  #define ENDW(tt) do{ if((tt)+3<NT){WAIT_BAR(3);} else if((tt)+2<NT){WAIT_BAR(2);} else {WAIT_BAR(0);} }while(0)
  for(;t+1<NT;t+=2){
    STEP(pB0,pB1,pA0,pA1,t,(t+3<NT),(t+1<NT),(t+1<NT));       ENDW(t);   RESC(); ROT();
    STEP(pA0,pA1,pB0,pB1,t+1,(t+4<NT),(t+2<NT),(t+2<NT));     ENDW(t+1); RESC(); ROT();
  }
  STEP(pB0,pB1,pA0,pA1,NT-1,false,false,false); RESC();
  { float sacc=pB0[0]+pB0[1]; _Pragma("unroll") for(int r=2;r<16;++r)sacc+=pB0[r]; _Pragma("unroll") for(int r=0;r<16;++r)sacc+=pB1[r]; l_reg+=sacc;
    pw0=(u32x4){PKW(pB0,0),PKW(pB0,2),PKW(pB0,4),PKW(pB0,6)};pw1=(u32x4){PKW(pB0,8),PKW(pB0,10),PKW(pB0,12),PKW(pB0,14)};pw2=(u32x4){PKW(pB1,0),PKW(pB1,2),PKW(pB1,4),PKW(pB1,6)};pw3=(u32x4){PKW(pB1,8),PKW(pB1,10),PKW(pB1,12),PKW(pB1,14)};
    SBAR(); pv128(o,vb0+2*sl_cur,PAF(0),PAF(1),PAF(2),PAF(3)); }
  #undef PKW
  #undef PAF
  #undef VFR
  #undef PIN
  #undef MX3
  #undef GAPA
  #undef GAPB
  #undef EX
  #undef VRD
  #undef VRD2
  #undef KRD
  #undef STEP
  #undef ENDW
  #undef QLD
  {auto rr=__builtin_amdgcn_permlane32_swap(__float_as_uint(l_reg),__float_as_uint(l_reg),false,false);l_reg=__uint_as_float(rr[0])+__uint_as_float(rr[1]);}
  if(hi==0)wsf[32+r32]=l_reg;asm volatile("s_waitcnt lgkmcnt(0)":::"memory");
  int tide=(wv_in<<6)|lane_id_v();
  const int lane_e=tide&63,r32_e=lane_e&31,hi_e=lane_e>>5;
  float rli[16];
  #pragma unroll
  for(int r=0;r<16;++r)rli[r]=__builtin_amdgcn_rcpf(wsf[32+crow(r,hi_e)]);
  bf16*Ow=O+(long)(q0+wid*QBLK)*OPITCH+h*128;
  { bf16*stg=(bf16*)(shm+L_OST)+wid*2048;
    #pragma unroll
    for(int ch=0;ch<2;++ch){
      #pragma unroll
      for(int r=0;r<16;++r){const int orow=crow(r,hi_e);
        #pragma unroll
        for(int d0=0;d0<2;++d0)stg[orow*64+d0*32+r32_e]=(bf16)(o[2*ch+d0][r]*rli[r]);}
      asm volatile("s_waitcnt lgkmcnt(0)":::"memory");
      #pragma unroll
      for(int i=0;i<4;++i){const int row=i*8+(lane_e>>3),c8=lane_e&7; const u32x4 v=*(const u32x4*)(stg+row*64+c8*8); ATTN_STORE16(Ow+(long)row*OPITCH+ch*64+c8*8,v);}
      asm volatile("s_waitcnt lgkmcnt(0)":::"memory"); } }
  asm volatile("s_waitcnt lgkmcnt(0)\n\ts_barrier":::"memory");
  #undef DMA_K
  #undef DMA_V
  #undef CMASK
  #undef START
  #undef RESC
  #undef ROT
}
struct AttnTensors { const bf16* Q; const bf16* K; const bf16* V; bf16* O; };
template<class Sched,int THRL=8> __device__ __forceinline__ void attn_phase(char*lds,const AttnTensors&T,const Sched&S,const int wv_in){
  AttnUnit u;
  for(int i=0;S.next(i,u);++i){ attn_unit<THRL>(u.bh,u.qb,T.Q,T.K,T.V,T.O,lds,wv_in); }
}
#undef SBAR
#undef WAIT_BAR
}

DEV void ph_attn(const Params& p, LAS char* lds, int wv) {
    TID_DECL
    char* ws = p.ws;
    const attn128::AttnTensors T{(const half_t*)(ws + OFF_QA), (const half_t*)(ws + OFF_KA), (const half_t*)(ws + OFF_VAT), (half_t*)(ws + OFF_OA0)};
    const attn_body::StaticOrder S(nblk, bidx);
    attn128::attn_phase<attn_body::StaticOrder>((char*)lds, T, S, ls(wv));
}
DEV void ph_attn_comb(const Params& p, int l, int wv) {
    TID_DECL
    char* ws = p.ws; const int lane = tidx & 63, wid = tidx >> 6;
    const float* lp = p.da_lambda + l * 256;
    const float a = wave_sum(lane, lp[lane] * lp[64 + lane]), bq = wave_sum(lane, lp[128 + lane] * lp[192 + lane]);
    const float lam_init = 0.8f - 0.6f * expf(-0.3f * (float)l); const float lam = expf(a) - expf(bq) + lam_init;
    const int h = lane >> 3, part = lane & 7, dv0 = part * 16;
    const half_t* OA = (const half_t*)(ws + OFF_OA0);
    const half_t* ZA = (const half_t*)(ws + OFF_ZA); half_t* YA = (half_t*)(ws + OFF_QA);
    const float* ng = p.da_norm_g + l * 128;
    for (int t = bidx * NWAVE + wid; t < TB; t += nblk * NWAVE) {
        const half_t* o1p = OA + (size_t)t * 2048 + (2 * h) * 128 + dv0; const half_t* o2p = o1p + 128;
        const h8 a0 = *(const h8*)o1p, a1 = *(const h8*)(o1p + 8), b0 = *(const h8*)o2p, b1 = *(const h8*)(o2p + 8);
        float d[16]; float ss = 0.f;
#pragma unroll
        for (int e = 0; e < 8; ++e) { d[e] = (float)a0[e] - lam * (float)b0[e]; d[8 + e] = (float)a1[e] - lam * (float)b1[e]; ss += d[e] * d[e] + d[8 + e] * d[8 + e]; }
        ss += shx(lane, ss, 1); ss += shx(lane, ss, 2); ss += shx(lane, ss, 4);
        const float rs = rsqrtf(ss * (1.f / 128.f) + NORM_EPS) * (1.f - lam_init);
        const size_t off = (size_t)t * 1024 + h * 128 + dv0; const h8 z0 = *(const h8*)(ZA + off), z1 = *(const h8*)(ZA + off + 8); h8 y0, y1;
#pragma unroll
        for (int e = 0; e < 8; ++e) { y0[e] = (half_t)(d[e] * rs * ng[dv0 + e] * (float)z0[e]); y1[e] = (half_t)(d[8 + e] * rs * ng[dv0 + 8 + e] * (float)z1[e]); }
        *(h8*)(YA + off) = y0; *(h8*)(YA + off + 8) = y1;
    }
}


template <int ROFF> DEV void tr_rd8(h4 (&lo)[4], h4 (&hi)[4], unsigned a0) {
    asm volatile("ds_read_b64_tr_b16 %0, %8\n\tds_read_b64_tr_b16 %1, %8 offset:32\n\tds_read_b64_tr_b16 %2, %8 offset:64\n\tds_read_b64_tr_b16 %3, %8 offset:96\n\t"
                 "ds_read_b64_tr_b16 %4, %8 offset:%c9\n\tds_read_b64_tr_b16 %5, %8 offset:%c10\n\tds_read_b64_tr_b16 %6, %8 offset:%c11\n\tds_read_b64_tr_b16 %7, %8 offset:%c12\n\ts_waitcnt lgkmcnt(0)"
                 : "=&v"(lo[0]), "=&v"(lo[1]), "=&v"(lo[2]), "=&v"(lo[3]), "=&v"(hi[0]), "=&v"(hi[1]), "=&v"(hi[2]), "=&v"(hi[3])
                 : "v"(a0), "i"(ROFF), "i"(ROFF + 32), "i"(ROFF + 64), "i"(ROFF + 96) : "memory");
}
DEV float chunk_scan(const float* MG, int hh, int c, float& ig, int lane) {
    const int t = c * 64 + lane;
    ig = MG[(size_t)t * 8 + hh]; float a = MG[(size_t)t * 8 + 4 + hh];
#pragma unroll
    for (int o = 1; o < 64; o <<= 1) { const float u = shi(a, lane - o); if (lane >= o) a += u; }
    return a;
}
constexpr int LDV = 264, LDK = 136;
constexpr int ML_VT_BYTES = 64 * LDV * 2, ML_KT_BYTES = 64 * LDK * 2;
DEV void ph_ml_state(const Params& p, LAS char* lds, int wv) { TID_DECL
    char* ws = p.ws; const int lane = tidx & 63, wid = tidx >> 6, r = lane & 15, g = lane >> 4;
    const float* MG = (const float*)(ws + OFF_MG); const half_t* MV = (const half_t*)(ws + OFF_MVT); const half_t* MQKC = (const half_t*)(ws + OFF_MQKC);
    float* ST = (float*)(ws + OFF_ST); float* NV = (float*)(ws + OFF_NV); float* DEC = (float*)(ws + OFF_DEC);
    LAS half_t* Vt = (LAS half_t*)lds; LAS half_t* Kt = (LAS half_t*)(lds + ML_VT_BYTES);
    const unsigned vt_addr = (unsigned)(uintptr_t)Vt, kt_addr = (unsigned)(uintptr_t)Kt;
    for (int u = bidx; u < 1024; u += nblk) {
        const int hh = u >> 8, c = u & 255; float ig; const float a = chunk_scan(MG, hh, c, ig, lane); const float a63 = shi(a, 63); const float w = __expf(a63 - a + ig);
        __syncthreads();
        { h8 x[4];
#pragma unroll
          for (int i = 0; i < 4; ++i) { const int ch = tidx + 512 * i, row = ch >> 5, c16 = ch & 31; x[i] = *(const h8*)(MV + (size_t)(c * 64 + row) * 1024 + hh * 256 + c16 * 8); }
          h8 y[2];
#pragma unroll
          for (int i = 0; i < 2; ++i) { const int ch = tidx + 512 * i, row = ch >> 4, c16 = ch & 15; y[i] = *(const h8*)(MQKC + (size_t)(c * 64 + row) * 1024 + 512 + hh * 128 + c16 * 8); }
#pragma unroll
          for (int i = 0; i < 4; ++i) { const int ch = tidx + 512 * i, row = ch >> 5, c16 = ch & 31; const float wr = shi(w, row); h8 z;
#pragma unroll
              for (int e = 0; e < 8; ++e) z[e] = (half_t)((float)x[i][e] * wr);
              *(LAS h8*)(Vt + row * LDV + c16 * 8) = z; }
#pragma unroll
          for (int i = 0; i < 2; ++i) { const int ch = tidx + 512 * i, row = ch >> 4, c16 = ch & 15; *(LAS h8*)(Kt + row * LDK + c16 * 8) = y[i]; } }
        __syncthreads();
        f4 acc[2][8];
#pragma unroll
        for (int i = 0; i < 2; ++i)
#pragma unroll
            for (int j = 0; j < 8; ++j) acc[i][j] = (f4){0.f, 0.f, 0.f, 0.f};
#pragma unroll
        for (int ks = 0; ks < 2; ++ks) {
            const int frow = 32 * ks + 8 * g + (r >> 2);
            h4 vlo[4], vhi[4]; tr_rd8<4 * LDV * 2>(vlo, vhi, vt_addr + (unsigned)((frow * LDV + wid * 32 + 4 * (r & 3)) * 2));
            h4 klo[4], khi[4], klo2[4], khi2[4];
            tr_rd8<4 * LDK * 2>(klo, khi, kt_addr + (unsigned)((frow * LDK + 4 * (r & 3)) * 2));
            tr_rd8<4 * LDK * 2>(klo2, khi2, kt_addr + (unsigned)((frow * LDK + 64 + 4 * (r & 3)) * 2));
            const h8 va0 = cat44(vlo[0], vhi[0]), va1 = cat44(vlo[1], vhi[1]);
#pragma unroll
            for (int dt = 0; dt < 4; ++dt) { const h8 kb = cat44(klo[dt], khi[dt]); acc[0][dt] = MFMA16(va0, kb, acc[0][dt]); acc[1][dt] = MFMA16(va1, kb, acc[1][dt]); }
#pragma unroll
            for (int dt = 0; dt < 4; ++dt) { const h8 kb = cat44(klo2[dt], khi2[dt]); acc[0][4 + dt] = MFMA16(va0, kb, acc[0][4 + dt]); acc[1][4 + dt] = MFMA16(va1, kb, acc[1][4 + dt]); }
        }
#pragma unroll
        for (int vt = 0; vt < 2; ++vt)
#pragma unroll
            for (int dt = 0; dt < 8; ++dt)
#pragma unroll
                for (int e = 0; e < 4; ++e) ST[((size_t)(hh * 256 + c) * 256 + wid * 32 + vt * 16 + 4 * g + e) * 128 + dt * 16 + r] = acc[vt][dt][e];
        { const int d = wid * 16 + r; float s = 0.f;
#pragma unroll
          for (int e = 0; e < 16; ++e) s += (float)Kt[(16 * g + e) * LDK + d] * shi(w, 16 * g + e);
          s = gsum(lane, s); if (g == 0) NV[(size_t)(hh * 256 + c) * 128 + d] = s; }
        if (tidx == 0) DEC[hh * 256 + c] = __expf(a63);
    }
    __syncthreads();
}
DEV void ph_ml_scan(const Params& p, int wv) { TID_DECL
    char* ws = p.ws; float* ST = (float*)(ws + OFF_ST); float* NV = (float*)(ws + OFF_NV); const float* DEC = (const float*)(ws + OFF_DEC);
    const int nthr = nblk * NTHREADS;
    for (int e0 = bidx * NTHREADS + tidx; e0 < 4 * 32768 + 512; e0 += nthr) {
        float* base; size_t stride; int hh;
        half_t* b16 = nullptr;
        if (e0 < 4 * 32768) { hh = e0 >> 15; base = ST + (size_t)hh * 256 * 32768 + (e0 & 32767); stride = 32768; b16 = (half_t*)(ws + OFF_ST16) + (size_t)hh * 256 * 32768 + (e0 & 32767); }
        else { const int q = e0 - 4 * 32768; hh = q >> 7; base = NV + (size_t)hh * 256 * 128 + (q & 127); stride = 128; }
        float S = 0.f;
        for (int c0 = 0; c0 < 256; c0 += 8) { float tmp[8];
#pragma unroll
            for (int i = 0; i < 8; ++i) tmp[i] = base[(size_t)(c0 + i) * stride];
#pragma unroll
            for (int i = 0; i < 8; ++i) { if (b16) b16[(size_t)(c0 + i) * stride] = (half_t)S; else base[(size_t)(c0 + i) * stride] = S; S = DEC[hh * 256 + c0 + i] * S + tmp[i]; } }
    }
}
DEV void ph_ml_out(const Params& p, int l, LAS char* lds, int wv) { TID_DECL
    char* ws = p.ws; const int lane = tidx & 63, wid = tidx >> 6, r = lane & 15, g = lane >> 4;
    const float* MG = (const float*)(ws + OFF_MG); const half_t* MV = (const half_t*)(ws + OFF_MVT); const half_t* MQKC = (const half_t*)(ws + OFF_MQKC);
    const half_t* ST16 = (const half_t*)(ws + OFF_ST16); const float* NV = (const float*)(ws + OFF_NV);
    const half_t* MO = (const half_t*)(ws + OFF_MO); const half_t* MZ = (const half_t*)(ws + OFF_MZ); half_t* YB = (half_t*)(ws + OFF_YB);
    const float* ng = p.ml_norm_g + l * 256;
    const int ci = wid >> 2, j = wid & 3;
    LAS half_t* Vt = (LAS half_t*)(lds + ci * ML_VT_BYTES); const unsigned vt_addr = (unsigned)(uintptr_t)Vt;
    for (int bu = bidx; bu < 512; bu += nblk) {
        const int cu = 2 * bu + ci, hh = cu >> 8, c = cu & 255; const int t = c * 64 + 16 * j + r;
        __syncthreads();
        { h8 x[8];
#pragma unroll
          for (int i = 0; i < 8; ++i) { const int ch = tidx + 512 * i, row = ch >> 5, c16 = ch & 31; x[i] = *(const h8*)(MV + (size_t)(((2 * bu) & 255) * 64 + row) * 1024 + ((2 * bu) >> 8) * 256 + c16 * 8); }
#pragma unroll
          for (int i = 0; i < 8; ++i) { const int ch = tidx + 512 * i, row = ch >> 5, c16 = ch & 31; *(LAS h8*)((LAS half_t*)lds + (row >> 6) * (ML_VT_BYTES / 2) + (row & 63) * LDV + c16 * 8) = x[i]; } }
        __syncthreads();
        float ig; const float a = chunk_scan(MG, hh, c, ig, lane); const float a_t = shi(a, 16 * j + r); const float ea = __expf(a_t);
        h8 qf[4];
#pragma unroll
        for (int ks = 0; ks < 4; ++ks) qf[ks] = *(const h8*)(MQKC + (size_t)t * 1024 + hh * 128 + 32 * ks + 8 * g);
        f4 acc[16];
#pragma unroll
        for (int vb = 0; vb < 16; vb += 4) { h8 sa[4][4];
#pragma unroll
            for (int v4 = 0; v4 < 4; ++v4)
#pragma unroll
                for (int ks = 0; ks < 4; ++ks) sa[v4][ks] = *(const h8*)(ST16 + ((size_t)cu * 256 + (vb + v4) * 16 + r) * 128 + 32 * ks + 8 * g);
#pragma unroll
            for (int v4 = 0; v4 < 4; ++v4) { const int vt = vb + v4; acc[vt] = (f4){0.f, 0.f, 0.f, 0.f};
#pragma unroll
                for (int ks = 0; ks < 4; ++ks) acc[vt] = MFMA16(sa[v4][ks], qf[ks], acc[vt]);
                acc[vt] *= ea; } }
        float den = 0.f;
        { const float* np = NV + (size_t)cu * 128 + 32 * g; const half_t* qp = MQKC + (size_t)t * 1024 + hh * 128 + 32 * g;
#pragma unroll
          for (int m = 0; m < 4; ++m) { const h8 q8 = *(const h8*)(qp + 8 * m);
#pragma unroll
              for (int e = 0; e < 8; ++e) den += (float)q8[e] * np[8 * m + e]; }
          den *= ea; }
        for (int kb = 0; kb <= (j >> 1); ++kb) {
            h8 kfr[2][4];
#pragma unroll
            for (int st = 0; st < 2; ++st)
#pragma unroll
                for (int ks = 0; ks < 4; ++ks) kfr[st][ks] = *(const h8*)(MQKC + (size_t)(c * 64 + 32 * kb + 16 * st + r) * 1024 + 512 + hh * 128 + 32 * ks + 8 * g);
            f4 wv[2];
#pragma unroll
            for (int st = 0; st < 2; ++st) { f4 gacc = (f4){0.f, 0.f, 0.f, 0.f};
#pragma unroll
                for (int ks = 0; ks < 4; ++ks) gacc = MFMA16(kfr[st][ks], qf[ks], gacc);
#pragma unroll
                for (int e = 0; e < 4; ++e) { const int si = 32 * kb + 16 * st + 4 * g + e; const float a_s = shi(a, si), ig_s = shi(ig, si);
                    wv[st][e] = (si <= 16 * j + r) ? gacc[e] * __expf(a_t - a_s + ig_s) : 0.f; den += wv[st][e]; } }
            const h8 pb = cat44(toh4(wv[0]), toh4(wv[1]));
            const unsigned a0 = vt_addr + (unsigned)((((32 * kb + 4 * g + (r >> 2)) * LDV) + 4 * (r & 3)) * 2);
            asm volatile("s_waitcnt lgkmcnt(0)" ::: "memory");
#pragma unroll
            for (int c4 = 0; c4 < 4; ++c4) { h4 lo[4], hi4[4]; tr_rd8<16 * LDV * 2>(lo, hi4, a0 + c4 * 128);
#pragma unroll
                for (int i = 0; i < 4; ++i) acc[c4 * 4 + i] = MFMA16(cat44(lo[i], hi4[i]), pb, acc[c4 * 4 + i]); }
        }
        den = gsum(lane, den); const float inv = 1.f / fmaxf(fabsf(den), 1.f); float ss = 0.f;
#pragma unroll
        for (int vt = 0; vt < 16; ++vt) { acc[vt] *= inv; ss += acc[vt][0] * acc[vt][0] + acc[vt][1] * acc[vt][1] + acc[vt][2] * acc[vt][2] + acc[vt][3] * acc[vt][3]; }
        ss = gsum(lane, ss); const float rs = rsqrtf(ss * (1.f / 256.f) + NORM_EPS);
#pragma unroll
        for (int vb = 0; vb < 16; vb += 8) {
            f4 gg[8]; h4 o4[8], z4[8];
#pragma unroll
            for (int i = 0; i < 8; ++i) { const int v = (vb + i) * 16 + 4 * g; const size_t off = (size_t)t * 1024 + hh * 256 + v; gg[i] = *(const f4*)(ng + v); o4[i] = *(const h4*)(MO + off); z4[i] = *(const h4*)(MZ + off); }
#pragma unroll
            for (int i = 0; i < 8; ++i) { const int vt = vb + i; const size_t off = (size_t)t * 1024 + hh * 256 + vt * 16 + 4 * g;
                *(h4*)(YB + off) = toh4((f4){acc[vt][0] * rs * gg[i][0] * (float)o4[i][0] * (float)z4[i][0], acc[vt][1] * rs * gg[i][1] * (float)o4[i][1] * (float)z4[i][1],
                                             acc[vt][2] * rs * gg[i][2] * (float)o4[i][2] * (float)z4[i][2], acc[vt][3] * rs * gg[i][3] * (float)o4[i][3] * (float)z4[i][3]}); } }
    }
    __syncthreads();
}

constexpr int CAP = 704, NPL = CAP / 64;
constexpr int IDX_WAVE_LDS = 4 * CAP * 4 + 4 * CAP * 2 + 256 * 4;
DEV unsigned f2key(float v) { const unsigned b = __float_as_uint(v); return b ^ ((b >> 31) ? 0xffffffffu : 0x80000000u); }
DEV float key2f(unsigned u) { const unsigned b = (u >> 31) ? (u ^ 0x80000000u) : ~u; return __uint_as_float(b); }
template <int PASSES> DEV float prune(LAS float* val, LAS u16* idx, LAS unsigned* hist, int n, int lane, int& kept_out) {
    unsigned u[NPL]; u16 id[NPL];
#pragma unroll
    for (int i = 0; i < NPL; ++i) { const int e = lane + 64 * i; const bool ok = e < n; u[i] = ok ? f2key(val[e]) : 0u; id[i] = ok ? idx[e] : (u16)0; }
    unsigned prefix = 0u, mask = 0u; int want = TOPK;
#pragma unroll 1
    for (int ps = 0; ps < PASSES; ++ps) { const int shift = 24 - 8 * ps;
#pragma unroll
        for (int i = 0; i < 4; ++i) hist[lane + 64 * i] = 0u;
        __builtin_amdgcn_fence(__ATOMIC_RELEASE, "wavefront"); __builtin_amdgcn_wave_barrier();
#pragma unroll
        for (int i = 0; i < NPL; ++i) { const int e = lane + 64 * i; if (e < n && (u[i] & mask) == prefix) __hip_atomic_fetch_add(&hist[(u[i] >> shift) & 255u], 1u, __ATOMIC_RELAXED, __HIP_MEMORY_SCOPE_WORKGROUP); }
        __builtin_amdgcn_fence(__ATOMIC_ACQ_REL, "wavefront"); __builtin_amdgcn_wave_barrier();
        const unsigned c0 = hist[4 * lane], c1 = hist[4 * lane + 1], c2 = hist[4 * lane + 2], c3 = hist[4 * lane + 3];
        const unsigned mine = c0 + c1 + c2 + c3; unsigned above = mine;
#pragma unroll
        for (int o = 1; o < 64; o <<= 1) { const unsigned t = shi(above, lane + o); if (lane + o < 64) above += t; }
        above -= mine;
        const bool here = (above < (unsigned)want) && (above + mine >= (unsigned)want);
        int bsel = 0; unsigned cab = 0;
        if (here) { unsigned cum = above; if (cum + c3 >= (unsigned)want) { bsel = 4 * lane + 3; cab = cum; } else { cum += c3; if (cum + c2 >= (unsigned)want) { bsel = 4 * lane + 2; cab = cum; } else { cum += c2; if (cum + c1 >= (unsigned)want) { bsel = 4 * lane + 1; cab = cum; } else { cum += c1; bsel = 4 * lane; cab = cum; } } } }
        const unsigned long long bal = __ballot(here); const int src = __ffsll((long long)bal) - 1;
        bsel = shi(bsel, src); cab = shi(cab, src);
        prefix |= ((unsigned)bsel) << shift; mask |= 0xffu << shift; want -= (int)cab;
        __builtin_amdgcn_wave_barrier();
    }
    int kept = 0, eqseen = 0;
#pragma unroll
    for (int i = 0; i < NPL; ++i) { const int e = lane + 64 * i; const bool ok = e < n; const unsigned um = u[i] & mask; const bool gt = ok && um > prefix, eq = ok && um == prefix;
        const unsigned long long lt = (1ull << lane) - 1ull; bool keep;
        if (PASSES == 4) { const unsigned long long beq = __ballot(eq); const int erank = eqseen + __popcll(beq & lt); keep = gt || (eq && erank < want); eqseen += __popcll(beq); }
        else keep = gt || eq;
        const unsigned long long bk = __ballot(keep); const int pos = kept + __popcll(bk & lt); kept += __popcll(bk);
        if (keep) { val[pos] = key2f(u[i]); idx[pos] = id[i]; } }
    __builtin_amdgcn_fence(__ATOMIC_ACQ_REL, "wavefront"); __builtin_amdgcn_wave_barrier();
    kept_out = kept;
    return key2f(prefix);
}
DEV void ph_index(const Params& p, LAS char* lds, int wv, int qslot) {
    TID_DECL
    char* ws = p.ws; const int lane = tidx & 63, wid = tidx >> 6, c32 = lane & 31, hi = lane >> 5;
    const half_t* IQ = (const half_t*)(ws + OFF_IQ); const half_t* IK = (const half_t*)(ws + OFF_IK); const float* IW = (const float*)(ws + OFF_IW);
    u16* IDX = (u16*)(ws + OFF_IDX); int* CNT = (int*)(ws + OFF_CNT);
    LAS char* my = lds + wid * IDX_WAVE_LDS; LAS float* val = (LAS float*)my; LAS u16* idxb = (LAS u16*)(my + 4 * CAP * 4); LAS unsigned* hist = (LAS unsigned*)(my + 4 * CAP * 4 + 4 * CAP * 2);
    const unsigned ltm = (1u << c32) - 1u;
    unsigned* qctr = (unsigned*)(ws + OFF_CTRL) + 8192 + 64 * qslot;
    for (;;) {
        {
            int uq = 0; if (lane == 0) uq = (int)__hip_atomic_fetch_add(qctr, 1u, __ATOMIC_RELAXED, __HIP_MEMORY_SCOPE_AGENT);
            uq = __builtin_amdgcn_readfirstlane(uq); if (uq >= 4096) break;
            uq = 4095 - uq;
            const int tq0 = uq * 4;
            const int asel = (c32 >> 2) & 1, ah = (c32 & 3) + 4 * (c32 >> 3);
            h8 af[2][4]; float iw[2][16];
#pragma unroll
            for (int T = 0; T < 2; ++T) {
#pragma unroll
                for (int s = 0; s < 4; ++s) af[T][s] = *(const h8*)(IQ + (size_t)(tq0 + 2 * T + asel) * 1024 + ah * 64 + 16 * s + 8 * hi);
#pragma unroll
                for (int e = 0; e < 16; e += 4) { const f4 w4 = *(const f4*)(IW + (size_t)(tq0 + 2 * T + hi) * 16 + e); iw[T][e] = w4[0]; iw[T][e + 1] = w4[1]; iw[T][e + 2] = w4[2]; iw[T][e + 3] = w4[3]; } }
            float tau[2] = {-INFINITY, -INFINITY}; int cnt[2] = {0, 0};
#pragma unroll
            for (int T = 0; T < 2; ++T) { asm volatile("" :: "v"(af[T][0]), "v"(af[T][1]), "v"(af[T][2]), "v"(af[T][3]));
#pragma unroll
                for (int e = 0; e < 16; e += 4) asm volatile("" :: "v"(iw[T][e]), "v"(iw[T][e + 1]), "v"(iw[T][e + 2]), "v"(iw[T][e + 3])); }
            const int nkt = (tq0 + 3) / 32 + 1;
            h8 B0[4], B1[4], B2[4];
            const int ktl = nkt - 1;
#define IDX_GLD(dst, ptr) asm volatile("global_load_dwordx4 %0, %1, off" : "=v"(dst) : "v"(ptr) : "memory")
#define IDX_WAIT(n, b) asm volatile("s_waitcnt vmcnt(" #n ")" : "+v"(b[0]), "+v"(b[1]), "+v"(b[2]), "+v"(b[3]) :: "memory")
#pragma unroll
            for (int s = 0; s < 4; ++s) { IDX_GLD(B0[s], IK + (size_t)(s * 64 + lane) * 8); }
#pragma unroll
            for (int s = 0; s < 4; ++s) { IDX_GLD(B1[s], IK + (size_t)(((ktl < 1 ? ktl : 1) * 4 + s) * 64 + lane) * 8); }
            auto tile = [&](h8 (&bu)[4], h8 (&bl)[4], const int kt) {
                const int key = kt * 32 + c32; const int ktn = (kt + 2 < ktl) ? kt + 2 : ktl;
#pragma unroll
                for (int s = 0; s < 4; ++s) { IDX_GLD(bl[s], IK + (size_t)((ktn * 4 + s) * 64 + lane) * 8); }
                IDX_WAIT(8, bu);
                f16v acc[2];
#pragma unroll
                for (int T = 0; T < 2; ++T) { acc[T] = (f16v){0.f, 0.f, 0.f, 0.f, 0.f, 0.f, 0.f, 0.f, 0.f, 0.f, 0.f, 0.f, 0.f, 0.f, 0.f, 0.f};
#pragma unroll
                    for (int s = 0; s < 4; ++s) acc[T] = MFMA32(af[T][s], bu[s], acc[T]); }
#pragma unroll
                for (int T = 0; T < 2; ++T) { float v = 0.f;
#pragma unroll
                    for (int e = 0; e < 16; ++e)
                        v = __builtin_fmaf(__int_as_float(max(__float_as_int(acc[T][e]), 0)), iw[T][e], v);
                    const bool cand = (key <= tq0 + 2 * T + hi) && (v > tau[T]);
                    const unsigned long long bal = __ballot(cand);
                    if (bal) { const unsigned m32 = hi ? (unsigned)(bal >> 32) : (unsigned)bal; const int pos = cnt[T] + __popc(m32 & ltm);
                        if (cand) { val[(2 * T + hi) * CAP + pos] = v; idxb[(2 * T + hi) * CAP + pos] = (u16)key; }
                        cnt[T] += __popc(m32); } }
            };
            for (int kt = 0; kt < nkt;) {
                for (; kt < nkt; kt += 3) { tile(B0, B2, kt); tile(B1, B0, kt + 1); tile(B2, B1, kt + 2);
                    if (__ballot(cnt[0] > CAP - 96 || cnt[1] > CAP - 96)) { kt += 3; break; } }
                IDX_WAIT(0, B0); IDX_WAIT(0, B1); IDX_WAIT(0, B2);
                __builtin_amdgcn_fence(__ATOMIC_ACQ_REL, "wavefront"); __builtin_amdgcn_wave_barrier();
#pragma unroll
                for (int T = 0; T < 2; ++T)
#pragma unroll
                    for (int hh = 0; hh < 2; ++hh) { const int nq = __builtin_amdgcn_readlane(cnt[T], 32 * hh);
                        if (nq > CAP - 96) { const int q = 2 * T + hh; int kept; float tn = prune<2>(val + q * CAP, idxb + q * CAP, hist, nq, lane, kept);
                            if (kept > CAP - 128) tn = prune<4>(val + q * CAP, idxb + q * CAP, hist, kept, lane, kept);
                            if (hi == hh) { tau[T] = tn; cnt[T] = kept; } } }
            }
            __builtin_amdgcn_fence(__ATOMIC_ACQ_REL, "wavefront"); __builtin_amdgcn_wave_barrier();
#undef IDX_GLD
#undef IDX_WAIT
#pragma unroll
            for (int T = 0; T < 2; ++T)
#pragma unroll
                for (int hh = 0; hh < 2; ++hh) { const int q = 2 * T + hh; int nq = __builtin_amdgcn_readlane(cnt[T], 32 * hh);
                    if (nq > TOPK) { int kept; prune<4>(val + q * CAP, idxb + q * CAP, hist, nq, lane, kept); nq = kept; }
#pragma unroll
                    for (int i = 0; i < 4; ++i) { const int e = lane + 64 * i; IDX[(size_t)(tq0 + q) * 256 + e] = (e < nq) ? idxb[q * CAP + e] : (u16)0; }
                    if (lane == 0) CNT[tq0 + q] = nq; }
            __builtin_amdgcn_fence(__ATOMIC_ACQ_REL, "wavefront"); __builtin_amdgcn_wave_barrier();
        }
    }
}

constexpr int SP_LD = 264;
constexpr int SP_WAVE_LDS = 32 * SP_LD * 2 + 512;
DEV void tr_read8(h4 (&lo)[4], h4 (&hi)[4], unsigned a0) {
    asm volatile("ds_read_b64_tr_b16 %0, %8\n\tds_read_b64_tr_b16 %1, %8 offset:32\n\tds_read_b64_tr_b16 %2, %8 offset:64\n\tds_read_b64_tr_b16 %3, %8 offset:96\n\t"
                 "ds_read_b64_tr_b16 %4, %8 offset:%c9\n\tds_read_b64_tr_b16 %5, %8 offset:%c10\n\tds_read_b64_tr_b16 %6, %8 offset:%c11\n\tds_read_b64_tr_b16 %7, %8 offset:%c12\n\ts_waitcnt lgkmcnt(0)"
                 : "=&v"(lo[0]), "=&v"(lo[1]), "=&v"(lo[2]), "=&v"(lo[3]), "=&v"(hi[0]), "=&v"(hi[1]), "=&v"(hi[2]), "=&v"(hi[3])
                 : "v"(a0), "i"(16 * SP_LD * 2), "i"(16 * SP_LD * 2 + 32), "i"(16 * SP_LD * 2 + 64), "i"(16 * SP_LD * 2 + 96) : "memory");
}
DEV void ph_sparse(const Params& p, LAS char* lds, int wv, int qslot) {
    TID_DECL
    char* ws = p.ws; const int lane = tidx & 63, wid = tidx >> 6, r = lane & 15, g = lane >> 4;
    half_t* DQ = (half_t*)(ws + OFF_DQ); const half_t* C = (const half_t*)(ws + OFF_C); const u16* IDX = (const u16*)(ws + OFF_IDX); const int* CNT = (const int*)(ws + OFF_CNT);
    LAS half_t* tile = (LAS half_t*)(lds + wid * SP_WAVE_LDS); const unsigned tile_addr = (unsigned)(uintptr_t)tile;
    LAS u16* idl = (LAS u16*)(lds + wid * SP_WAVE_LDS + 32 * SP_LD * 2);
    const int grow = lane >> 5, gc = (lane & 31) * 8;
    unsigned* qctr = (unsigned*)(ws + OFF_CTRL) + 8192 + 64 * (4 + qslot);
    for (;;) {
      int qb4 = 0; if (lane == 0) qb4 = (int)__hip_atomic_fetch_add(qctr, 1u, __ATOMIC_RELAXED, __HIP_MEMORY_SCOPE_AGENT);
      qb4 = __builtin_amdgcn_readfirstlane(qb4); if (qb4 >= TB / 4) break;
      for (int t = 4 * qb4; t < 4 * qb4 + 4; ++t) {
        const int n = CNT[t];
        { typedef unsigned u32x2_t __attribute__((ext_vector_type(2))); *(LAS u32x2_t*)(idl + lane * 4) = *(const u32x2_t*)(IDX + (size_t)t * 256 + lane * 4); }
        h8 qf[8];
#pragma unroll
        for (int ks = 0; ks < 8; ++ks) qf[ks] = (r < 8) ? *(const h8*)(DQ + (size_t)t * 2048 + r * 256 + 32 * ks + 8 * g) : zero8();
        f4 ob[16];
#pragma unroll
        for (int ct = 0; ct < 16; ++ct) ob[ct] = (f4){0.f, 0.f, 0.f, 0.f};
        float mrun = -INFINITY, lpart = 0.f;
        const int nkb = (n + 31) >> 5;
        __builtin_amdgcn_fence(__ATOMIC_ACQ_REL, "wavefront"); __builtin_amdgcn_wave_barrier();
        h8 pre[16];
#pragma unroll
        for (int i = 0; i < 16; ++i) pre[i] = *(const h8*)(C + (size_t)idl[grow + 2 * i] * 256 + gc);
        for (int kb = 0; kb < nkb; ++kb) {
#pragma unroll
            for (int i = 0; i < 16; ++i) *(LAS h8*)(tile + (grow + 2 * i) * SP_LD + gc) = pre[i];
            if (kb + 1 < nkb) {
#pragma unroll
                for (int i = 0; i < 16; ++i) pre[i] = *(const h8*)(C + (size_t)idl[32 * (kb + 1) + grow + 2 * i] * 256 + gc); }
            __builtin_amdgcn_fence(__ATOMIC_ACQ_REL, "wavefront"); __builtin_amdgcn_wave_barrier();
            f4 s[2];
#pragma unroll
            for (int st = 0; st < 2; ++st) { s[st] = (f4){0.f, 0.f, 0.f, 0.f};
#pragma unroll
                for (int ks = 0; ks < 8; ++ks) { const h8 a = *(const LAS h8*)(tile + (16 * st + r) * SP_LD + 32 * ks + 8 * g); s[st] = MFMA16(a, qf[ks], s[st]); }
#pragma unroll
                for (int e = 0; e < 4; ++e) if (32 * kb + 16 * st + 4 * g + e >= n) s[st][e] = -INFINITY; }
            float mx = fmaxf(fmaxf(fmaxf(s[0][0], s[0][1]), fmaxf(s[0][2], s[0][3])), fmaxf(fmaxf(s[1][0], s[1][1]), fmaxf(s[1][2], s[1][3])));
            mx = gmax(lane, mx); const float mn = fmaxf(mrun, mx); const float sc = exp2f(mrun - mn); mrun = mn;
            float ps = 0.f; f4 pp[2];
#pragma unroll
            for (int st = 0; st < 2; ++st)
#pragma unroll
                for (int e = 0; e < 4; ++e) { pp[st][e] = exp2f(s[st][e] - mn); ps += pp[st][e]; }
            lpart = lpart * sc + ps;
            const h8 pb = cat44(toh4(pp[0]), toh4(pp[1]));
            const unsigned a0 = tile_addr + (unsigned)(((4 * g + (r >> 2)) * SP_LD + 4 * (r & 3)) * 2);
            asm volatile("s_waitcnt lgkmcnt(0)" ::: "memory");
#pragma unroll
            for (int c4 = 0; c4 < 4; ++c4) { h4 lo[4], hi4[4]; tr_read8(lo, hi4, a0 + c4 * 128);
#pragma unroll
                for (int j = 0; j < 4; ++j) { const int ct = c4 * 4 + j; ob[ct] = ob[ct] * sc; ob[ct] = MFMA16(cat44(lo[j], hi4[j]), pb, ob[ct]); } }
        }
        const float inv = 1.f / gsum(lane, lpart);
        __builtin_amdgcn_fence(__ATOMIC_ACQ_REL, "wavefront"); __builtin_amdgcn_wave_barrier();
        if (r < 8) {
#pragma unroll
            for (int ct = 0; ct < 16; ++ct) *(LAS h4*)(tile + r * 256 + 16 * ct + 4 * g) = toh4(ob[ct] * inv); }
        __builtin_amdgcn_fence(__ATOMIC_ACQ_REL, "wavefront"); __builtin_amdgcn_wave_barrier();
#pragma unroll
        for (int i = 0; i < 4; ++i) { const int ch = lane + 64 * i; *(h8*)(DQ + (size_t)t * 2048 + ch * 8) = *(const LAS h8*)(tile + ch * 8); }
        __builtin_amdgcn_fence(__ATOMIC_ACQ_REL, "wavefront"); __builtin_amdgcn_wave_barrier();
      }
    }
}

DEV void ph_final(const Params& p, int l, int b, int wv) {
    TID_DECL
    const float* X = p.x + (size_t)b * TB * 2048; float* O = p.out + (size_t)b * TB * 2048; half_t* XH = (half_t*)(p.ws + OFF_X1H) + (size_t)b * TB * 2048;
    const half_t* OUTP = (const half_t*)(p.ws + OFF_OUTP); const float* g = p.post_g + l * 2048;
    const int lane = tidx & 63, wid = tidx >> 6;
    for (int t = bidx * NWAVE + wid; t < TB; t += nblk * NWAVE) {
        f4 ov[8], xv[8]; float ss = 0.f;
#pragma unroll
        for (int i = 0; i < 8; ++i) { const size_t off = (size_t)t * 2048 + i * 256 + lane * 4; const h4 oh = *(const h4*)(OUTP + off);
            if (l == 0) xv[i] = *(const f4*)(X + off); else { const h4 xh = *(const h4*)(XH + off); xv[i] = (f4){(float)xh[0], (float)xh[1], (float)xh[2], (float)xh[3]}; }
            ov[i] = (f4){(float)oh[0], (float)oh[1], (float)oh[2], (float)oh[3]}; ss += ov[i][0] * ov[i][0] + ov[i][1] * ov[i][1] + ov[i][2] * ov[i][2] + ov[i][3] * ov[i][3]; }
        ss = wave_sum(lane, ss); const float rs = rsqrtf(ss * (1.f / 2048.f) + NORM_EPS);
#pragma unroll
        for (int i = 0; i < 8; ++i) { const size_t off = (size_t)t * 2048 + i * 256 + lane * 4; const f4 gg = *(const f4*)(g + i * 256 + lane * 4); const f4 r = xv[i] + ov[i] * rs * gg;
            if (l == DEPTH - 1) *(f4*)(O + off) = r; else *(h4*)(XH + off) = toh4(r); }
    }
}

#define XB_TMO      128
#define XB_XCNT(j)  (256  + 64 * (j))
#define XB_XSUB(j)  (1280 + 64 * (j))
#define XB_XGEN(j)  (2304 + 64 * (j))
#define XB_TOP      3328
#define XB_TOPGEN   3392
#define XCD_BAR_WORDS 3456
#define XB_SPIN_CAP (1u << 22)

__device__ __forceinline__ unsigned xb_ld(unsigned* p)              { return __hip_atomic_load(p, __ATOMIC_RELAXED, __HIP_MEMORY_SCOPE_AGENT); }
__device__ __forceinline__ unsigned xb_add(unsigned* p, unsigned v) { return __hip_atomic_fetch_add(p, v, __ATOMIC_RELAXED, __HIP_MEMORY_SCOPE_AGENT); }
__device__ __forceinline__ unsigned xb_xcc_id() { return (unsigned)__builtin_amdgcn_s_getreg((3 << 11) | 20) & 0xFu; }
#define XB_SPIN(cond, bar) do { unsigned _sp = 0; while (cond) { __builtin_amdgcn_s_sleep(1); \
    if ((++_sp & 255u) == 0u) { if (xb_ld(&(bar)[XB_TMO])) break; if (_sp > XB_SPIN_CAP) { atomicAdd(&(bar)[XB_TMO], 1u); break; } } } } while (0)

struct XcdBarrier {
    unsigned* bar; unsigned x;
    volatile LAS unsigned* st;
};

__device__ __forceinline__ XcdBarrier xcd_barrier_post(unsigned* bar, volatile LAS unsigned* st, const bool t0) {
    XcdBarrier b; b.bar = bar; b.x = xb_xcc_id(); b.st = st;
    if (t0) (void)xb_add(&bar[XB_XCNT(b.x)], 1u);
    return b;
}
__device__ __forceinline__ void xcd_barrier_complete(unsigned* bar, unsigned x, unsigned& nloc, unsigned& nx) {
    const unsigned G = gridDim.x * gridDim.y * gridDim.z;
    unsigned sum, cnt, mine, sp = 0u;
    for (;;) {
        sum = 0u; cnt = 0u; mine = 0u;
#pragma unroll
        for (unsigned j = 0; j < 16; ++j) { const unsigned c = xb_ld(&bar[XB_XCNT(j)]); sum += c; cnt += (c > 0u) ? 1u : 0u; mine = (j == x) ? c : mine; }
        if (sum == G) break;
        __builtin_amdgcn_s_sleep(1);
        if ((++sp & 255u) == 0u) { if (xb_ld(&bar[XB_TMO])) break; if (sp > XB_SPIN_CAP) { atomicAdd(&bar[XB_TMO], 1u); break; } }
    }
    nloc = mine > 0u ? mine : 1u; nx = cnt > 0u ? cnt : 1u;
}

__device__ __forceinline__ void xcd_barrier(const XcdBarrier& b, const bool t0) {
    asm volatile("s_waitcnt vmcnt(0)" ::: "memory");
    __syncthreads();
    if (t0) {
        unsigned* bar = b.bar;
        __builtin_amdgcn_s_waitcnt(0);
        unsigned nloc = b.st[0], nx = b.st[1];
        if (nloc == 0u) { xcd_barrier_complete(bar, b.x, nloc, nx); b.st[0] = nloc; b.st[1] = nx; }
        const unsigned old = xb_add(&bar[XB_XSUB(b.x)], 1u);
        const unsigned gen = old / nloc;
        if (old + 1u == (gen + 1u) * nloc) {
            __builtin_amdgcn_fence(__ATOMIC_RELEASE, "agent");
            asm volatile("s_waitcnt vmcnt(0)" ::: "memory");
            const unsigned og = xb_add(&bar[XB_TOP], 1u);
            const unsigned tg = og / nx;
            if (og + 1u == (tg + 1u) * nx) xb_add(&bar[XB_TOPGEN], 1u);
            else XB_SPIN(xb_ld(&bar[XB_TOPGEN]) == tg, bar);
            __builtin_amdgcn_fence(__ATOMIC_ACQUIRE, "agent");
            xb_add(&bar[XB_XGEN(b.x)], 1u);
            asm volatile("s_waitcnt vmcnt(0)" ::: "memory");
        } else {
            XB_SPIN(xb_ld(&bar[XB_XGEN(b.x)]) == gen, bar);
            __builtin_amdgcn_fence(__ATOMIC_ACQUIRE, "agent");
            asm volatile("s_waitcnt vmcnt(0)" ::: "memory");
        }
    }
    __syncthreads();
}

constexpr int LDS_BYTES = 147456;
constexpr int LDS_HDR_OFF = LDS_BYTES - 256;
static_assert(8 * SP_WAVE_LDS <= LDS_HDR_OFF && pg8::STAGE_BYTES <= LDS_HDR_OFF && 8 * IDX_WAVE_LDS <= LDS_HDR_OFF, "LDS map");
constexpr int PH_PER_B = 9, PH_PER_L = 1 + NB * PH_PER_B, PH_TOTAL = DEPTH * PH_PER_L;
template <class T> DEV T* ldptr(const LAS unsigned* w) {
    const unsigned lo = __builtin_amdgcn_readfirstlane(w[0]), hi = __builtin_amdgcn_readfirstlane(w[1]);
    const unsigned long long v = ((unsigned long long)hi << 32) | lo;
    return (T*)(__attribute__((address_space(1))) T*)v;
}
DEV Params ldp(const LAS unsigned* w_in) { Params q;
    const LAS unsigned* w = (const LAS unsigned*)(size_t)(unsigned)ls((int)(unsigned)(size_t)w_in);
    q.x = ldptr<const float>(w + 0); q.pre_g = ldptr<const float>(w + 2); q.w_in = ldptr<const float>(w + 4); q.da_lambda = ldptr<const float>(w + 6); q.da_norm_g = ldptr<const float>(w + 8);
    q.ml_conv_w = ldptr<const float>(w + 10); q.ml_conv_b = ldptr<const float>(w + 12); q.ml_gate_b = ldptr<const float>(w + 14); q.ml_norm_g = ldptr<const float>(w + 16);
    q.kv_norm_g = ldptr<const float>(w + 18); q.ik_norm_g = ldptr<const float>(w + 20); q.w_uv = ldptr<const float>(w + 22); q.w_branch = ldptr<const float>(w + 24); q.w_out = ldptr<const float>(w + 26);
    q.post_g = ldptr<const float>(w + 28); q.out = ldptr<float>(w + 30); q.ws = ldptr<char>(w + 32); q.ph_lo = 0; q.ph_hi = 0; return q; }
DEV void stptr(LAS unsigned* w, const void* ptr) { const unsigned long long v = (unsigned long long)ptr; w[0] = (unsigned)v; w[1] = (unsigned)(v >> 32); }
__global__ void __launch_bounds__(NTHREADS, 2) fwd(Params p0) {
    extern __shared__ __attribute__((aligned(16))) char lds_raw[];
    LAS char* lds = (LAS char*)lds_raw; LAS char* lds0 = lds + LDS_HDR_OFF;
    const int wv = __builtin_amdgcn_readfirstlane((int)threadIdx.x >> 6);
    LAS unsigned* pw = (LAS unsigned*)(lds0 + 64);
    if (threadIdx.x == 0) { LAS unsigned* z = (LAS unsigned*)lds0; z[0] = 0u; z[1] = 0u; z[2] = 0u; z[3] = 0u;
        stptr(pw + 0, p0.x); stptr(pw + 2, p0.pre_g); stptr(pw + 4, p0.w_in); stptr(pw + 6, p0.da_lambda); stptr(pw + 8, p0.da_norm_g); stptr(pw + 10, p0.ml_conv_w); stptr(pw + 12, p0.ml_conv_b);
        stptr(pw + 14, p0.ml_gate_b); stptr(pw + 16, p0.ml_norm_g); stptr(pw + 18, p0.kv_norm_g); stptr(pw + 20, p0.ik_norm_g); stptr(pw + 22, p0.w_uv); stptr(pw + 24, p0.w_branch); stptr(pw + 26, p0.w_out);
        stptr(pw + 28, p0.post_g); stptr(pw + 30, p0.out); stptr(pw + 32, p0.ws); }
    __syncthreads();
    { XcdBarrier bar0 = xcd_barrier_post((unsigned*)(p0.ws + OFF_CTRL), (volatile LAS unsigned*)lds0, threadIdx.x == 0); (void)bar0; }
#define SEAM(id) if ((id) + 1 < PH_TOTAL) { XcdBarrier bar; bar.bar = (unsigned*)(ldptr<char>((const LAS unsigned*)(size_t)(unsigned)ls((int)(unsigned)(size_t)(pw + 32))) + OFF_CTRL); bar.x = xb_xcc_id(); bar.st = (volatile LAS unsigned*)lds0; \
        xcd_barrier(bar, ls(wv) == 0 && lane_id_v() == 0); }
#define RUN(id) true
    for (int l_ = 0; l_ < DEPTH; ++l_) {
        const int b_ = 0;
        { const int id = l_ * PH_PER_L; if (RUN(id)) { const Params p = ldp(pw); const int l = ls(l_), b = ls(b_); (void)l; (void)b; ph_weights(p, l, lds, wv); } SEAM(id); }
        for (int b_ = 0; b_ < NB; ++b_) {
            const int id0 = l_ * PH_PER_L + 1 + b_ * PH_PER_B;
            if (RUN(id0 + 0)) { const Params p = ldp(pw); const int l = ls(l_), b = ls(b_); (void)l; (void)b; ph_h(p, l, b, wv); }
            SEAM(id0 + 0);
            if (RUN(id0 + 1)) { const Params p = ldp(pw); const int l = ls(l_), b = ls(b_); (void)l; (void)b; char* ws = p.ws; { EpiIn E{ws, 0}; gemm8((const half_t*)(ws + OFF_H), (const half_t*)(ws + OFF_WT), TB, N16, 2048, E, lds, wv); }
                { EpiIn8 E8{ws, 0}; gemm8<EpiIn8, true>((const half_t*)(ws + OFF_H8), (const half_t*)(ws + OFF_WT8), TB, N8 - 512, 1024, E8, lds, wv); } }
            SEAM(id0 + 1);
            if (RUN(id0 + 2)) { const Params p = ldp(pw); const int l = ls(l_), b = ls(b_); (void)l; (void)b; ph_post(p, l, wv); }
            SEAM(id0 + 2);
            if (RUN(id0 + 3)) { const Params p = ldp(pw); const int l = ls(l_), b = ls(b_); (void)l; (void)b; { char* ws = p.ws; EpiIn8 E8{ws, (N8 - 512) / 256}; gemm8<EpiIn8, true>((const half_t*)(ws + OFF_H8), (const half_t*)(ws + OFF_WT8) + (size_t)(N8 - 512) * 1024, TB, 512, 1024, E8, lds, wv); }
                ph_attn(p, lds, wv); ph_ml_state(p, lds, wv); ph_index(p, lds, wv, 2 * l + b); }
            SEAM(id0 + 3);
            if (RUN(id0 + 4)) { const Params p = ldp(pw); const int l = ls(l_), b = ls(b_); (void)l; (void)b; ph_attn_comb(p, l, wv); ph_ml_scan(p, wv); ph_sparse(p, lds, wv, 2 * l + b); }
            SEAM(id0 + 4);
            if (RUN(id0 + 5)) { const Params p = ldp(pw); const int l = ls(l_), b = ls(b_); (void)l; (void)b; ph_ml_out(p, l, lds, wv);
                char* ws = p.ws; EpiMulH E{(half_t*)(ws + OFF_IQ), (const half_t*)(ws + OFF_DZ), 1024}; gemm8((const half_t*)(ws + OFF_DQ), (const half_t*)(ws + OFF_WUVT), TB, 1024, 512, E, lds, wv, 2048, 512); }
            SEAM(id0 + 5);
            if (RUN(id0 + 6)) { const Params p = ldp(pw); const int l = ls(l_), b = ls(b_); (void)l; (void)b; char* ws = p.ws;
                const half_t* Y[3] = {(const half_t*)(ws + OFF_QA), (const half_t*)(ws + OFF_YB), (const half_t*)(ws + OFF_IQ)};
#pragma unroll
                for (int i = 0; i < 3; ++i) { EpiGate E{(half_t*)(ws + OFF_MIX), (const unsigned char*)(ws + OFF_G), i * 2048, i == 0};
                    gemm8(Y[i], (const half_t*)(ws + OFF_WBT) + (size_t)i * 2048 * 1024, TB, 2048, 1024, E, lds, wv); } }
            SEAM(id0 + 6);
            if (RUN(id0 + 7)) { const Params p = ldp(pw); const int l = ls(l_), b = ls(b_); (void)l; (void)b; char* ws = p.ws; EpiOut E{(half_t*)(ws + OFF_OUTP)}; gemm8((const half_t*)(ws + OFF_MIX), (const half_t*)(ws + OFF_WOT), TB, 2048, 2048, E, lds, wv); }
            SEAM(id0 + 7);
            if (RUN(id0 + 8)) { const Params p = ldp(pw); const int l = ls(l_), b = ls(b_); (void)l; (void)b; ph_final(p, l, b, wv); }
            SEAM(id0 + 8);
        }
    }
#undef RUN
#undef SEAM
}

extern "C" void kernel_launch(void* const* d_in, const int* in_sizes, int n_in, void* d_out, int out_size, void* d_ws, size_t ws_size, hipStream_t stream) {
    (void)in_sizes; (void)n_in; (void)out_size;
    if (ws_size < WS_NEED) { fprintf(stderr, "workspace too small: %zu < %zu\n", ws_size, (size_t)WS_NEED); return; }
    static int grid = 0;
    if (!grid) {
        (void)hipFuncSetAttribute((const void*)fwd, hipFuncAttributeMaxDynamicSharedMemorySize, LDS_BYTES);
        int dev = 0, cus = 0, per_cu = 0; (void)hipGetDevice(&dev); (void)hipDeviceGetAttribute(&cus, hipDeviceAttributeMultiprocessorCount, dev);
        (void)hipOccupancyMaxActiveBlocksPerMultiprocessor(&per_cu, fwd, NTHREADS, LDS_BYTES);
        grid = (per_cu >= 1 && cus >= 256) ? 256 : 0;
        if (!grid) { fprintf(stderr, "kernel does not fit a CU\n"); return; }
    }
    Params p{};
    p.x = (const float*)d_in[0]; p.pre_g = (const float*)d_in[1]; p.w_in = (const float*)d_in[2]; p.da_lambda = (const float*)d_in[3]; p.da_norm_g = (const float*)d_in[4];
    p.ml_conv_w = (const float*)d_in[5]; p.ml_conv_b = (const float*)d_in[6]; p.ml_gate_b = (const float*)d_in[7]; p.ml_norm_g = (const float*)d_in[8];
    p.kv_norm_g = (const float*)d_in[9]; p.ik_norm_g = (const float*)d_in[10]; p.w_uv = (const float*)d_in[11]; p.w_branch = (const float*)d_in[12]; p.w_out = (const float*)d_in[13]; p.post_g = (const float*)d_in[14];
    p.out = (float*)d_out; p.ws = (char*)d_ws; p.ph_lo = 0; p.ph_hi = PH_TOTAL;
    (void)hipMemsetAsync((char*)d_ws + OFF_CTRL, 0, 65536, stream);
    hipLaunchKernelGGL(fwd, dim3(grid), dim3(NTHREADS), LDS_BYTES, stream, p);
}
```

```cpp
#include <hip/hip_runtime.h>
#include <stdint.h>
#include <stdio.h>

typedef _Float16 half_t;
typedef _Float16 h8 __attribute__((ext_vector_type(8)));
typedef _Float16 h4 __attribute__((ext_vector_type(4)));
typedef float f4 __attribute__((ext_vector_type(4)));
typedef float f16v __attribute__((ext_vector_type(16)));
typedef unsigned short u16;
#define LAS __attribute__((address_space(3)))
#define DEV __device__ __forceinline__

constexpr int D_MODEL = 2048, NB = 2, SEQ = 16384, DEPTH = 2, TB = SEQ;
constexpr int N_IN_SRC = 18776, N_IN = 18944;
constexpr int N16 = 16 * 256, N8 = 58 * 256;
constexpr float NORM_EPS = 1e-6f;
constexpr float LOG2E = 1.4426950408889634f;
constexpr int NTHREADS = 512, NWAVE = 8;
constexpr int TOPK = 256;

constexpr size_t U1 = (size_t)TB * 1024 * 2;
constexpr size_t OFF_CTRL = 0;
constexpr size_t OFF_WT   = 1 << 20;
constexpr size_t OFF_WT8  = OFF_WT + (size_t)N16 * 2048 * 2;
constexpr size_t OFF_WS8  = OFF_WT8 + (size_t)N8 * 2048;
constexpr size_t OFF_WBT  = (OFF_WS8 + (size_t)N8 * 4 + 4095) / 4096 * 4096;
constexpr size_t OFF_WOT  = OFF_WBT + (size_t)3 * 2048 * 1024 * 2;
constexpr size_t OFF_WUVT = OFF_WOT + (size_t)2048 * 2048 * 2;
constexpr size_t OFF_H    = OFF_WUVT + (size_t)1024 * 512 * 2;

constexpr size_t OFF_QA   = OFF_H + 2 * U1;
constexpr size_t OFF_KA   = OFF_QA + U1;
constexpr size_t OFF_VAT  = OFF_KA + U1;
constexpr size_t OFF_MIX  = OFF_KA;
constexpr size_t OFF_ST16 = OFF_KA;
constexpr size_t OFF_ZA   = OFF_VAT + U1;
constexpr size_t OFF_MQKR = OFF_ZA + U1;
constexpr size_t OFF_MVT  = OFF_MQKR + U1;
constexpr size_t OFF_MO   = OFF_MVT + U1;
constexpr size_t OFF_MZ   = OFF_MO + U1;
constexpr size_t OFF_DQ   = OFF_MZ + U1;
constexpr size_t OFF_IQ   = OFF_DQ + 2 * U1;
constexpr size_t OFF_DZ   = OFF_IQ + U1;
constexpr size_t OFF_G    = OFF_DZ + U1;
constexpr size_t OFF_ST   = OFF_G + 3 * U1;
constexpr size_t OFF_OUTP = OFF_ST;

constexpr size_t OFF_CKV  = OFF_ST + 4 * U1;
constexpr size_t OFF_SM   = OFF_CKV + (size_t)TB * 256 * 4;
constexpr size_t OFF_C    = OFF_SM + (size_t)TB * 96 * 4;
constexpr size_t OFF_IK   = OFF_C + (size_t)TB * 256 * 2;
constexpr size_t OFF_IW   = OFF_IK + (size_t)TB * 64 * 2;
constexpr size_t OFF_MG   = OFF_IW + (size_t)TB * 16 * 4;
constexpr size_t OFF_IDX  = OFF_MG + (size_t)TB * 8 * 4;
constexpr size_t OFF_CNT  = OFF_IDX + (size_t)TB * 256 * 2;
constexpr size_t OFF_NV   = OFF_CNT + (size_t)TB * 4;
constexpr size_t OFF_DEC  = OFF_NV + (size_t)4 * 256 * 128 * 4;
constexpr size_t OFF_SS   = OFF_DEC + 4096;
constexpr size_t OFF_OA0  = OFF_SS + (size_t)TB * 4;
constexpr size_t OFF_OA1  = OFF_OA0 + U1;
constexpr size_t OFF_MQKC = OFF_OA1 + U1;
constexpr size_t OFF_YB   = OFF_MQKR;
constexpr size_t OFF_H8   = OFF_MQKC + U1;
constexpr size_t OFF_HS   = OFF_H8 + U1;
constexpr size_t OFF_X1H  = OFF_HS + (size_t)TB * 4;
constexpr size_t WS_NEED  = OFF_X1H + (size_t)NB * TB * 2048 * 2;

struct Params {
    const float *x, *pre_g, *w_in, *da_lambda, *da_norm_g, *ml_conv_w, *ml_conv_b, *ml_gate_b, *ml_norm_g, *kv_norm_g, *ik_norm_g, *w_uv, *w_branch, *w_out, *post_g;
    float* out;
    char* ws;
    int ph_lo, ph_hi;
};

DEV int lv(int v) { asm volatile("" : "+v"(v)); return v; }
DEV int ls(int v) { asm volatile("" : "+s"(v)); return v; }
DEV int lane_id_v() { int l; asm volatile("v_mbcnt_lo_u32_b32 %0, -1, 0\n\tv_mbcnt_hi_u32_b32 %0, -1, %0" : "=v"(l)); return l; }
#define TID_DECL const int tidx = lv((ls(wv) << 6) | lane_id_v()); const int bidx = ls((int)blockIdx.x); const int nblk = ls((int)gridDim.x); (void)tidx; (void)bidx; (void)nblk;
DEV float silu_f(float v) { return v * __builtin_amdgcn_rcpf(1.f + __expf(-v)); }
DEV float sigm_f(float v) { return __builtin_amdgcn_rcpf(1.f + __expf(-v)); }
DEV float shi(float v, int src) { return __int_as_float(__builtin_amdgcn_ds_bpermute(src << 2, __float_as_int(v))); }
DEV int shi(int v, int src) { return __builtin_amdgcn_ds_bpermute(src << 2, v); }
DEV unsigned shi(unsigned v, int src) { return (unsigned)__builtin_amdgcn_ds_bpermute(src << 2, (int)v); }
DEV float shx(int lane, float v, int m) { return shi(v, lane ^ m); }
DEV float wave_sum(int lane, float v) {
#pragma unroll
    for (int o = 32; o >= 1; o >>= 1) v += shx(lane, v, o);
    return v;
}
DEV float gsum(int lane, float v) { v += shx(lane, v, 16); v += shx(lane, v, 32); return v; }
DEV float gmax(int lane, float v) { v = fmaxf(v, shx(lane, v, 16)); v = fmaxf(v, shx(lane, v, 32)); return v; }
DEV h8 cat44(h4 a, h4 b) { return (h8){a[0], a[1], a[2], a[3], b[0], b[1], b[2], b[3]}; }
DEV h4 toh4(f4 v) { return (h4){(half_t)v[0], (half_t)v[1], (half_t)v[2], (half_t)v[3]}; }
DEV h8 zero8() { return (h8){0, 0, 0, 0, 0, 0, 0, 0}; }
#define MFMA16(a, b, c) __builtin_amdgcn_mfma_f32_16x16x32_f16((a), (b), (c), 0, 0, 0)
#define MFMA32(a, b, c) __builtin_amdgcn_mfma_f32_32x32x16_f16((a), (b), (c), 0, 0, 0)

DEV int in_src_col(int n) {
    if (n < 2048) return n;
    if (n < 2304) return n - 2048 + 10248;
    if (n < 3328) return n - 2304 + 10504;
    if (n < 3584) { const int c = n - 3328; return c < 64 ? 11528 + c : c < 80 ? 11592 + (c - 64) : c < 88 ? 6144 + (c - 80) : -1; }
    return n - 3584 + 8200;
}
DEV int in_src_col8(int n) {
    if (n < 1024) return 3072 + n;
    if (n < 2048) return 6152 + (n - 1024);
    if (n < 3072) return 7176 + (n - 2048);
    if (n < 4096) return 11608 + (n - 3072);
    if (n < 5120) return 2048 + (n - 4096);
    if (n < 6144) return n;
    if (n < 7168) return 4096 + (n - 6144);
    if (n < 13312) return 12632 + (n - 7168);
    return 8200 + 512 + (n - 13312);
}
template <class F> DEV void tr_tile(half_t* dst, int Kd, int n0, int k0, F src, LAS float* tile  , int tidx) {
    const int tid = tidx;
    __syncthreads();
#pragma unroll
    for (int j = 0; j < 8; ++j) { const int kk = (tid >> 6) + 8 * j, nn = tid & 63; tile[kk * 65 + nn] = src(k0 + kk, n0 + nn); }
    __syncthreads();
#pragma unroll
    for (int j = 0; j < 8; ++j) { const int nn = (tid >> 6) + 8 * j, kk = tid & 63; dst[(size_t)(n0 + nn) * Kd + k0 + kk] = (half_t)tile[kk * 65 + nn]; }
}
DEV void ph_weights(const Params& p, int l, LAS char* lds, int wv) {
    TID_DECL
    LAS float* tile = (LAS float*)lds;
    half_t* Wt = (half_t*)(p.ws + OFF_WT); half_t* Wbt = (half_t*)(p.ws + OFF_WBT); half_t* Wot = (half_t*)(p.ws + OFF_WOT); half_t* Wuvt = (half_t*)(p.ws + OFF_WUVT);
    const float* w_in = p.w_in + (size_t)l * 2048 * N_IN_SRC;
    const float* w_br = p.w_branch + (size_t)l * 3 * 1024 * 2048;
    const float* w_out = p.w_out + (size_t)l * 2048 * 2048;
    const float* w_uv = p.w_uv + (size_t)l * 8 * 256 * 128;
    constexpr int T_I8 = N8 / 64, T_IN = (N16 / 64) * 32, T_BR = 3 * 32 * 16, T_OUT = 32 * 32, T_UV = 16 * 8;
    for (int u0 = bidx; u0 < T_I8 + T_IN + T_BR + T_OUT + T_UV; u0 += nblk) {
        if (u0 < T_I8) {
            const int n0 = u0 * 64, nn = tidx & 63, kg = tidx >> 6; const int s = in_src_col8(n0 + nn);
            LAS float* red = tile + 64 * 65;
            float mx = 0.f;
            for (int kk = kg; kk < 2048; kk += 8) mx = fmaxf(mx, fabsf(w_in[(size_t)kk * N_IN_SRC + s]));
            __syncthreads(); red[kg * 64 + nn] = mx; __syncthreads();
            if (tidx < 64) { float m = red[nn];
#pragma unroll
                for (int j = 1; j < 8; ++j) m = fmaxf(m, red[j * 64 + nn]);
                red[512 + nn] = m > 0.f ? 127.f / m : 0.f; ((float*)(p.ws + OFF_WS8))[n0 + nn] = m * (1.f / 127.f); }
            __syncthreads();
            const float inv = red[512 + nn];
            unsigned char* W8 = (unsigned char*)(p.ws + OFF_WT8);
            for (int kt = 0; kt < 32; ++kt) {
                __syncthreads();
#pragma unroll
                for (int j = 0; j < 8; ++j) { const int kk = kg + 8 * j; tile[kk * 65 + nn] = w_in[(size_t)(kt * 64 + kk) * N_IN_SRC + s] * inv; }
                __syncthreads();
                const int n2 = tidx >> 3, kq = tidx & 7; unsigned w0 = 0u, w1 = 0u;
#pragma unroll
                for (int j = 0; j < 4; ++j) { w0 |= ((unsigned)(int)__builtin_rintf(tile[(8 * kq + j) * 65 + n2]) & 255u) << (8 * j); w1 |= ((unsigned)(int)__builtin_rintf(tile[(8 * kq + 4 + j) * 65 + n2]) & 255u) << (8 * j); }
                *(uint2*)(W8 + (size_t)(n0 + n2) * 2048 + kt * 64 + 8 * kq) = make_uint2(w0, w1);
            }
            continue;
        }
        const int u = u0 - T_I8;
        if (u < T_IN) { const int nt = u / 32, kt = u % 32;
            tr_tile(Wt, 2048, nt * 64, kt * 64, [&](int k, int n) { const int s = in_src_col(n); return s < 0 ? 0.f : w_in[(size_t)k * N_IN_SRC + s]; }, tile, tidx);
        } else if (u < T_IN + T_BR) { const int v = u - T_IN, i = v / 512, r = v % 512, nt = r / 16, kt = r % 16;
            const float* src = w_br + (size_t)i * 1024 * 2048;
            tr_tile(Wbt + (size_t)i * 2048 * 1024, 1024, nt * 64, kt * 64, [&](int k, int n) { return src[(size_t)k * 2048 + n]; }, tile, tidx);
        } else if (u < T_IN + T_BR + T_OUT) { const int v = u - T_IN - T_BR, nt = v / 32, kt = v % 32;
            tr_tile(Wot, 2048, nt * 64, kt * 64, [&](int k, int n) { return w_out[(size_t)k * 2048 + n]; }, tile, tidx);
        } else { const int v = u - T_IN - T_BR - T_OUT, nt = v / 8, kt = v % 8;
            tr_tile(Wuvt, 512, nt * 64, kt * 64, [&](int k, int n) { const int hh = n >> 7, vv = n & 127; const int c = k - (hh & 1) * 256; return (c >= 0 && c < 256) ? w_uv[((size_t)hh * 256 + c) * 128 + vv] : 0.f; }, tile, tidx);
        }
    }
}

DEV void ph_h(const Params& p, int l, int b, int wv) {
    TID_DECL
    const float* X = p.x + (size_t)b * TB * 2048; const half_t* XH = (const half_t*)(p.ws + OFF_X1H) + (size_t)b * TB * 2048;
    const float* g = p.pre_g + l * 2048;
    half_t* H = (half_t*)(p.ws + OFF_H); unsigned char* H8 = (unsigned char*)(p.ws + OFF_H8); float* HS = (float*)(p.ws + OFF_HS);
    const int lane = tidx & 63, wid = tidx >> 6;
    for (int t = bidx * NWAVE + wid; t < TB; t += nblk * NWAVE) {
        const float* xr = X + (size_t)t * 2048; f4 v[8]; float ss = 0.f;
#pragma unroll
        for (int i = 0; i < 8; ++i) { if (l == 0) v[i] = *(const f4*)(xr + i * 256 + lane * 4); else { const h4 xh = *(const h4*)(XH + (size_t)t * 2048 + i * 256 + lane * 4); v[i] = (f4){(float)xh[0], (float)xh[1], (float)xh[2], (float)xh[3]}; }
            ss += v[i][0] * v[i][0] + v[i][1] * v[i][1] + v[i][2] * v[i][2] + v[i][3] * v[i][3]; }
        ss = wave_sum(lane, ss); const float rs = rsqrtf(ss * (1.f / 2048.f) + NORM_EPS);
#pragma unroll
        for (int i = 0; i < 8; ++i) { const f4 gg = *(const f4*)(g + i * 256 + lane * 4); v[i] = v[i] * rs * gg; *(h4*)(H + (size_t)t * 2048 + i * 256 + lane * 4) = toh4(v[i]); }
        float mx = 0.f;
#pragma unroll
        for (int i = 0; i < 8; ++i) mx = fmaxf(fmaxf(mx, fmaxf(fabsf(v[i][0]), fabsf(v[i][1]))), fmaxf(fabsf(v[i][2]), fabsf(v[i][3])));
#pragma unroll
        for (int o = 32; o >= 1; o >>= 1) mx = fmaxf(mx, shx(lane, mx, o));
        const float inv = mx > 0.f ? 127.f / mx : 0.f;
#pragma unroll
        for (int i = 0; i < 8; ++i) { unsigned w = 0u;
#pragma unroll
            for (int e = 0; e < 4; ++e) w |= ((unsigned)(int)__builtin_rintf(v[i][e] * inv) & 255u) << (8 * e);
            *(unsigned*)(H8 + (size_t)t * 2048 + i * 256 + lane * 4) = w; }
        if (lane == 0) HS[t] = mx * (1.f / 127.f);
    }
}

template <class Epi> DEV void gemm_simple(const half_t* A, int lda, const half_t* Bt, int ldb, int M, int N, int K, int a_koff, const Epi& E, int wv) {
    TID_DECL
    const int lane = tidx & 63, wid = tidx >> 6, r = lane & 15, g = lane >> 4, wm = wid & 1, wn = wid >> 1;
    const int nM = M / 128, nN = N / 256;
    for (int u = bidx; u < nM * nN; u += nblk) {
        const int pn = u / nM, pm = u % nM; const int m0 = pm * 128 + wm * 64, n0 = pn * 256 + wn * 64;
        const half_t* Ab = A + (size_t)(m0 + r) * lda + (size_t)pn * a_koff + 8 * g;
        const half_t* Bb = Bt + (size_t)(n0 + r) * ldb + 8 * g;
        f4 acc[4][4];
#pragma unroll
        for (int i = 0; i < 4; ++i)
#pragma unroll
            for (int j = 0; j < 4; ++j) acc[i][j] = (f4){0.f, 0.f, 0.f, 0.f};
        for (int k0 = 0; k0 < K; k0 += 32) {
            h8 a[4], bb[4];
#pragma unroll
            for (int i = 0; i < 4; ++i) { a[i] = *(const h8*)(Ab + (size_t)i * 16 * lda + k0); bb[i] = *(const h8*)(Bb + (size_t)i * 16 * ldb + k0); }
#pragma unroll
            for (int i = 0; i < 4; ++i)
#pragma unroll
                for (int j = 0; j < 4; ++j) acc[i][j] = MFMA16(bb[j], a[i], acc[i][j]);
        }
#pragma unroll
        for (int i = 0; i < 4; ++i)
#pragma unroll
            for (int j = 0; j < 4; ++j) E.store4(m0 + 16 * i + r, n0 + 16 * j + 4 * g, acc[i][j]);
    }
}

struct EpiIn {
    char* ws; int pn_base;
    static constexpr bool HAS_TILE = true;
    template <int SEG> DEV void st(int row, int c, f4 v) const {
        if constexpr (SEG == 0) *(h4*)((half_t*)(ws + OFF_QA) + (size_t)row * 1024 + c) = toh4(v * (0.125f * LOG2E));
        else if constexpr (SEG == 1) *(h4*)((half_t*)(ws + OFF_KA) + (size_t)row * 1024 + c) = toh4(v);
        else if constexpr (SEG == 2) *(h4*)((half_t*)(ws + OFF_VAT) + (size_t)row * 1024 + c) = toh4(v);
        else if constexpr (SEG == 3) *(h4*)((half_t*)(ws + OFF_ZA) + (size_t)row * 1024 + c) = toh4((f4){silu_f(v[0]), silu_f(v[1]), silu_f(v[2]), silu_f(v[3])});
        else if constexpr (SEG == 4) *(h4*)((half_t*)(ws + OFF_MQKR) + (size_t)row * 1024 + c) = toh4(v);
        else if constexpr (SEG == 5) { half_t* d = (half_t*)(ws + OFF_MVT) + (size_t)c * TB + row;
#pragma unroll
            for (int e = 0; e < 4; ++e) d[(size_t)e * TB] = (half_t)v[e]; }
        else if constexpr (SEG == 6) *(h4*)((half_t*)(ws + OFF_MO) + (size_t)row * 1024 + c) = toh4((f4){sigm_f(v[0]), sigm_f(v[1]), sigm_f(v[2]), sigm_f(v[3])});
        else if constexpr (SEG == 7) *(h4*)((half_t*)(ws + OFF_MZ) + (size_t)row * 1024 + c) = toh4((f4){silu_f(v[0]), silu_f(v[1]), silu_f(v[2]), silu_f(v[3])});
        else if constexpr (SEG == 8) *(h4*)((half_t*)(ws + OFF_DQ) + (size_t)row * 2048 + c) = toh4(v * (0.0625f * LOG2E));
        else if constexpr (SEG == 9) *(f4*)((float*)(ws + OFF_CKV) + (size_t)row * 256 + c) = v;
        else if constexpr (SEG == 10) *(h4*)((half_t*)(ws + OFF_IQ) + (size_t)row * 1024 + c) = toh4(v);
        else if constexpr (SEG == 11) { if (c < 96) *(f4*)((float*)(ws + OFF_SM) + (size_t)row * 96 + c) = v; }
        else if constexpr (SEG == 12) *(h4*)((half_t*)(ws + OFF_DZ) + (size_t)row * 1024 + c) = toh4((f4){silu_f(v[0]), silu_f(v[1]), silu_f(v[2]), silu_f(v[3])});
        else *(h4*)((half_t*)(ws + OFF_G) + (size_t)row * 6144 + c) = toh4((f4){sigm_f(v[0]), sigm_f(v[1]), sigm_f(v[2]), sigm_f(v[3])});
    }
    DEV static h8 pack8(f4 a, f4 b) { return (h8){(half_t)a[0], (half_t)a[1], (half_t)a[2], (half_t)a[3], (half_t)b[0], (half_t)b[1], (half_t)b[2], (half_t)b[3]}; }
    DEV static f4 silu4(f4 v) { return (f4){silu_f(v[0]), silu_f(v[1]), silu_f(v[2]), silu_f(v[3])}; }
    DEV static f4 sigm4(f4 v) { return (f4){sigm_f(v[0]), sigm_f(v[1]), sigm_f(v[2]), sigm_f(v[3])}; }
    template <int SEG> DEV void st8(int row, int c, f4 a, f4 b) const {
        if constexpr (SEG == 0) __builtin_nontemporal_store(pack8(a * (0.125f * LOG2E), b * (0.125f * LOG2E)), (h8*)((half_t*)(ws + OFF_QA) + (size_t)row * 1024 + c));
        else if constexpr (SEG == 1) __builtin_nontemporal_store(pack8(a, b), (h8*)((half_t*)(ws + OFF_KA) + (size_t)row * 1024 + c));
        else if constexpr (SEG == 2) __builtin_nontemporal_store(pack8(a, b), (h8*)((half_t*)(ws + OFF_VAT) + (size_t)row * 1024 + c));
        else if constexpr (SEG == 3) __builtin_nontemporal_store(pack8(silu4(a), silu4(b)), (h8*)((half_t*)(ws + OFF_ZA) + (size_t)row * 1024 + c));
        else if constexpr (SEG == 4) __builtin_nontemporal_store(pack8(a, b), (h8*)((half_t*)(ws + OFF_MQKR) + (size_t)row * 1024 + c));
        else if constexpr (SEG == 5) __builtin_nontemporal_store(pack8(a, b), (h8*)((half_t*)(ws + OFF_MVT) + (size_t)row * 1024 + c));
        else if constexpr (SEG == 6) __builtin_nontemporal_store(pack8(sigm4(a), sigm4(b)), (h8*)((half_t*)(ws + OFF_MO) + (size_t)row * 1024 + c));
        else if constexpr (SEG == 7) __builtin_nontemporal_store(pack8(silu4(a), silu4(b)), (h8*)((half_t*)(ws + OFF_MZ) + (size_t)row * 1024 + c));
        else if constexpr (SEG == 8) __builtin_nontemporal_store(pack8(a * (0.0625f * LOG2E), b * (0.0625f * LOG2E)), (h8*)((half_t*)(ws + OFF_DQ) + (size_t)row * 2048 + c));
        else if constexpr (SEG == 10) __builtin_nontemporal_store(pack8(a, b), (h8*)((half_t*)(ws + OFF_IQ) + (size_t)row * 1024 + c));
        else if constexpr (SEG == 12) __builtin_nontemporal_store(pack8(silu4(a), silu4(b)), (h8*)((half_t*)(ws + OFF_DZ) + (size_t)row * 1024 + c));
        else if constexpr (SEG == 13) { const f4 sa = sigm4(a) * 255.f, sb = sigm4(b) * 255.f; typedef unsigned u32x2_t __attribute__((ext_vector_type(2)));
            unsigned w0 = 0u, w1 = 0u;
            w0 = __builtin_amdgcn_cvt_pk_u8_f32(sa[0], 0, w0); w0 = __builtin_amdgcn_cvt_pk_u8_f32(sa[1], 1, w0); w0 = __builtin_amdgcn_cvt_pk_u8_f32(sa[2], 2, w0); w0 = __builtin_amdgcn_cvt_pk_u8_f32(sa[3], 3, w0);
            w1 = __builtin_amdgcn_cvt_pk_u8_f32(sb[0], 0, w1); w1 = __builtin_amdgcn_cvt_pk_u8_f32(sb[1], 1, w1); w1 = __builtin_amdgcn_cvt_pk_u8_f32(sb[2], 2, w1); w1 = __builtin_amdgcn_cvt_pk_u8_f32(sb[3], 3, w1);
            __builtin_nontemporal_store((u32x2_t){w0, w1}, (u32x2_t*)((unsigned char*)(ws + OFF_G) + (size_t)row * 6144 + c)); }
        else { st<SEG>(row, c, a); st<SEG>(row, c + 4, b); }
    }
    template <int SEG> DEV void run(const f4 (&acc)[2][2][4][2], int row0, int c0) const {
#pragma unroll
        for (int ai = 0; ai < 2; ++ai)
#pragma unroll
            for (int m = 0; m < 4; ++m) { const int row = row0 + ai * 128 + m * 16;
                st8<SEG>(row, c0, acc[ai][0][m][0], acc[ai][0][m][1]); st8<SEG>(row, c0 + 128, acc[ai][1][m][0], acc[ai][1][m][1]); }
    }
    DEV void tile(const f4 (&acc)[2][2][4][2], int pm, int pn, int wr, int wc, int fr, int fq) const {
        const int t = __builtin_amdgcn_readfirstlane(pn) + pn_base; const int row0 = pm * 256 + wr * 64 + fr, cw = wc * 32 + 8 * fq;
        if (t < 4) run<0>(acc, row0, t * 256 + cw); else if (t < 8) run<1>(acc, row0, (t - 4) * 256 + cw); else if (t < 9) run<9>(acc, row0, cw);
        else if (t < 13) run<10>(acc, row0, (t - 9) * 256 + cw); else if (t < 14) run<11>(acc, row0, cw); else run<8>(acc, row0, (t - 14) * 256 + cw);
    }
};
struct EpiIn8 {
    char* ws; int pn_base;
    static constexpr bool HAS_TILE = true;
    DEV static f4 cvt(const f4& a, const f4& s) { return (f4){(float)__float_as_int(a[0]) * s[0], (float)__float_as_int(a[1]) * s[1], (float)__float_as_int(a[2]) * s[2], (float)__float_as_int(a[3]) * s[3]}; }
    template <int SEG> DEV void run(const f4 (&acc)[2][2][4][2], int row0, int c0, int cg) const {
        const EpiIn e{ws, 0}; const float* HS = (const float*)(ws + OFF_HS); const float* WS8 = (const float*)(ws + OFF_WS8);
        const f4 s00 = *(const f4*)(WS8 + cg), s01 = *(const f4*)(WS8 + cg + 4), s10 = *(const f4*)(WS8 + cg + 128), s11 = *(const f4*)(WS8 + cg + 132);
#pragma unroll
        for (int ai = 0; ai < 2; ++ai)
#pragma unroll
            for (int m = 0; m < 4; ++m) { const int row = row0 + ai * 128 + m * 16; const float hs = HS[row];
                e.template st8<SEG>(row, c0, cvt(acc[ai][0][m][0], s00 * hs), cvt(acc[ai][0][m][1], s01 * hs)); e.template st8<SEG>(row, c0 + 128, cvt(acc[ai][1][m][0], s10 * hs), cvt(acc[ai][1][m][1], s11 * hs)); }
    }
    DEV void tile(const f4 (&acc)[2][2][4][2], int pm, int pn, int wr, int wc, int fr, int fq) const {
        const int t = __builtin_amdgcn_readfirstlane(pn) + pn_base; const int row0 = pm * 256 + wr * 64 + fr, cw = wc * 32 + 8 * fq, cg = t * 256 + cw;
        if (t < 4) run<3>(acc, row0, t * 256 + cw, cg); else if (t < 8) run<6>(acc, row0, (t - 4) * 256 + cw, cg); else if (t < 12) run<7>(acc, row0, (t - 8) * 256 + cw, cg);
        else if (t < 16) run<12>(acc, row0, (t - 12) * 256 + cw, cg); else if (t < 20) run<2>(acc, row0, (t - 16) * 256 + cw, cg); else if (t < 24) run<5>(acc, row0, (t - 20) * 256 + cw, cg);
        else if (t < 28) run<4>(acc, row0, (t - 24) * 256 + cw, cg); else if (t < 52) run<13>(acc, row0, (t - 28) * 256 + cw, cg); else run<8>(acc, row0, (t - 50) * 256 + cw, cg);
    }
};
struct EpiMulH {
    static constexpr bool HAS_TILE = false;
    half_t* O; const half_t* Z; int ld;
    DEV void store8(int row, int col, f4 v0, f4 v1) const { const h8 z = *(const h8*)(Z + (size_t)row * ld + col);
        *(h8*)(O + (size_t)row * ld + col) = (h8){(half_t)(v0[0] * (float)z[0]), (half_t)(v0[1] * (float)z[1]), (half_t)(v0[2] * (float)z[2]), (half_t)(v0[3] * (float)z[3]),
                                                   (half_t)(v1[0] * (float)z[4]), (half_t)(v1[1] * (float)z[5]), (half_t)(v1[2] * (float)z[6]), (half_t)(v1[3] * (float)z[7])}; }
};
struct EpiGate {
    static constexpr bool HAS_TILE = false;
    half_t* MIXp; const unsigned char* G; int goff; bool first;
    DEV void store8(int row, int col, f4 v0, f4 v1) const { typedef unsigned u32x2_t __attribute__((ext_vector_type(2)));
        const u32x2_t gw = *(const u32x2_t*)(G + (size_t)row * 6144 + goff + col);
        float o[8];
#pragma unroll
        for (int e = 0; e < 4; ++e) { o[e] = v0[e] * ((float)((gw[0] >> (8 * e)) & 255u) * (1.f / 255.f)); o[4 + e] = v1[e] * ((float)((gw[1] >> (8 * e)) & 255u) * (1.f / 255.f)); }
        half_t* d = MIXp + (size_t)row * 2048 + col;
        if (!first) { const h8 pz = *(const h8*)d;
#pragma unroll
            for (int e = 0; e < 8; ++e) o[e] += (float)pz[e]; }
        h8 r8;
#pragma unroll
        for (int e = 0; e < 8; ++e) r8[e] = (half_t)o[e];
        *(h8*)d = r8; }
};
struct EpiOut {
    static constexpr bool HAS_TILE = false;
    half_t* O;
    DEV void store8(int row, int col, f4 v0, f4 v1) const {
        *(h8*)(O + (size_t)row * 2048 + col) = (h8){(half_t)v0[0], (half_t)v0[1], (half_t)v0[2], (half_t)v0[3], (half_t)v1[0], (half_t)v1[1], (half_t)v1[2], (half_t)v1[3]}; }
};

namespace pg8 {
#define PG8_LAS __attribute__((address_space(3)))
typedef unsigned short bf16_t;
typedef _Float16 bf16x8 __attribute__((ext_vector_type(8)));
typedef float f32x4 __attribute__((ext_vector_type(4)));
typedef unsigned u32x4 __attribute__((ext_vector_type(4)));
constexpr int BM = 256, BK = 64, HALF = 128, HTB = HALF * BK * 2  , STAGE_BYTES = 8 * HTB, NXCD = 8, WGM = 8;

__host__ __device__ __forceinline__ int lds_byte(int r, int c) { const int st = (r >> 4) * 2 + (c >> 5), rr = r & 15, cc = c & 31, ob = rr * 64 + cc * 2; return st * 1024 + (ob ^ (((ob >> 9) & 1) << 5)); }
__host__ __device__ __forceinline__ void stage_rc(int b, int& R, int& C) { const int st = b / 1024, sb = b % 1024, swz = sb ^ (((sb >> 9) & 1) << 5); R = (st >> 1) * 16 + swz / 64; C = (st & 1) * 32 + (swz % 64) / 2; }
__host__ __device__ __forceinline__ int perm32(int rho) { const int n = rho >> 4, i = rho & 15; return 8 * (i >> 2) + 4 * n + (i & 3); }

struct Unit { int pm, pn; };
struct Gemm { const bf16_t* A; const bf16_t* Bt; int M, N, K; int lda, a_koff; };

struct StaticOrder {
    int nM, nN, nwg, G, c;
    __host__ __device__ void init(int M, int N, int G_, int c_) { nM = M / BM; nN = N / BM; nwg = nM * nN; G = G_; c = c_; }
    __host__ __device__ bool next(int i, Unit& u) const {
        const long L = (long)i * G + c; if (L >= nwg) return false;
        int wgid = (int)L; { const int q = nwg / NXCD, r = nwg % NXCD, xcd = wgid % NXCD, off = wgid / NXCD; wgid = (xcd < r ? xcd * (q + 1) : r * (q + 1) + (xcd - r) * q) + off; }
        const int nig = WGM * nN, gid = wgid / nig, fm = gid * WGM, gsz = (nM - fm) < WGM ? (nM - fm) : WGM;
        u.pm = fm + ((wgid % nig) % gsz); u.pn = (wgid % nig) / gsz; return true;
    }
    __device__ __forceinline__ void a_ready(const Unit&) const {}
    __device__ __forceinline__ void done(const Unit&) const {}
};
typedef int i32x4 __attribute__((ext_vector_type(4)));
template <class Epi, class Sched, bool ALIGN_EPI = false, bool SP2 = false, bool I8 = false>
__device__ __forceinline__ void gemm_phase(PG8_LAS unsigned char* lds, const Gemm g, const Sched& S, const Epi& E, const int tid) {
    const int wid = __builtin_amdgcn_readfirstlane(tid >> 6), lane = tid & 63, wr = wid >> 2, wc = wid & 3, fr = lane & 15, fq = lane >> 4;
    const int K = g.K, nt = K / BK;
    unsigned voffA[2], voffB[2];
#pragma unroll
    for (int i = 0; i < 2; ++i) { int R, C; stage_rc(tid * 16 + i * 8192, R, C); const int Rb = Epi::PERM ? ((R & ~31) + perm32(R & 31)) : R;
        voffA[i] = (unsigned)(R * g.lda + C) * 2u; voffB[i] = (unsigned)(Rb * K + C) * 2u; }
    const size_t kstep = (size_t)(BK * 2);
    const size_t hstepA = (size_t)HALF * g.lda * 2, tstepA = 2 * hstepA, akoff = (size_t)g.a_koff * 2;
    const size_t hstep = (size_t)HALF * K * 2;
    const size_t tstep = 2 * hstep;
    const unsigned ldsw = (unsigned)wid * 1024u;
    const int aoff = lds_byte(wr * 64 + fr, fq * 8), boff = lds_byte(wc * 32 + fr, fq * 8);
#define PG8_SA(b, h) (((b) * 2 + (h)) * HTB)
#define PG8_SB(b, h) ((4 + (b) * 2 + (h)) * HTB)
#define PG8_STAGE(bufoff, gbase, voff) do { _Pragma("unroll") for (int _i = 0; _i < 2; ++_i) \
        __builtin_amdgcn_global_load_lds((const unsigned*)((const char*)(gbase) + (voff)[_i]), (PG8_LAS unsigned*)(lds + (bufoff) + ldsw + _i * 8192), 16, 0, 0); } while (0)
#define PG8_LDA(dst, b, h) do { _Pragma("unroll") for (int m = 0; m < 4; ++m) _Pragma("unroll") for (int k = 0; k < 2; ++k) dst[m][k] = *(const PG8_LAS bf16x8*)(lds + PG8_SA(b, h) + aoff + m * 2048 + k * 1024); } while (0)
#define PG8_LDB(dst, b, h) do { _Pragma("unroll") for (int n = 0; n < 2; ++n) _Pragma("unroll") for (int k = 0; k < 2; ++k) dst[n][k] = *(const PG8_LAS bf16x8*)(lds + PG8_SB(b, h) + boff + n * 2048 + k * 1024); } while (0)
#define PG8_MMA(ai, bj, At, Bt) do { __builtin_amdgcn_s_setprio(1); _Pragma("unroll") for (int m = 0; m < 4; ++m) _Pragma("unroll") for (int n = 0; n < 2; ++n) _Pragma("unroll") for (int k = 0; k < 2; ++k) \
        { if constexpr (I8) acc[ai][bj][m][n] = __builtin_bit_cast(f32x4, __builtin_amdgcn_mfma_i32_16x16x64_i8(__builtin_bit_cast(i32x4, Bt[n][k]), __builtin_bit_cast(i32x4, At[m][k]), __builtin_bit_cast(i32x4, acc[ai][bj][m][n]), 0, 0, 0)); \
          else acc[ai][bj][m][n] = __builtin_amdgcn_mfma_f32_16x16x32_f16(Bt[n][k], At[m][k], acc[ai][bj][m][n], 0, 0, 0); } __builtin_amdgcn_s_setprio(0); } while (0)
#define PG8_WAIT_V(n) asm volatile("s_waitcnt vmcnt(" #n ")" ::: "memory")
#define PG8_WAIT_L(n) asm volatile("s_waitcnt lgkmcnt(" #n ")" ::: "memory")
#define PG8_BAR __builtin_amdgcn_s_barrier()
#define PG8_SCHED __builtin_amdgcn_sched_barrier(0)
    Unit cur, nxt; int ui = 0;
    if (!S.next(0, cur)) return;
    f32x4 acc[2][2][4][2];
#pragma unroll
    for (int a = 0; a < 2; ++a)
#pragma unroll
        for (int b = 0; b < 2; ++b)
#pragma unroll
            for (int m = 0; m < 4; ++m)
#pragma unroll
                for (int n = 0; n < 2; ++n) acc[a][b][m][n] = (f32x4){0.f, 0.f, 0.f, 0.f};
    bf16x8 At[4][2], B0[2][2], B1[2][2];
    const char* cA = (const char*)g.A + (size_t)cur.pm * tstepA + (size_t)cur.pn * akoff; const char* cB = (const char*)g.Bt + (size_t)cur.pn * tstep;
    S.a_ready(cur);
    if constexpr (SP2) {
        PG8_STAGE(PG8_SB(0, 0), cB, voffB); PG8_STAGE(PG8_SB(0, 1), cB + hstep, voffB); PG8_STAGE(PG8_SA(0, 0), cA, voffA); PG8_STAGE(PG8_SA(0, 1), cA + hstepA, voffA);
        if (wr == 1) PG8_BAR;
        PG8_WAIT_V(2); PG8_BAR;
        PG8_STAGE(PG8_SB(1, 0), cB + kstep, voffB); PG8_STAGE(PG8_SA(1, 0), cA + kstep, voffA); PG8_STAGE(PG8_SB(1, 1), cB + hstep + kstep, voffB);
        PG8_WAIT_V(6); PG8_BAR;
    } else {
        PG8_STAGE(PG8_SB(0, 0), cB, voffB); PG8_STAGE(PG8_SA(0, 0), cA, voffA); PG8_STAGE(PG8_SB(0, 1), cB + hstep, voffB); PG8_STAGE(PG8_SA(0, 1), cA + hstepA, voffA);
        if (wr == 1) PG8_BAR;
        PG8_WAIT_V(4); PG8_BAR;
        PG8_STAGE(PG8_SB(1, 0), cB + kstep, voffB); PG8_STAGE(PG8_SA(1, 0), cA + kstep, voffA); PG8_STAGE(PG8_SB(1, 1), cB + hstep + kstep, voffB);
        PG8_WAIT_V(6); PG8_BAR;
    }
    for (;;) {
        const bool has_next = S.next(ui + 1, nxt);
        const char* nA = has_next ? (const char*)g.A + (size_t)nxt.pm * tstepA + (size_t)nxt.pn * akoff : cA; const char* nB = has_next ? (const char*)g.Bt + (size_t)nxt.pn * tstep : cB;
        for (int t = 0; t < nt; t += 2) {
            const bool last = (t == nt - 2);
            const char* a1 = cA + (size_t)(t + 1) * kstep;
            const char* a2 = last ? nA : cA + (size_t)(t + 2) * kstep; const char* b2 = last ? nB : cB + (size_t)(t + 2) * kstep;
            const char* a3 = a2 + kstep; const char* b3 = b2 + kstep;
            if (last && has_next) S.a_ready(nxt);
            if constexpr (SP2) {
            PG8_LDB(B0, 0, 0); PG8_LDB(B1, 0, 1); PG8_SCHED; PG8_LDA(At, 0, 0); PG8_STAGE(PG8_SA(1, 1), a1 + hstepA, voffA);
            PG8_WAIT_V(8); PG8_WAIT_L(0); PG8_BAR; PG8_MMA(0, 0, At, B0); PG8_MMA(0, 1, At, B1); PG8_BAR; PG8_SCHED;
            PG8_LDA(At, 0, 1); PG8_STAGE(PG8_SB(0, 0), b2, voffB); PG8_STAGE(PG8_SB(0, 1), b2 + hstep, voffB); PG8_STAGE(PG8_SA(0, 0), a2, voffA);
            PG8_WAIT_V(8); PG8_WAIT_L(0); PG8_BAR; PG8_MMA(1, 0, At, B0); PG8_MMA(1, 1, At, B1); PG8_BAR; PG8_SCHED;
            PG8_LDB(B0, 1, 0); PG8_LDB(B1, 1, 1); PG8_SCHED; PG8_LDA(At, 1, 0); PG8_STAGE(PG8_SA(0, 1), a2 + hstepA, voffA);
            PG8_WAIT_V(8); PG8_WAIT_L(0); PG8_BAR; PG8_MMA(0, 0, At, B0); PG8_MMA(0, 1, At, B1); PG8_BAR; PG8_SCHED;
            PG8_LDA(At, 1, 1); PG8_STAGE(PG8_SB(1, 0), b3, voffB); PG8_STAGE(PG8_SB(1, 1), b3 + hstep, voffB); PG8_STAGE(PG8_SA(1, 0), a3, voffA);
            PG8_WAIT_V(8); PG8_WAIT_L(0); PG8_BAR; PG8_MMA(1, 0, At, B0); PG8_MMA(1, 1, At, B1); PG8_BAR; PG8_SCHED;
            } else {
            PG8_LDB(B0, 0, 0); PG8_SCHED; PG8_LDA(At, 0, 0); PG8_STAGE(PG8_SA(1, 1), a1 + hstepA, voffA);
            PG8_WAIT_L(8); PG8_BAR; PG8_WAIT_L(0); PG8_MMA(0, 0, At, B0); PG8_BAR; PG8_SCHED;
            PG8_LDB(B1, 0, 1); PG8_STAGE(PG8_SB(0, 0), b2, voffB);
            PG8_BAR; PG8_WAIT_L(0); PG8_MMA(0, 1, At, B1); PG8_BAR;
            PG8_LDA(At, 0, 1); PG8_STAGE(PG8_SA(0, 0), a2, voffA);
            PG8_BAR; PG8_WAIT_L(0); PG8_MMA(1, 0, At, B0); PG8_BAR; PG8_SCHED;
            PG8_STAGE(PG8_SB(0, 1), b2 + hstep, voffB);
            PG8_WAIT_V(6); PG8_BAR; PG8_MMA(1, 1, At, B1); PG8_BAR;
            PG8_LDB(B0, 1, 0); PG8_SCHED; PG8_LDA(At, 1, 0); PG8_STAGE(PG8_SA(0, 1), a2 + hstepA, voffA);
            PG8_WAIT_L(8); PG8_BAR; PG8_WAIT_L(0); PG8_MMA(0, 0, At, B0); PG8_BAR; PG8_SCHED;
            PG8_LDB(B1, 1, 1); PG8_STAGE(PG8_SB(1, 0), b3, voffB);
            PG8_BAR; PG8_WAIT_L(0); PG8_MMA(0, 1, At, B1); PG8_BAR;
            PG8_LDA(At, 1, 1); PG8_STAGE(PG8_SA(1, 0), a3, voffA);
            PG8_BAR; PG8_WAIT_L(0); PG8_MMA(1, 0, At, B0); PG8_BAR; PG8_SCHED;
            PG8_STAGE(PG8_SB(1, 1), b3 + hstep, voffB);
            PG8_WAIT_V(6); PG8_BAR; PG8_MMA(1, 1, At, B1); PG8_BAR;
            }
        }
        if constexpr (ALIGN_EPI) { if (wr == 0) PG8_BAR; }
        if constexpr (!Epi::AFTER_DRAIN) { E(acc, cur, wr, wc, fr, fq); S.done(cur); }
        if (!has_next) break;
#pragma unroll
        for (int a = 0; a < 2; ++a)
#pragma unroll
            for (int b = 0; b < 2; ++b)
#pragma unroll
                for (int m = 0; m < 4; ++m)
#pragma unroll
                    for (int n = 0; n < 2; ++n) acc[a][b][m][n] = (f32x4){0.f, 0.f, 0.f, 0.f};
        cur = nxt; cA = nA; cB = nB; ++ui;
        if constexpr (ALIGN_EPI) { if (wr == 1) PG8_BAR; }
    }
    PG8_WAIT_V(0);
    if constexpr (!ALIGN_EPI) { if (wr == 0) PG8_BAR; }
    PG8_BAR;
    if constexpr (Epi::AFTER_DRAIN) { E.fused(acc, cur, wr, wc, fr, fq, lds, wid, lane); S.done(cur); }
#undef PG8_SA
#undef PG8_SB
#undef PG8_STAGE
#undef PG8_LDA
#undef PG8_LDB
#undef PG8_MMA
#undef PG8_WAIT_V
#undef PG8_WAIT_L
#undef PG8_BAR
#undef PG8_SCHED
}
}

template <class E4> struct EpiAdapt { static constexpr bool PERM = true, AFTER_DRAIN = false; E4 e;
    DEV void rowgrp(int row, int col, const pg8::f32x4& a00, const pg8::f32x4& a01, const pg8::f32x4& a10, const pg8::f32x4& a11) const {
        e.store8(row, col, a00, a01); e.store8(row, col + 128, a10, a11); }
    DEV void operator()(const pg8::f32x4 (&acc)[2][2][4][2], const pg8::Unit& u, int wr, int wc, int fr, int fq) const {
        if constexpr (E4::HAS_TILE) { e.tile(acc, u.pm, u.pn, wr, wc, fr, fq); }
        else {
        const int row0 = u.pm * 256 + wr * 64 + fr, col0 = u.pn * 256 + wc * 32 + 8 * fq;
#define EA_RG(ai, m) rowgrp(row0 + (ai) * 128 + (m) * 16, col0, acc[ai][0][m][0], acc[ai][0][m][1], acc[ai][1][m][0], acc[ai][1][m][1])
        EA_RG(0, 0); EA_RG(0, 1); EA_RG(0, 2); EA_RG(0, 3); EA_RG(1, 0); EA_RG(1, 1); EA_RG(1, 2); EA_RG(1, 3);
#undef EA_RG
        }
    }
};
template <class E4, bool I8 = false> DEV void gemm8(const half_t* A, const half_t* Bt, int M, int N, int K, const E4& e, LAS char* lds, int wv, int lda = 0, int a_koff = 0) {
    TID_DECL
    const pg8::Gemm g{(const pg8::bf16_t*)A, (const pg8::bf16_t*)Bt, M, N, K, lda ? lda : K, a_koff};
    pg8::StaticOrder S; S.init(M, N, nblk, bidx);
    const EpiAdapt<E4> E{e};
    pg8::gemm_phase<EpiAdapt<E4>, pg8::StaticOrder, true, true, I8>((LAS unsigned char*)lds, g, S, E, tidx);
}

DEV void ph_post(const Params& p, int l, int wv) {
    TID_DECL
    char* ws = p.ws; const int lane = tidx & 63, wid = tidx >> 6;
    const float* CKV = (const float*)(ws + OFF_CKV); const float* SM = (const float*)(ws + OFF_SM);
    half_t* C = (half_t*)(ws + OFF_C); half_t* IK = (half_t*)(ws + OFF_IK); float* IW = (float*)(ws + OFF_IW); float* MG = (float*)(ws + OFF_MG);
    const half_t* MQKR = (const half_t*)(ws + OFF_MQKR); half_t* MQKC = (half_t*)(ws + OFF_MQKC);
    const float* kvg = p.kv_norm_g + l * 256; const float* ikg = p.ik_norm_g + l * 64; const float* gb = p.ml_gate_b + l * 8;
    const float* cw = p.ml_conv_w + (size_t)l * 4 * 1024; const float* cb = p.ml_conv_b + l * 1024;
    for (int t = bidx * NWAVE + wid; t < TB; t += nblk * NWAVE) {
        { const f4 v = *(const f4*)(CKV + (size_t)t * 256 + lane * 4); float ss = wave_sum(lane, v[0] * v[0] + v[1] * v[1] + v[2] * v[2] + v[3] * v[3]);
          const float rs = rsqrtf(ss * (1.f / 256.f) + NORM_EPS); const f4 gg = *(const f4*)(kvg + lane * 4); *(h4*)(C + (size_t)t * 256 + lane * 4) = toh4(v * rs * gg); }
        { f4 v = (f4){0.f, 0.f, 0.f, 0.f}; if (lane < 24) v = *(const f4*)(SM + (size_t)t * 96 + lane * 4);
          float ss = (lane < 16) ? (v[0] * v[0] + v[1] * v[1] + v[2] * v[2] + v[3] * v[3]) : 0.f; ss = wave_sum(lane, ss);
          const float rs = rsqrtf(ss * (1.f / 64.f) + NORM_EPS);
          if (lane < 16) { const f4 gg = *(const f4*)(ikg + lane * 4);
              *(h4*)(IK + ((((size_t)(t >> 5) * 4 + (lane >> 2)) * 2 + ((lane >> 1) & 1)) * 32 + (t & 31)) * 8 + (lane & 1) * 4) = toh4(v * rs * gg); }
          else if (lane < 20) { *(f4*)(IW + (size_t)t * 16 + (lane - 16) * 4) = v * (1.f / 32.f); }
          else if (lane == 20) { const f4 bb = *(const f4*)(gb); *(f4*)(MG + (size_t)t * 8) = v + bb; }
          else if (lane == 21) { const f4 bb = *(const f4*)(gb + 4); f4 o;
#pragma unroll
              for (int e = 0; e < 4; ++e) { const float xg = v[e] + bb[e]; o[e] = fminf(xg, 0.f) - log1pf(__expf(-fabsf(xg))); }
              *(f4*)(MG + (size_t)t * 8 + 4) = o; }
        }
        { const int c0 = lane * 16; float acc[16];
#pragma unroll
          for (int e = 0; e < 16; ++e) acc[e] = cb[c0 + e];
#pragma unroll
          for (int j = 0; j < 4; ++j) { const int tt = t - 3 + j; if (tt >= 0) {
              const h8 x0 = *(const h8*)(MQKR + (size_t)tt * 1024 + c0), x1 = *(const h8*)(MQKR + (size_t)tt * 1024 + c0 + 8);
#pragma unroll
              for (int e = 0; e < 8; ++e) { acc[e] += cw[j * 1024 + c0 + e] * (float)x0[e]; acc[8 + e] += cw[j * 1024 + c0 + 8 + e] * (float)x1[e]; } } }
          const float sc = (c0 >= 512) ? 0.08838834764831845f : 1.f; h8 o0, o1;
#pragma unroll
          for (int e = 0; e < 8; ++e) { o0[e] = (half_t)(silu_f(acc[e]) * sc); o1[e] = (half_t)(silu_f(acc[8 + e]) * sc); }
          *(h8*)(MQKC + (size_t)t * 1024 + c0) = o0; *(h8*)(MQKC + (size_t)t * 1024 + c0 + 8) = o1;
        }
    }
}

namespace attn_body {
using bf16=_Float16;
using bf16x8=__attribute__((ext_vector_type(8)))short;
using s16x4=__attribute__((ext_vector_type(4)))short;
using f32x16=__attribute__((ext_vector_type(16)))float;
using u32x4=__attribute__((ext_vector_type(4)))unsigned;
using h8v=__attribute__((ext_vector_type(8)))_Float16;
#define MFMA_H(a,b,c,x,y,z) __builtin_amdgcn_mfma_f32_32x32x16_f16(__builtin_bit_cast(h8v,(a)),__builtin_bit_cast(h8v,(b)),(c),x,y,z)
constexpr int BATCH=1,NHEAD=16,SEQ=16384,D=64,DM=NHEAD*D;
constexpr int NW=8,QBLK=32,QB=QBLK*NW,KVBLK=64,NQB=SEQ/QB;
constexpr int ATTN_PITCH=DM, ATTN_UNIT_ROWS=QB;
__device__ __forceinline__ int crow(int r,int hi){return (r&3)+8*(r>>2)+4*hi;}
#define SBAR() __builtin_amdgcn_sched_barrier(0)
__device__ __forceinline__ void cmask(f32x16&p0,f32x16&p1,int jb,int qrel_in,int hi){
  const float NEG=-INFINITY; int kb=64*jb+4*hi, qrel=qrel_in; asm volatile("":"+v"(kb),"+v"(qrel));
  #pragma unroll
  for(int r=0;r<16;++r){int kv=kb+(r&3)+8*(r>>2); if(kv>qrel)p0[r]=NEG; if(kv+32>qrel)p1[r]=NEG;}
}

constexpr int NSLOT=3, SLOTB=8192;
constexpr int LDS_K=0, LDS_V=NSLOT*SLOTB, LDS_WS=2*NSLOT*SLOTB, LDS_OST=LDS_WS+NW*64*4, LDS_BYTES=LDS_OST+NW*4096;
constexpr float C2=0.125f*1.4426950408889634f;
__device__ __forceinline__ void glds16(const void*gsrc,unsigned lds_dst){unsigned keep;
  asm volatile("s_mov_b32 %0, m0\n\ts_mov_b32 m0, %2\n\ts_nop 0\n\tglobal_load_lds_dwordx4 %1, off\n\ts_mov_b32 m0, %0":"=&s"(keep):"v"(gsrc),"s"(lds_dst):"memory");}
__device__ __forceinline__ float max3f(float a,float b,float c){float r;asm("v_max3_f32 %0, %1, %2, %3":"=v"(r):"v"(a),"v"(b),"v"(c));return r;}
__device__ __forceinline__ float max2f(float a,float b){float r;asm("v_max_f32_e32 %0, %1, %2":"=v"(r):"v"(a),"v"(b));return r;}
__device__ __forceinline__ float fadd_s(float a,float b){float r;asm("v_add_f32_e32 %0, %1, %2":"=v"(r):"v"(a),"v"(b));return r;}
__device__ __forceinline__ float fsub_s(float a,float b){float r;asm("v_sub_f32_e32 %0, %1, %2":"=v"(r):"v"(a),"v"(b));return r;}
typedef float f32x2_t __attribute__((ext_vector_type(2))); typedef _Float16 bf16x2_t __attribute__((ext_vector_type(2)));
__device__ __forceinline__ unsigned cvtpk_s(float lo,float hi){f32x2_t v={lo,hi};bf16x2_t b=__builtin_convertvector(v,bf16x2_t);return __builtin_bit_cast(unsigned,b);}
#define WAIT_BAR(N) asm volatile("s_waitcnt vmcnt(" #N ") lgkmcnt(0)\n\ts_barrier":::"memory")

__device__ __forceinline__ void qkt(f32x16&p0,f32x16&p1,const char*Kslot,const bf16x8*qr,const f32x16&negm,int r32,int hi){
  const char*kb=Kslot+hi*1024+r32*16;
  #pragma unroll
  for(int d0=0;d0<4;++d0){
    const bf16x8 b0=*reinterpret_cast<const bf16x8*>(kb+d0*2048);
    const bf16x8 b1=*reinterpret_cast<const bf16x8*>(kb+d0*2048+512);
    if(d0==0){p0=MFMA_H(b0,qr[0],negm,0,0,0);p1=MFMA_H(b1,qr[0],negm,0,0,0);}
    else{p0=MFMA_H(b0,qr[d0],p0,0,0,0);p1=MFMA_H(b1,qr[d0],p1,0,0,0);}}
}
typedef __attribute__((address_space(3))) const char* lds_cptr;
typedef short v4i16_t __attribute__((ext_vector_type(4)));
__device__ __forceinline__ void kload8(bf16x8*kf,lds_cptr kp){
  kf[0]=*(const __attribute__((address_space(3))) bf16x8*)(kp);      kf[1]=*(const __attribute__((address_space(3))) bf16x8*)(kp+512);
  kf[2]=*(const __attribute__((address_space(3))) bf16x8*)(kp+2048); kf[3]=*(const __attribute__((address_space(3))) bf16x8*)(kp+2560);
  kf[4]=*(const __attribute__((address_space(3))) bf16x8*)(kp+4096); kf[5]=*(const __attribute__((address_space(3))) bf16x8*)(kp+4608);
  kf[6]=*(const __attribute__((address_space(3))) bf16x8*)(kp+6144); kf[7]=*(const __attribute__((address_space(3))) bf16x8*)(kp+6656);
}
__device__ __forceinline__ void kload2(bf16x8*kf,lds_cptr kp,int j){ kf[2*j]=*(const __attribute__((address_space(3))) bf16x8*)(kp+j*2048); kf[2*j+1]=*(const __attribute__((address_space(3))) bf16x8*)(kp+j*2048+512); }
__device__ __forceinline__ s16x4 vtr(lds_cptr p){ return __builtin_bit_cast(s16x4,__builtin_amdgcn_ds_read_tr16_b64_v4i16((__attribute__((address_space(3))) v4i16_t*)p)); }
__device__ __forceinline__ float rowmax(const f32x16&p0,const f32x16&p1){
  float a=max3f(p0[0],p0[1],p1[0]),b=max3f(p0[2],p0[3],p1[1]);a=max3f(a,p1[2],p1[3]);
  #pragma unroll
  for(int r=4;r<16;r+=4){a=max3f(a,p0[r],p0[r+1]);b=max3f(b,p0[r+2],p0[r+3]);a=max3f(a,p1[r],p1[r+1]);b=max3f(b,p1[r+2],p1[r+3]);}
  const float m=max2f(a,b);
  auto rr=__builtin_amdgcn_permlane32_swap(__float_as_uint(m),__float_as_uint(m),false,false);
  return max2f(__uint_as_float(rr[0]),__uint_as_float(rr[1]));
}
__device__ __forceinline__ void pv(f32x16*o,int vb,bf16x8 pa0,bf16x8 pa1,bf16x8 pa2,bf16x8 pa3){
  #pragma unroll
  for(int d0=0;d0<2;++d0){s16x4 lo[4],hi[4];
    #pragma unroll
    for(int ks=0;ks<4;++ks){
      asm volatile("ds_read_b64_tr_b16 %0,%1 offset:%c2":"=&v"(lo[ks]):"v"(vb),"i"(d0*4096+ks*1024):"memory");
      asm volatile("ds_read_b64_tr_b16 %0,%1 offset:%c2":"=&v"(hi[ks]):"v"(vb),"i"(d0*4096+ks*1024+512):"memory");}
    asm volatile("s_waitcnt lgkmcnt(0)":::"memory");SBAR();
    #define PK(k) (bf16x8){lo[k][0],lo[k][1],lo[k][2],lo[k][3],hi[k][0],hi[k][1],hi[k][2],hi[k][3]}
    o[d0]=MFMA_H(pa0,PK(0),o[d0],0,0,0);
    o[d0]=MFMA_H(pa1,PK(1),o[d0],0,0,0);
    o[d0]=MFMA_H(pa2,PK(2),o[d0],0,0,0);
    o[d0]=MFMA_H(pa3,PK(3),o[d0],0,0,0);
    #undef PK
  }
}

#ifndef ATTN_STORE16
#define ATTN_STORE16(p,v) (*(u32x4*)(p)=(v))
#endif
template<int THRL> __device__ __forceinline__ void attn_unit(int b,int h,int qb,const bf16*Q,const bf16*__restrict__ K,const bf16*__restrict__ V,bf16*O,char*shm,const int wv_in,const int vhalf){
  int tid=(wv_in<<6)|lane_id_v();
  const int lane=tid&63,r32=lane&31,hi=lane>>5; const int wid=__builtin_amdgcn_readfirstlane(tid>>6);
  const long rowbase=(long)b*SEQ; const int q0=qb*QB;
  const bf16*Qw=Q+(rowbase+q0+wid*QBLK)*DM+h*D;
  const bf16*Kh=K+rowbase*DM+h*D,*Vh=V+rowbase*DM+(h>>1)*128+vhalf*64;
  const unsigned lds0=(unsigned)(uintptr_t)shm;
  float*wsf=(float*)(shm+LDS_WS)+wid*64;
  const bf16*ksrc=Kh+(long)lane*DM+wid*8;
  const bf16*vsrc=Vh+(long)(16*(wid&3)+(lane>>2))*DM+(wid>>2)*32+(lane&3)*8;
  const unsigned kdst=lds0+LDS_K+wid*1024, vdst=lds0+LDS_V+wid*1024;
  #define DMA_K(t,slot) glds16(ksrc+(long)(t)*KVBLK*DM,(unsigned)__builtin_amdgcn_readfirstlane(kdst+(slot)))
  #define DMA_V(t,slot) glds16(vsrc+(long)(t)*KVBLK*DM,(unsigned)__builtin_amdgcn_readfirstlane(vdst+(slot)))
  const int vb0=(int)(lds0+LDS_V)+((lane>>4)&1)*32+(lane&3)*8+(4*hi+((lane&15)>>2))*64;
  const char*Kbase=shm+LDS_K; bf16x8 kf[8];
  const lds_cptr shm3=(lds_cptr)shm; const lds_cptr kp0=shm3+LDS_K+hi*1024+r32*16; const lds_cptr vp0=shm3+LDS_V+((lane>>4)&1)*32+(lane&3)*8+(4*hi+((lane&15)>>2))*64;
  const int NT=(q0+QB)/KVBLK;
  DMA_K(0,0);DMA_V(0,0);DMA_K(1,SLOTB);
  bf16x8 qr[4];
  #pragma unroll
  for(int d0=0;d0<4;++d0)qr[d0]=*reinterpret_cast<const bf16x8*>(&Qw[(long)r32*DM+d0*16+hi*8]);
  float mhat=0.f,l_reg=0.f;f32x16 o[2];o[0]=f32x16{};o[1]=f32x16{};f32x16 negm=f32x16{};asm volatile("":"+v"(negm));
  const int qrel=wid*QBLK+r32;
  #define CMASK(P0,P1,t) do{int jb_=(t)-(NT-4); if(jb_>=0)cmask(P0,P1,jb_,qrel,hi);}while(0)
  bool resc=false;
  #define START(P0,P1) do{ const float rm=rowmax(P0,P1); resc=false; \
    { const float dl=rm; mhat=fadd_s(mhat,dl); \
      _Pragma("unroll") for(int r=0;r<16;++r){P0[r]=fsub_s(P0[r],dl);P1[r]=fsub_s(P1[r],dl);} \
      _Pragma("unroll") for(int r=0;r<16;++r)negm[r]=-mhat; asm volatile("":"+v"(negm)); } \
    _Pragma("unroll") for(int r=0;r<16;++r)P0[r]=__builtin_amdgcn_exp2f(P0[r]); }while(0)
  #define RESC() do{ if(resc){ asm volatile("s_waitcnt lgkmcnt(0)":::"memory"); \
      _Pragma("unroll") for(int d_=0;d_<2;++d_) _Pragma("unroll") for(int r=0;r<16;++r)o[d_][r]*=wsf[crow(r,hi)]; } }while(0)
  f32x16 pA0,pA1,pB0,pB1;
  int sl_prev=0,sl_cur=0,sl_next=SLOTB;
  #define ROT() do{sl_prev=sl_cur;sl_cur=sl_next;sl_next=(sl_next==(NSLOT-1)*SLOTB)?0:sl_next+SLOTB;}while(0)
  DMA_K(2,2*SLOTB);
  WAIT_BAR(3);
  qkt(pA0,pA1,Kbase,qr,negm,r32,hi);asm volatile("s_nop 15\n\ts_nop 7":"+v"(pA0),"+v"(pA1));CMASK(pA0,pA1,0);
  START(pA0,pA1);
  _Pragma("unroll") for(int r=0;r<16;++r)pA1[r]=__builtin_amdgcn_exp2f(pA1[r]);
  WAIT_BAR(0);
  DMA_K(3,0);DMA_V(1,SLOTB);
  ROT();
  kload8(kf,kp0+sl_cur);
  WAIT_BAR(2);
  s16x4 vlo[8],vhi[8]; u32x4 pw0,pw1,pw2,pw3;
  #define PKW(P,B) cvtpk_s(P[B],P[B+1])
  #define PAF(k) __builtin_bit_cast(bf16x8,pw##k)
  #define VFR(i) (bf16x8){vlo[i][0],vlo[i][1],vlo[i][2],vlo[i][3],vhi[i][0],vhi[i][1],vhi[i][2],vhi[i][3]}
  #define PIN(x) asm volatile("":"+v"(x))
  #define MX3(a,b,c) __builtin_fmaxf(__builtin_fmaxf((a),(b)),(c))
  #define GAPA(MF,A0,A1,A2,A3,W0,W1,PW) do{ MF; sacc+=A0; sacc+=A1; sacc+=A2; sacc+=A3; PIN(sacc); W0; W1; PIN(PW); SBAR(); }while(0)
  #define EX(v) __builtin_amdgcn_exp2f(v)
  #define GAPB(MF,X,B) do{ MF; X[B]=EX(X[B]); X[B+1]=EX(X[B+1]); X[B+2]=EX(X[B+2]); X[B+3]=EX(X[B+3]); PIN(X); SBAR(); }while(0)
  #define VRD(i) do{ vlo[i]=vtr(vp_+(((i)>>2)*4096+((i)&3)*1024)); vhi[i]=vtr(vp_+(((i)>>2)*4096+((i)&3)*1024+512)); }while(0)
  #define KRD(G,j) do{ if(G){ kload2(kf,kp0+sl_next,j); SBAR(); } }while(0)
  #define STEP(C0,C1,P0,P1,t,GK,GV,GL) do{ SBAR(); \
    const lds_cptr vp_=vp0+sl_prev; \
    VRD(0); SBAR(); float sacc=(P0[0]+P0[1]); \
    GAPA(C0=MFMA_H(kf[0],qr[0],negm,0,0,0), P0[2],P0[3],P0[4],P0[5],     pw0[0]=PKW(P0,0), pw0[1]=PKW(P0,2), pw0); \
    VRD(4); SBAR(); GAPA(C1=MFMA_H(kf[1],qr[0],negm,0,0,0), P0[6],P0[7],P0[8],P0[9],     pw0[2]=PKW(P0,4), pw0[3]=PKW(P0,6), pw0); \
    VRD(1); SBAR(); GAPA(C0=MFMA_H(kf[2],qr[1],C0,0,0,0),   P0[10],P0[11],P0[12],P0[13], pw1[0]=PKW(P0,8), pw1[1]=PKW(P0,10), pw1); \
    VRD(5); SBAR(); GAPA(C1=MFMA_H(kf[3],qr[1],C1,0,0,0),   P0[14],P0[15],P1[0],P1[1],   pw1[2]=PKW(P0,12),pw1[3]=PKW(P0,14), pw1); \
    VRD(2); SBAR(); GAPA(C0=MFMA_H(kf[4],qr[2],C0,0,0,0),   P1[2],P1[3],P1[4],P1[5],     pw2[0]=PKW(P1,0), pw2[1]=PKW(P1,2), pw2); \
    VRD(6); SBAR(); GAPA(C1=MFMA_H(kf[5],qr[2],C1,0,0,0),   P1[6],P1[7],P1[8],P1[9],     pw2[2]=PKW(P1,4), pw2[3]=PKW(P1,6), pw2); \
    VRD(3); SBAR(); GAPA(C0=MFMA_H(kf[6],qr[3],C0,0,0,0),   P1[10],P1[11],P1[12],P1[13], pw3[0]=PKW(P1,8), pw3[1]=PKW(P1,10), pw3); \
    VRD(7); SBAR(); GAPA(C1=MFMA_H(kf[7],qr[3],C1,0,0,0),   P1[14],P1[15],0.f,0.f,       pw3[2]=PKW(P1,12),pw3[3]=PKW(P1,14), pw3); \
    l_reg+=sacc; \
    if(GK){DMA_K((t)+3,sl_cur);} if(GV){DMA_V((t)+1,sl_next);} \
    CMASK(C0,C1,t); \
    { float a=MX3(C0[0],C0[1],C1[0]),b=MX3(C0[2],C0[3],C1[1]); a=MX3(a,C1[2],C1[3]); \
      _Pragma("unroll") for(int r=4;r<16;r+=4){a=MX3(a,C0[r],C0[r+1]);b=MX3(b,C0[r+2],C0[r+3]);a=MX3(a,C1[r],C1[r+1]);b=MX3(b,C1[r+2],C1[r+3]);} \
      float rm=__builtin_fmaxf(a,b); { auto rr=__builtin_amdgcn_permlane32_swap(__float_as_uint(rm),__float_as_uint(rm),false,false); rm=__builtin_fmaxf(__uint_as_float(rr[0]),__uint_as_float(rr[1])); } \
      resc=false; \
      if(__builtin_expect(__any(rm>(float)THRL),0)){ const float dl=__builtin_fmaxf(rm,0.f); mhat+=dl; \
        _Pragma("unroll") for(int r=0;r<16;++r){C0[r]-=dl;C1[r]-=dl;} \
        _Pragma("unroll") for(int r=0;r<16;++r)negm[r]=-mhat; asm volatile("":"+v"(negm)); \
        const float f=__builtin_amdgcn_exp2f(-dl); l_reg*=f; { const int le_=lane_id_v(); if(le_<32)wsf[le_]=f; } resc=true; } } \
    SBAR(); \
    GAPB(o[0]=MFMA_H(PAF(0),VFR(0),o[0],0,0,0), C0,0); \
    GAPB(o[1]=MFMA_H(PAF(0),VFR(4),o[1],0,0,0), C0,4); \
    KRD(GL,0); GAPB(o[0]=MFMA_H(PAF(1),VFR(1),o[0],0,0,0), C0,8); \
    KRD(GL,1); GAPB(o[1]=MFMA_H(PAF(1),VFR(5),o[1],0,0,0), C0,12); \
    KRD(GL,2); GAPB(o[0]=MFMA_H(PAF(2),VFR(2),o[0],0,0,0), C1,0); \
    KRD(GL,3); GAPB(o[1]=MFMA_H(PAF(2),VFR(6),o[1],0,0,0), C1,4); \
    GAPB(o[0]=MFMA_H(PAF(3),VFR(3),o[0],0,0,0), C1,8); \
    GAPB(o[1]=MFMA_H(PAF(3),VFR(7),o[1],0,0,0), C1,12); \
    }while(0)
  int t=1;
  #undef CMASK
  #define CMASK(P0,P1,t) do{}while(0)
  for(;t+5<NT;t+=2){
    STEP(pB0,pB1,pA0,pA1,t,true,true,true);     WAIT_BAR(2); RESC(); ROT();
    STEP(pA0,pA1,pB0,pB1,t+1,true,true,true);   WAIT_BAR(2); RESC(); ROT();
  }
  #undef CMASK
  #define CMASK(P0,P1,t) do{int jb_=(t)-(NT-4); if(jb_>=0)cmask(P0,P1,jb_,qrel,hi);}while(0)
  #define ENDW(tt) do{ if((tt)+3<NT){WAIT_BAR(2);} else if((tt)+2<NT){WAIT_BAR(1);} else {WAIT_BAR(0);} }while(0)
  for(;t+1<NT;t+=2){
    STEP(pB0,pB1,pA0,pA1,t,(t+3<NT),(t+1<NT),(t+1<NT));       ENDW(t);   RESC(); ROT();
    STEP(pA0,pA1,pB0,pB1,t+1,(t+4<NT),(t+2<NT),(t+2<NT));     ENDW(t+1); RESC(); ROT();
  }
  STEP(pB0,pB1,pA0,pA1,NT-1,false,false,false); RESC();
  { float sacc=pB0[0]+pB0[1]; _Pragma("unroll") for(int r=2;r<16;++r)sacc+=pB0[r]; _Pragma("unroll") for(int r=0;r<16;++r)sacc+=pB1[r]; l_reg+=sacc;
    pw0=(u32x4){PKW(pB0,0),PKW(pB0,2),PKW(pB0,4),PKW(pB0,6)};pw1=(u32x4){PKW(pB0,8),PKW(pB0,10),PKW(pB0,12),PKW(pB0,14)};pw2=(u32x4){PKW(pB1,0),PKW(pB1,2),PKW(pB1,4),PKW(pB1,6)};pw3=(u32x4){PKW(pB1,8),PKW(pB1,10),PKW(pB1,12),PKW(pB1,14)};
    SBAR(); pv(o,vb0+sl_cur,PAF(0),PAF(1),PAF(2),PAF(3)); }
  #undef PKW
  #undef PAF
  #undef VFR
  #undef PIN
  #undef MX3
  #undef GAPA
  #undef GAPB
  #undef EX
  #undef VRD
  #undef KRD
  #undef STEP
  #undef ENDW
  {auto rr=__builtin_amdgcn_permlane32_swap(__float_as_uint(l_reg),__float_as_uint(l_reg),false,false);l_reg=__uint_as_float(rr[0])+__uint_as_float(rr[1]);}
  if(hi==0)wsf[32+r32]=l_reg;asm volatile("s_waitcnt lgkmcnt(0)":::"memory");
  int tide=(wv_in<<6)|lane_id_v();
  const int lane_e=tide&63,r32_e=lane_e&31,hi_e=lane_e>>5;
  float rli[16];
  #pragma unroll
  for(int r=0;r<16;++r)rli[r]=__builtin_amdgcn_rcpf(wsf[32+crow(r,hi_e)]);
  bf16*Ow=O+(rowbase+q0+wid*QBLK)*DM+h*D;
  { bf16*stg=(bf16*)(shm+LDS_OST)+wid*2048;
    #pragma unroll
    for(int r=0;r<16;++r){const int orow=crow(r,hi_e);
      #pragma unroll
      for(int d0=0;d0<2;++d0)stg[orow*64+d0*32+r32_e]=(bf16)(o[d0][r]*rli[r]);}
    asm volatile("s_waitcnt lgkmcnt(0)":::"memory");
    #pragma unroll
    for(int i=0;i<4;++i){const int row=i*8+(lane_e>>3),ch=lane_e&7; const u32x4 v=*(const u32x4*)(stg+row*64+ch*8); ATTN_STORE16(Ow+(long)row*DM+ch*8,v);} }
  asm volatile("s_waitcnt lgkmcnt(0)\n\ts_barrier":::"memory");
  #undef DMA_K
  #undef DMA_V
  #undef CMASK
  #undef START
  #undef RESC
  #undef ROT
}
constexpr int ATTN_LDS_BYTES=LDS_BYTES;
struct AttnTensors { const bf16* Q; const bf16* K; const bf16* V; bf16* O; };
struct AttnUnit { int bh; int qb; };
struct StaticOrder {
  int vcu;
  __device__ __forceinline__ explicit StaticOrder(int grid,int block):vcu((block%8)*(grid/8)+block/8){}
  __device__ __forceinline__ bool next(int i,AttnUnit&u)const{ if(i>=4)return false; const int s=vcu&15; u.bh=vcu>>4; u.qb=(i==0)?s:(i==1)?31-s:(i==2)?32+s:63-s; return true; }
  __device__ __forceinline__ void a_ready(const AttnUnit&)const{}
  __device__ __forceinline__ void done(const AttnUnit&)const{}
};
template<class Sched,int THRL=8> __device__ __forceinline__ void attn_phase(char*lds,const AttnTensors&T,const Sched&S,const int wv_in,const int vhalf){
  AttnUnit u;
  for(int i=0;S.next(i,u);++i){ S.a_ready(u); attn_unit<THRL>(u.bh/NHEAD,u.bh%NHEAD,u.qb,T.Q,T.K,T.V,T.O,lds,wv_in,vhalf); S.done(u); }
}
#undef SBAR
#undef WAIT_BAR
}
namespace attn128 {
using namespace attn_body;
#define SBAR() __builtin_amdgcn_sched_barrier(0)
#define WAIT_BAR(N) asm volatile("s_waitcnt vmcnt(" #N ") lgkmcnt(0)\n\ts_barrier":::"memory")
constexpr int VSLOTB=16384, OPITCH=2048;
constexpr int L_K=0, L_V=NSLOT*SLOTB, L_WS=L_V+NSLOT*VSLOTB, L_OST=L_WS+NW*64*4, L_BYTES=L_OST+NW*4096;
typedef __attribute__((address_space(3))) char* lds_ptr;
__device__ __forceinline__ void pv128(f32x16*o,int vb,bf16x8 pa0,bf16x8 pa1,bf16x8 pa2,bf16x8 pa3){
  #pragma unroll
  for(int d0=0;d0<4;++d0){s16x4 lo[4],hi[4];
    #pragma unroll
    for(int ks=0;ks<4;++ks){
      asm volatile("ds_read_b64_tr_b16 %0,%1 offset:%c2":"=&v"(lo[ks]):"v"(vb),"i"(d0*4096+ks*1024):"memory");
      asm volatile("ds_read_b64_tr_b16 %0,%1 offset:%c2":"=&v"(hi[ks]):"v"(vb),"i"(d0*4096+ks*1024+512):"memory");}
    asm volatile("s_waitcnt lgkmcnt(0)":::"memory");SBAR();
    #define PK(k) (bf16x8){lo[k][0],lo[k][1],lo[k][2],lo[k][3],hi[k][0],hi[k][1],hi[k][2],hi[k][3]}
    o[d0]=MFMA_H(pa0,PK(0),o[d0],0,0,0);
    o[d0]=MFMA_H(pa1,PK(1),o[d0],0,0,0);
    o[d0]=MFMA_H(pa2,PK(2),o[d0],0,0,0);
    o[d0]=MFMA_H(pa3,PK(3),o[d0],0,0,0);
    #undef PK
  }
}
template<int THRL> __device__ __forceinline__ void attn_unit(int h,int qb,const bf16*Q,const bf16*__restrict__ K,const bf16*__restrict__ V,bf16*O,char*shm,const int wv_in){
  int tid=(wv_in<<6)|lane_id_v();
  const int lane=tid&63,r32=lane&31,hi=lane>>5; const int wid=__builtin_amdgcn_readfirstlane(tid>>6);
  const int q0=qb*QB;
  const bf16*Qw=Q+(long)(q0+wid*QBLK)*DM+h*D;
  const bf16*Kh=K+h*D,*Vh=V+(h>>1)*128;
  const unsigned lds0=(unsigned)(uintptr_t)shm;
  float*wsf=(float*)(shm+L_WS)+wid*64;
  const bf16*ksrc=Kh+(long)lane*DM+wid*8;
  const bf16*vsrc=Vh+(long)(16*(wid&3)+(lane>>2))*DM+(wid>>2)*32+(lane&3)*8;
  const unsigned kdst=lds0+L_K+wid*1024, vdst=lds0+L_V+wid*1024;
  #define DMA_K(t,slot) glds16(ksrc+(long)(t)*KVBLK*DM,(unsigned)__builtin_amdgcn_readfirstlane(kdst+(slot)))
  #define DMA_V(t,slot) do{ glds16(vsrc+(long)(t)*KVBLK*DM,(unsigned)__builtin_amdgcn_readfirstlane(vdst+2*(slot))); glds16(vsrc+(long)(t)*KVBLK*DM+64,(unsigned)__builtin_amdgcn_readfirstlane(vdst+2*(slot)+8192)); }while(0)
  const int vb0=(int)(lds0+L_V)+((lane>>4)&1)*32+(lane&3)*8+(4*hi+((lane&15)>>2))*64;
  const char*Kbase=shm+L_K; bf16x8 kf[8];
  const lds_cptr shm3=(lds_cptr)shm; const lds_cptr kp0=shm3+L_K+hi*1024+r32*16; const lds_cptr vp0=shm3+L_V+((lane>>4)&1)*32+(lane&3)*8+(4*hi+((lane&15)>>2))*64;
  const lds_cptr qp=shm3+L_OST+wid*4096+lane*16;
  #define QLD(d0) (*(const __attribute__((address_space(3))) bf16x8*)(qp+(d0)*1024))
  const int NT=(q0+QB)/KVBLK;
  DMA_K(0,0);DMA_V(0,0);DMA_K(1,SLOTB);
  float mhat=0.f,l_reg=0.f;f32x16 o[4];o[0]=f32x16{};o[1]=f32x16{};o[2]=f32x16{};o[3]=f32x16{};
  const f32x16 zero16=f32x16{}; f32x16 negm=f32x16{};asm volatile("":"+v"(negm));
  const int qrel=wid*QBLK+r32;
  #define CMASK(P0,P1,t) do{int jb_=(t)-(NT-4); if(jb_>=0)cmask(P0,P1,jb_,qrel,hi);}while(0)
  bool resc=false;
  #define START(P0,P1) do{ const float rm=rowmax(P0,P1); resc=false; \
    { const float dl=rm; mhat=fadd_s(mhat,dl); \
      _Pragma("unroll") for(int r=0;r<16;++r){P0[r]=fsub_s(P0[r],dl);P1[r]=fsub_s(P1[r],dl);} \
      _Pragma("unroll") for(int r=0;r<16;++r)negm[r]=-mhat; asm volatile("":"+v"(negm)); } \
    _Pragma("unroll") for(int r=0;r<16;++r)P0[r]=__builtin_amdgcn_exp2f(P0[r]); }while(0)
  #define RESC() do{ if(resc){ asm volatile("s_waitcnt lgkmcnt(0)":::"memory"); \
      _Pragma("unroll") for(int d_=0;d_<4;++d_) _Pragma("unroll") for(int r=0;r<16;++r)o[d_][r]*=wsf[crow(r,hi)]; } }while(0)
  f32x16 pA0,pA1,pB0,pB1;
  int sl_prev=0,sl_cur=0,sl_next=SLOTB;
  #define ROT() do{sl_prev=sl_cur;sl_cur=sl_next;sl_next=(sl_next==(NSLOT-1)*SLOTB)?0:sl_next+SLOTB;}while(0)
  {
    bf16x8 qr[4];
    #pragma unroll
    for(int d0=0;d0<4;++d0)qr[d0]=*reinterpret_cast<const bf16x8*>(&Qw[(long)r32*DM+d0*16+hi*8]);
    DMA_K(2,2*SLOTB);
    WAIT_BAR(4);
    qkt(pA0,pA1,Kbase,qr,zero16,r32,hi);asm volatile("s_nop 15\n\ts_nop 7":"+v"(pA0),"+v"(pA1));CMASK(pA0,pA1,0);
    #pragma unroll
    for(int d0=0;d0<4;++d0)*(__attribute__((address_space(3))) bf16x8*)((lds_ptr)qp+d0*1024)=qr[d0];
  }
  START(pA0,pA1);
  _Pragma("unroll") for(int r=0;r<16;++r)pA1[r]=__builtin_amdgcn_exp2f(pA1[r]);
  WAIT_BAR(0);
  DMA_K(3,0);DMA_V(1,SLOTB);
  ROT();
  kload8(kf,kp0+sl_cur);
  WAIT_BAR(3);
  s16x4 vlo[8],vhi[8]; u32x4 pw0,pw1,pw2,pw3;
  #define PKW(P,B) cvtpk_s(P[B],P[B+1])
  #define PAF(k) __builtin_bit_cast(bf16x8,pw##k)
  #define VFR(i) (bf16x8){vlo[i][0],vlo[i][1],vlo[i][2],vlo[i][3],vhi[i][0],vhi[i][1],vhi[i][2],vhi[i][3]}
  #define PIN(x) asm volatile("":"+v"(x))
  #define MX3(a,b,c) __builtin_fmaxf(__builtin_fmaxf((a),(b)),(c))
  #define GAPA(MF,A0,A1,A2,A3,W0,W1,PW) do{ MF; sacc+=A0; sacc+=A1; sacc+=A2; sacc+=A3; PIN(sacc); W0; W1; PIN(PW); SBAR(); }while(0)
  #define EX(v) __builtin_amdgcn_exp2f(v)
  #define GAPB(MF,X,B) do{ MF; X[B]=EX(X[B]); X[B+1]=EX(X[B+1]); PIN(X); SBAR(); }while(0)
  #define VRD(i) do{ vlo[i]=vtr(vp_+(((i)>>2)*4096+((i)&3)*1024)); vhi[i]=vtr(vp_+(((i)>>2)*4096+((i)&3)*1024+512)); }while(0)
  #define VRD2(i) do{ vlo[i]=vtr(vp_+((2+((i)>>2))*4096+((i)&3)*1024)); vhi[i]=vtr(vp_+((2+((i)>>2))*4096+((i)&3)*1024+512)); SBAR(); }while(0)
  #define KRD(G,j) do{ if(G){ kload2(kf,kp0+sl_next,j); SBAR(); } }while(0)
  #define STEP(C0,C1,P0,P1,t,GK,GV,GL) do{ SBAR(); \
    const lds_cptr vp_=vp0+2*sl_prev; \
    const bf16x8 q0_=QLD(0),q1_=QLD(1),q2_=QLD(2),q3_=QLD(3); \
    VRD(0); SBAR(); float sacc=(P0[0]+P0[1]); \
    GAPA(C0=MFMA_H(kf[0],q0_,negm,0,0,0), P0[2],P0[3],P0[4],P0[5],     pw0[0]=PKW(P0,0), pw0[1]=PKW(P0,2), pw0); \
    VRD(4); SBAR(); GAPA(C1=MFMA_H(kf[1],q0_,negm,0,0,0), P0[6],P0[7],P0[8],P0[9],     pw0[2]=PKW(P0,4), pw0[3]=PKW(P0,6), pw0); \
    VRD(1); SBAR(); GAPA(C0=MFMA_H(kf[2],q1_,C0,0,0,0),   P0[10],P0[11],P0[12],P0[13], pw1[0]=PKW(P0,8), pw1[1]=PKW(P0,10), pw1); \
    VRD(5); SBAR(); GAPA(C1=MFMA_H(kf[3],q1_,C1,0,0,0),   P0[14],P0[15],P1[0],P1[1],   pw1[2]=PKW(P0,12),pw1[3]=PKW(P0,14), pw1); \
    VRD(2); SBAR(); GAPA(C0=MFMA_H(kf[4],q2_,C0,0,0,0),   P1[2],P1[3],P1[4],P1[5],     pw2[0]=PKW(P1,0), pw2[1]=PKW(P1,2), pw2); \
    VRD(6); SBAR(); GAPA(C1=MFMA_H(kf[5],q2_,C1,0,0,0),   P1[6],P1[7],P1[8],P1[9],     pw2[2]=PKW(P1,4), pw2[3]=PKW(P1,6), pw2); \
    VRD(3); SBAR(); GAPA(C0=MFMA_H(kf[6],q3_,C0,0,0,0),   P1[10],P1[11],P1[12],P1[13], pw3[0]=PKW(P1,8), pw3[1]=PKW(P1,10), pw3); \
    VRD(7); SBAR(); GAPA(C1=MFMA_H(kf[7],q3_,C1,0,0,0),   P1[14],P1[15],0.f,0.f,       pw3[2]=PKW(P1,12),pw3[3]=PKW(P1,14), pw3); \
    l_reg+=sacc; \
    if(GK){DMA_K((t)+3,sl_cur);} if(GV){DMA_V((t)+1,sl_next);} \
    CMASK(C0,C1,t); \
    { float a=MX3(C0[0],C0[1],C1[0]),b=MX3(C0[2],C0[3],C1[1]); a=MX3(a,C1[2],C1[3]); \
      _Pragma("unroll") for(int r=4;r<16;r+=4){a=MX3(a,C0[r],C0[r+1]);b=MX3(b,C0[r+2],C0[r+3]);a=MX3(a,C1[r],C1[r+1]);b=MX3(b,C1[r+2],C1[r+3]);} \
      float rm=__builtin_fmaxf(a,b); { auto rr=__builtin_amdgcn_permlane32_swap(__float_as_uint(rm),__float_as_uint(rm),false,false); rm=__builtin_fmaxf(__uint_as_float(rr[0]),__uint_as_float(rr[1])); } \
      resc=false; \
      if(__builtin_expect(__any(rm>(float)THRL),0)){ const float dl=__builtin_fmaxf(rm,0.f); mhat+=dl; \
        _Pragma("unroll") for(int r=0;r<16;++r){C0[r]-=dl;C1[r]-=dl;} \
        _Pragma("unroll") for(int r=0;r<16;++r)negm[r]=-mhat; asm volatile("":"+v"(negm)); \
        const float f=__builtin_amdgcn_exp2f(-dl); l_reg*=f; { const int le_=lane_id_v(); if(le_<32)wsf[le_]=f; } resc=true; } } \
    SBAR(); \
    GAPB(o[0]=MFMA_H(PAF(0),VFR(0),o[0],0,0,0), C0,0);  VRD2(0); \
    GAPB(o[1]=MFMA_H(PAF(0),VFR(4),o[1],0,0,0), C0,2);  VRD2(4); \
    KRD(GL,0); GAPB(o[0]=MFMA_H(PAF(1),VFR(1),o[0],0,0,0), C0,4);  VRD2(1); \
    KRD(GL,1); GAPB(o[1]=MFMA_H(PAF(1),VFR(5),o[1],0,0,0), C0,6);  VRD2(5); \
    KRD(GL,2); GAPB(o[0]=MFMA_H(PAF(2),VFR(2),o[0],0,0,0), C0,8);  VRD2(2); \
    KRD(GL,3); GAPB(o[1]=MFMA_H(PAF(2),VFR(6),o[1],0,0,0), C0,10); VRD2(6); \
    GAPB(o[0]=MFMA_H(PAF(3),VFR(3),o[0],0,0,0), C0,12); VRD2(3); \
    GAPB(o[1]=MFMA_H(PAF(3),VFR(7),o[1],0,0,0), C0,14); VRD2(7); \
    GAPB(o[2]=MFMA_H(PAF(0),VFR(0),o[2],0,0,0), C1,0); \
    GAPB(o[3]=MFMA_H(PAF(0),VFR(4),o[3],0,0,0), C1,2); \
    GAPB(o[2]=MFMA_H(PAF(1),VFR(1),o[2],0,0,0), C1,4); \
    GAPB(o[3]=MFMA_H(PAF(1),VFR(5),o[3],0,0,0), C1,6); \
    GAPB(o[2]=MFMA_H(PAF(2),VFR(2),o[2],0,0,0), C1,8); \
    GAPB(o[3]=MFMA_H(PAF(2),VFR(6),o[3],0,0,0), C1,10); \
    GAPB(o[2]=MFMA_H(PAF(3),VFR(3),o[2],0,0,0), C1,12); \
    GAPB(o[3]=MFMA_H(PAF(3),VFR(7),o[3],0,0,0), C1,14); \
    }while(0)
  int t=1;
  #undef CMASK
  #define CMASK(P0,P1,t) do{}while(0)
  for(;t+5<NT;t+=2){
    STEP(pB0,pB1,pA0,pA1,t,true,true,true);     WAIT_BAR(3); RESC(); ROT();
    STEP(pA0,pA1,pB0,pB1,t+1,true,true,true);   WAIT_BAR(3); RESC(); ROT();
  }
  #undef CMASK
  #define CMASK(P0,P1,t) do{int jb_=(t)-(NT-4); if(jb_>=0)cmask(P0,P1,jb_,qrel,hi);}while(0)
  #define ENDW(tt) do{ if((tt)+3<NT){WAIT_BAR(3);} else if((tt)+2<NT){WAIT_BAR(2);} else {WAIT_BAR(0);} }while(0)
  for(;t+1<NT;t+=2){
    STEP(pB0,pB1,pA0,pA1,t,(t+3<NT),(t+1<NT),(t+1<NT));       ENDW(t);   RESC(); ROT();
    STEP(pA0,pA1,pB0,pB1,t+1,(t+4<NT),(t+2<NT),(t+2<NT));     ENDW(t+1); RESC(); ROT();
  }
  STEP(pB0,pB1,pA0,pA1,NT-1,false,false,false); RESC();
  { float sacc=pB0[0]+pB0[1]; _Pragma("unroll") for(int r=2;r<16;++r)sacc+=pB0[r]; _Pragma("unroll") for(int r=0;r<16;++r)sacc+=pB1[r]; l_reg+=sacc;
    pw0=(u32x4){PKW(pB0,0),PKW(pB0,2),PKW(pB0,4),PKW(pB0,6)};pw1=(u32x4){PKW(pB0,8),PKW(pB0,10),PKW(pB0,12),PKW(pB0,14)};pw2=(u32x4){PKW(pB1,0),PKW(pB1,2),PKW(pB1,4),PKW(pB1,6)};pw3=(u32x4){PKW(pB1,8),PKW(pB1,10),PKW(pB1,12),PKW(pB1,14)};
    SBAR(); pv128(o,vb0+2*sl_cur,PAF(0),PAF(1),PAF(2),PAF(3)); }
  #undef PKW
  #undef PAF
  #undef VFR
  #undef PIN
  #undef MX3
  #undef GAPA
  #undef GAPB
  #undef EX
  #undef VRD
  #undef VRD2
  #undef KRD
  #undef STEP
  #undef ENDW
  #undef QLD
  {auto rr=__builtin_amdgcn_permlane32_swap(__float_as_uint(l_reg),__float_as_uint(l_reg),false,false);l_reg=__uint_as_float(rr[0])+__uint_as_float(rr[1]);}
  if(hi==0)wsf[32+r32]=l_reg;asm volatile("s_waitcnt lgkmcnt(0)":::"memory");
  int tide=(wv_in<<6)|lane_id_v();
  const int lane_e=tide&63,r32_e=lane_e&31,hi_e=lane_e>>5;
  float rli[16];
  #pragma unroll
  for(int r=0;r<16;++r)rli[r]=__builtin_amdgcn_rcpf(wsf[32+crow(r,hi_e)]);
  bf16*Ow=O+(long)(q0+wid*QBLK)*OPITCH+h*128;
  { bf16*stg=(bf16*)(shm+L_OST)+wid*2048;
    #pragma unroll
    for(int ch=0;ch<2;++ch){
      #pragma unroll
      for(int r=0;r<16;++r){const int orow=crow(r,hi_e);
        #pragma unroll
        for(int d0=0;d0<2;++d0)stg[orow*64+d0*32+r32_e]=(bf16)(o[2*ch+d0][r]*rli[r]);}
      asm volatile("s_waitcnt lgkmcnt(0)":::"memory");
      #pragma unroll
      for(int i=0;i<4;++i){const int row=i*8+(lane_e>>3),c8=lane_e&7; const u32x4 v=*(const u32x4*)(stg+row*64+c8*8); ATTN_STORE16(Ow+(long)row*OPITCH+ch*64+c8*8,v);}
      asm volatile("s_waitcnt lgkmcnt(0)":::"memory"); } }
  asm volatile("s_waitcnt lgkmcnt(0)\n\ts_barrier":::"memory");
  #undef DMA_K
  #undef DMA_V
  #undef CMASK
  #undef START
  #undef RESC
  #undef ROT
}
struct AttnTensors { const bf16* Q; const bf16* K; const bf16* V; bf16* O; };
template<class Sched,int THRL=8> __device__ __forceinline__ void attn_phase(char*lds,const AttnTensors&T,const Sched&S,const int wv_in){
  AttnUnit u;
  for(int i=0;S.next(i,u);++i){ attn_unit<THRL>(u.bh,u.qb,T.Q,T.K,T.V,T.O,lds,wv_in); }
}
#undef SBAR
#undef WAIT_BAR
}

DEV void ph_attn(const Params& p, LAS char* lds, int wv) {
    TID_DECL
    char* ws = p.ws;
    const attn128::AttnTensors T{(const half_t*)(ws + OFF_QA), (const half_t*)(ws + OFF_KA), (const half_t*)(ws + OFF_VAT), (half_t*)(ws + OFF_OA0)};
    const attn_body::StaticOrder S(nblk, bidx);
    attn128::attn_phase<attn_body::StaticOrder>((char*)lds, T, S, ls(wv));
}
DEV void ph_attn_comb(const Params& p, int l, int wv) {
    TID_DECL
    char* ws = p.ws; const int lane = tidx & 63, wid = tidx >> 6;
    const float* lp = p.da_lambda + l * 256;
    const float a = wave_sum(lane, lp[lane] * lp[64 + lane]), bq = wave_sum(lane, lp[128 + lane] * lp[192 + lane]);
    const float lam_init = 0.8f - 0.6f * expf(-0.3f * (float)l); const float lam = expf(a) - expf(bq) + lam_init;
    const int h = lane >> 3, part = lane & 7, dv0 = part * 16;
    const half_t* OA = (const half_t*)(ws + OFF_OA0);
    const half_t* ZA = (const half_t*)(ws + OFF_ZA); half_t* YA = (half_t*)(ws + OFF_QA);
    const float* ng = p.da_norm_g + l * 128;
    for (int t = bidx * NWAVE + wid; t < TB; t += nblk * NWAVE) {
        const half_t* o1p = OA + (size_t)t * 2048 + (2 * h) * 128 + dv0; const half_t* o2p = o1p + 128;
        const h8 a0 = *(const h8*)o1p, a1 = *(const h8*)(o1p + 8), b0 = *(const h8*)o2p, b1 = *(const h8*)(o2p + 8);
        float d[16]; float ss = 0.f;
#pragma unroll
        for (int e = 0; e < 8; ++e) { d[e] = (float)a0[e] - lam * (float)b0[e]; d[8 + e] = (float)a1[e] - lam * (float)b1[e]; ss += d[e] * d[e] + d[8 + e] * d[8 + e]; }
        ss += shx(lane, ss, 1); ss += shx(lane, ss, 2); ss += shx(lane, ss, 4);
        const float rs = rsqrtf(ss * (1.f / 128.f) + NORM_EPS) * (1.f - lam_init);
        const size_t off = (size_t)t * 1024 + h * 128 + dv0; const h8 z0 = *(const h8*)(ZA + off), z1 = *(const h8*)(ZA + off + 8); h8 y0, y1;
#pragma unroll
        for (int e = 0; e < 8; ++e) { y0[e] = (half_t)(d[e] * rs * ng[dv0 + e] * (float)z0[e]); y1[e] = (half_t)(d[8 + e] * rs * ng[dv0 + 8 + e] * (float)z1[e]); }
        *(h8*)(YA + off) = y0; *(h8*)(YA + off + 8) = y1;
    }
}


template <int ROFF> DEV void tr_rd8(h4 (&lo)[4], h4 (&hi)[4], unsigned a0) {
    asm volatile("ds_read_b64_tr_b16 %0, %8\n\tds_read_b64_tr_b16 %1, %8 offset:32\n\tds_read_b64_tr_b16 %2, %8 offset:64\n\tds_read_b64_tr_b16 %3, %8 offset:96\n\t"
                 "ds_read_b64_tr_b16 %4, %8 offset:%c9\n\tds_read_b64_tr_b16 %5, %8 offset:%c10\n\tds_read_b64_tr_b16 %6, %8 offset:%c11\n\tds_read_b64_tr_b16 %7, %8 offset:%c12\n\ts_waitcnt lgkmcnt(0)"
                 : "=&v"(lo[0]), "=&v"(lo[1]), "=&v"(lo[2]), "=&v"(lo[3]), "=&v"(hi[0]), "=&v"(hi[1]), "=&v"(hi[2]), "=&v"(hi[3])
                 : "v"(a0), "i"(ROFF), "i"(ROFF + 32), "i"(ROFF + 64), "i"(ROFF + 96) : "memory");
}
DEV float chunk_scan(const float* MG, int hh, int c, float& ig, int lane) {
    const int t = c * 64 + lane;
    ig = MG[(size_t)t * 8 + hh]; float a = MG[(size_t)t * 8 + 4 + hh];
#pragma unroll
    for (int o = 1; o < 64; o <<= 1) { const float u = shi(a, lane - o); if (lane >= o) a += u; }
    return a;
}
constexpr int LDV = 264, LDK = 136;
constexpr int ML_VT_BYTES = 64 * LDV * 2, ML_KT_BYTES = 64 * LDK * 2;
DEV void ph_ml_state(const Params& p, LAS char* lds, int wv) { TID_DECL
    char* ws = p.ws; const int lane = tidx & 63, wid = tidx >> 6, r = lane & 15, g = lane >> 4;
    const float* MG = (const float*)(ws + OFF_MG); const half_t* MV = (const half_t*)(ws + OFF_MVT); const half_t* MQKC = (const half_t*)(ws + OFF_MQKC);
    float* ST = (float*)(ws + OFF_ST); float* NV = (float*)(ws + OFF_NV); float* DEC = (float*)(ws + OFF_DEC);
    LAS half_t* Vt = (LAS half_t*)lds; LAS half_t* Kt = (LAS half_t*)(lds + ML_VT_BYTES);
    const unsigned vt_addr = (unsigned)(uintptr_t)Vt, kt_addr = (unsigned)(uintptr_t)Kt;
    for (int u = bidx; u < 1024; u += nblk) {
        const int hh = u >> 8, c = u & 255; float ig; const float a = chunk_scan(MG, hh, c, ig, lane); const float a63 = shi(a, 63); const float w = __expf(a63 - a + ig);
        __syncthreads();
        { h8 x[4];
#pragma unroll
          for (int i = 0; i < 4; ++i) { const int ch = tidx + 512 * i, row = ch >> 5, c16 = ch & 31; x[i] = *(const h8*)(MV + (size_t)(c * 64 + row) * 1024 + hh * 256 + c16 * 8); }
          h8 y[2];
#pragma unroll
          for (int i = 0; i < 2; ++i) { const int ch = tidx + 512 * i, row = ch >> 4, c16 = ch & 15; y[i] = *(const h8*)(MQKC + (size_t)(c * 64 + row) * 1024 + 512 + hh * 128 + c16 * 8); }
#pragma unroll
          for (int i = 0; i < 4; ++i) { const int ch = tidx + 512 * i, row = ch >> 5, c16 = ch & 31; const float wr = shi(w, row); h8 z;
#pragma unroll
              for (int e = 0; e < 8; ++e) z[e] = (half_t)((float)x[i][e] * wr);
              *(LAS h8*)(Vt + row * LDV + c16 * 8) = z; }
#pragma unroll
          for (int i = 0; i < 2; ++i) { const int ch = tidx + 512 * i, row = ch >> 4, c16 = ch & 15; *(LAS h8*)(Kt + row * LDK + c16 * 8) = y[i]; } }
        __syncthreads();
        f4 acc[2][8];
#pragma unroll
        for (int i = 0; i < 2; ++i)
#pragma unroll
            for (int j = 0; j < 8; ++j) acc[i][j] = (f4){0.f, 0.f, 0.f, 0.f};
#pragma unroll
        for (int ks = 0; ks < 2; ++ks) {
            const int frow = 32 * ks + 8 * g + (r >> 2);
            h4 vlo[4], vhi[4]; tr_rd8<4 * LDV * 2>(vlo, vhi, vt_addr + (unsigned)((frow * LDV + wid * 32 + 4 * (r & 3)) * 2));
            h4 klo[4], khi[4], klo2[4], khi2[4];
            tr_rd8<4 * LDK * 2>(klo, khi, kt_addr + (unsigned)((frow * LDK + 4 * (r & 3)) * 2));
            tr_rd8<4 * LDK * 2>(klo2, khi2, kt_addr + (unsigned)((frow * LDK + 64 + 4 * (r & 3)) * 2));
            const h8 va0 = cat44(vlo[0], vhi[0]), va1 = cat44(vlo[1], vhi[1]);
#pragma unroll
            for (int dt = 0; dt < 4; ++dt) { const h8 kb = cat44(klo[dt], khi[dt]); acc[0][dt] = MFMA16(va0, kb, acc[0][dt]); acc[1][dt] = MFMA16(va1, kb, acc[1][dt]); }
#pragma unroll
            for (int dt = 0; dt < 4; ++dt) { const h8 kb = cat44(klo2[dt], khi2[dt]); acc[0][4 + dt] = MFMA16(va0, kb, acc[0][4 + dt]); acc[1][4 + dt] = MFMA16(va1, kb, acc[1][4 + dt]); }
        }
#pragma unroll
        for (int vt = 0; vt < 2; ++vt)
#pragma unroll
            for (int dt = 0; dt < 8; ++dt)
#pragma unroll
                for (int e = 0; e < 4; ++e) ST[((size_t)(hh * 256 + c) * 256 + wid * 32 + vt * 16 + 4 * g + e) * 128 + dt * 16 + r] = acc[vt][dt][e];
        { const int d = wid * 16 + r; float s = 0.f;
#pragma unroll
          for (int e = 0; e < 16; ++e) s += (float)Kt[(16 * g + e) * LDK + d] * shi(w, 16 * g + e);
          s = gsum(lane, s); if (g == 0) NV[(size_t)(hh * 256 + c) * 128 + d] = s; }
        if (tidx == 0) DEC[hh * 256 + c] = __expf(a63);
    }
    __syncthreads();
}
DEV void ph_ml_scan(const Params& p, int wv) { TID_DECL
    char* ws = p.ws; float* ST = (float*)(ws + OFF_ST); float* NV = (float*)(ws + OFF_NV); const float* DEC = (const float*)(ws + OFF_DEC);
    const int nthr = nblk * NTHREADS;
    for (int e0 = bidx * NTHREADS + tidx; e0 < 4 * 32768 + 512; e0 += nthr) {
        float* base; size_t stride; int hh;
        half_t* b16 = nullptr;
        if (e0 < 4 * 32768) { hh = e0 >> 15; base = ST + (size_t)hh * 256 * 32768 + (e0 & 32767); stride = 32768; b16 = (half_t*)(ws + OFF_ST16) + (size_t)hh * 256 * 32768 + (e0 & 32767); }
        else { const int q = e0 - 4 * 32768; hh = q >> 7; base = NV + (size_t)hh * 256 * 128 + (q & 127); stride = 128; }
        float S = 0.f;
        for (int c0 = 0; c0 < 256; c0 += 8) { float tmp[8];
#pragma unroll
            for (int i = 0; i < 8; ++i) tmp[i] = base[(size_t)(c0 + i) * stride];
#pragma unroll
            for (int i = 0; i < 8; ++i) { if (b16) b16[(size_t)(c0 + i) * stride] = (half_t)S; else base[(size_t)(c0 + i) * stride] = S; S = DEC[hh * 256 + c0 + i] * S + tmp[i]; } }
    }
}
DEV void ph_ml_out(const Params& p, int l, LAS char* lds, int wv) { TID_DECL
    char* ws = p.ws; const int lane = tidx & 63, wid = tidx >> 6, r = lane & 15, g = lane >> 4;
    const float* MG = (const float*)(ws + OFF_MG); const half_t* MV = (const half_t*)(ws + OFF_MVT); const half_t* MQKC = (const half_t*)(ws + OFF_MQKC);
    const half_t* ST16 = (const half_t*)(ws + OFF_ST16); const float* NV = (const float*)(ws + OFF_NV);
    const half_t* MO = (const half_t*)(ws + OFF_MO); const half_t* MZ = (const half_t*)(ws + OFF_MZ); half_t* YB = (half_t*)(ws + OFF_YB);
    const float* ng = p.ml_norm_g + l * 256;
    const int ci = wid >> 2, j = wid & 3;
    LAS half_t* Vt = (LAS half_t*)(lds + ci * ML_VT_BYTES); const unsigned vt_addr = (unsigned)(uintptr_t)Vt;
    for (int bu = bidx; bu < 512; bu += nblk) {
        const int cu = 2 * bu + ci, hh = cu >> 8, c = cu & 255; const int t = c * 64 + 16 * j + r;
        __syncthreads();
        { h8 x[8];
#pragma unroll
          for (int i = 0; i < 8; ++i) { const int ch = tidx + 512 * i, row = ch >> 5, c16 = ch & 31; x[i] = *(const h8*)(MV + (size_t)(((2 * bu) & 255) * 64 + row) * 1024 + ((2 * bu) >> 8) * 256 + c16 * 8); }
#pragma unroll
          for (int i = 0; i < 8; ++i) { const int ch = tidx + 512 * i, row = ch >> 5, c16 = ch & 31; *(LAS h8*)((LAS half_t*)lds + (row >> 6) * (ML_VT_BYTES / 2) + (row & 63) * LDV + c16 * 8) = x[i]; } }
        __syncthreads();
        float ig; const float a = chunk_scan(MG, hh, c, ig, lane); const float a_t = shi(a, 16 * j + r); const float ea = __expf(a_t);
        h8 qf[4];
#pragma unroll
        for (int ks = 0; ks < 4; ++ks) qf[ks] = *(const h8*)(MQKC + (size_t)t * 1024 + hh * 128 + 32 * ks + 8 * g);
        f4 acc[16];
#pragma unroll
        for (int vb = 0; vb < 16; vb += 4) { h8 sa[4][4];
#pragma unroll
            for (int v4 = 0; v4 < 4; ++v4)
#pragma unroll
                for (int ks = 0; ks < 4; ++ks) sa[v4][ks] = *(const h8*)(ST16 + ((size_t)cu * 256 + (vb + v4) * 16 + r) * 128 + 32 * ks + 8 * g);
#pragma unroll
            for (int v4 = 0; v4 < 4; ++v4) { const int vt = vb + v4; acc[vt] = (f4){0.f, 0.f, 0.f, 0.f};
#pragma unroll
                for (int ks = 0; ks < 4; ++ks) acc[vt] = MFMA16(sa[v4][ks], qf[ks], acc[vt]);
                acc[vt] *= ea; } }
        float den = 0.f;
        { const float* np = NV + (size_t)cu * 128 + 32 * g; const half_t* qp = MQKC + (size_t)t * 1024 + hh * 128 + 32 * g;
#pragma unroll
          for (int m = 0; m < 4; ++m) { const h8 q8 = *(const h8*)(qp + 8 * m);
#pragma unroll
              for (int e = 0; e < 8; ++e) den += (float)q8[e] * np[8 * m + e]; }
          den *= ea; }
        for (int kb = 0; kb <= (j >> 1); ++kb) {
            h8 kfr[2][4];
#pragma unroll
            for (int st = 0; st < 2; ++st)
#pragma unroll
                for (int ks = 0; ks < 4; ++ks) kfr[st][ks] = *(const h8*)(MQKC + (size_t)(c * 64 + 32 * kb + 16 * st + r) * 1024 + 512 + hh * 128 + 32 * ks + 8 * g);
            f4 wv[2];
#pragma unroll
            for (int st = 0; st < 2; ++st) { f4 gacc = (f4){0.f, 0.f, 0.f, 0.f};
#pragma unroll
                for (int ks = 0; ks < 4; ++ks) gacc = MFMA16(kfr[st][ks], qf[ks], gacc);
#pragma unroll
                for (int e = 0; e < 4; ++e) { const int si = 32 * kb + 16 * st + 4 * g + e; const float a_s = shi(a, si), ig_s = shi(ig, si);
                    wv[st][e] = (si <= 16 * j + r) ? gacc[e] * __expf(a_t - a_s + ig_s) : 0.f; den += wv[st][e]; } }
            const h8 pb = cat44(toh4(wv[0]), toh4(wv[1]));
            const unsigned a0 = vt_addr + (unsigned)((((32 * kb + 4 * g + (r >> 2)) * LDV) + 4 * (r & 3)) * 2);
            asm volatile("s_waitcnt lgkmcnt(0)" ::: "memory");
#pragma unroll
            for (int c4 = 0; c4 < 4; ++c4) { h4 lo[4], hi4[4]; tr_rd8<16 * LDV * 2>(lo, hi4, a0 + c4 * 128);
#pragma unroll
                for (int i = 0; i < 4; ++i) acc[c4 * 4 + i] = MFMA16(cat44(lo[i], hi4[i]), pb, acc[c4 * 4 + i]); }
        }
        den = gsum(lane, den); const float inv = 1.f / fmaxf(fabsf(den), 1.f); float ss = 0.f;
#pragma unroll
        for (int vt = 0; vt < 16; ++vt) { acc[vt] *= inv; ss += acc[vt][0] * acc[vt][0] + acc[vt][1] * acc[vt][1] + acc[vt][2] * acc[vt][2] + acc[vt][3] * acc[vt][3]; }
        ss = gsum(lane, ss); const float rs = rsqrtf(ss * (1.f / 256.f) + NORM_EPS);
#pragma unroll
        for (int vb = 0; vb < 16; vb += 8) {
            f4 gg[8]; h4 o4[8], z4[8];
#pragma unroll
            for (int i = 0; i < 8; ++i) { const int v = (vb + i) * 16 + 4 * g; const size_t off = (size_t)t * 1024 + hh * 256 + v; gg[i] = *(const f4*)(ng + v); o4[i] = *(const h4*)(MO + off); z4[i] = *(const h4*)(MZ + off); }
#pragma unroll
            for (int i = 0; i < 8; ++i) { const int vt = vb + i; const size_t off = (size_t)t * 1024 + hh * 256 + vt * 16 + 4 * g;
                *(h4*)(YB + off) = toh4((f4){acc[vt][0] * rs * gg[i][0] * (float)o4[i][0] * (float)z4[i][0], acc[vt][1] * rs * gg[i][1] * (float)o4[i][1] * (float)z4[i][1],
                                             acc[vt][2] * rs * gg[i][2] * (float)o4[i][2] * (float)z4[i][2], acc[vt][3] * rs * gg[i][3] * (float)o4[i][3] * (float)z4[i][3]}); } }
    }
    __syncthreads();
}

constexpr int CAP = 704, NPL = CAP / 64;
constexpr int IDX_WAVE_LDS = 4 * CAP * 4 + 4 * CAP * 2 + 256 * 4;
DEV unsigned f2key(float v) { const unsigned b = __float_as_uint(v); return b ^ ((b >> 31) ? 0xffffffffu : 0x80000000u); }
DEV float key2f(unsigned u) { const unsigned b = (u >> 31) ? (u ^ 0x80000000u) : ~u; return __uint_as_float(b); }
template <int PASSES> DEV float prune(LAS float* val, LAS u16* idx, LAS unsigned* hist, int n, int lane, int& kept_out) {
    unsigned u[NPL]; u16 id[NPL];
#pragma unroll
    for (int i = 0; i < NPL; ++i) { const int e = lane + 64 * i; const bool ok = e < n; u[i] = ok ? f2key(val[e]) : 0u; id[i] = ok ? idx[e] : (u16)0; }
    unsigned prefix = 0u, mask = 0u; int want = TOPK;
#pragma unroll 1
    for (int ps = 0; ps < PASSES; ++ps) { const int shift = 24 - 8 * ps;
#pragma unroll
        for (int i = 0; i < 4; ++i) hist[lane + 64 * i] = 0u;
        __builtin_amdgcn_fence(__ATOMIC_RELEASE, "wavefront"); __builtin_amdgcn_wave_barrier();
#pragma unroll
        for (int i = 0; i < NPL; ++i) { const int e = lane + 64 * i; if (e < n && (u[i] & mask) == prefix) __hip_atomic_fetch_add(&hist[(u[i] >> shift) & 255u], 1u, __ATOMIC_RELAXED, __HIP_MEMORY_SCOPE_WORKGROUP); }
        __builtin_amdgcn_fence(__ATOMIC_ACQ_REL, "wavefront"); __builtin_amdgcn_wave_barrier();
        const unsigned c0 = hist[4 * lane], c1 = hist[4 * lane + 1], c2 = hist[4 * lane + 2], c3 = hist[4 * lane + 3];
        const unsigned mine = c0 + c1 + c2 + c3; unsigned above = mine;
#pragma unroll
        for (int o = 1; o < 64; o <<= 1) { const unsigned t = shi(above, lane + o); if (lane + o < 64) above += t; }
        above -= mine;
        const bool here = (above < (unsigned)want) && (above + mine >= (unsigned)want);
        int bsel = 0; unsigned cab = 0;
        if (here) { unsigned cum = above; if (cum + c3 >= (unsigned)want) { bsel = 4 * lane + 3; cab = cum; } else { cum += c3; if (cum + c2 >= (unsigned)want) { bsel = 4 * lane + 2; cab = cum; } else { cum += c2; if (cum + c1 >= (unsigned)want) { bsel = 4 * lane + 1; cab = cum; } else { cum += c1; bsel = 4 * lane; cab = cum; } } } }
        const unsigned long long bal = __ballot(here); const int src = __ffsll((long long)bal) - 1;
        bsel = shi(bsel, src); cab = shi(cab, src);
        prefix |= ((unsigned)bsel) << shift; mask |= 0xffu << shift; want -= (int)cab;
        __builtin_amdgcn_wave_barrier();
    }
    int kept = 0, eqseen = 0;
#pragma unroll
    for (int i = 0; i < NPL; ++i) { const int e = lane + 64 * i; const bool ok = e < n; const unsigned um = u[i] & mask; const bool gt = ok && um > prefix, eq = ok && um == prefix;
        const unsigned long long lt = (1ull << lane) - 1ull; bool keep;
        if (PASSES == 4) { const unsigned long long beq = __ballot(eq); const int erank = eqseen + __popcll(beq & lt); keep = gt || (eq && erank < want); eqseen += __popcll(beq); }
        else keep = gt || eq;
        const unsigned long long bk = __ballot(keep); const int pos = kept + __popcll(bk & lt); kept += __popcll(bk);
        if (keep) { val[pos] = key2f(u[i]); idx[pos] = id[i]; } }
    __builtin_amdgcn_fence(__ATOMIC_ACQ_REL, "wavefront"); __builtin_amdgcn_wave_barrier();
    kept_out = kept;
    return key2f(prefix);
}
DEV void ph_index(const Params& p, LAS char* lds, int wv, int qslot) {
    TID_DECL
    char* ws = p.ws; const int lane = tidx & 63, wid = tidx >> 6, c32 = lane & 31, hi = lane >> 5;
    const half_t* IQ = (const half_t*)(ws + OFF_IQ); const half_t* IK = (const half_t*)(ws + OFF_IK); const float* IW = (const float*)(ws + OFF_IW);
    u16* IDX = (u16*)(ws + OFF_IDX); int* CNT = (int*)(ws + OFF_CNT);
    LAS char* my = lds + wid * IDX_WAVE_LDS; LAS float* val = (LAS float*)my; LAS u16* idxb = (LAS u16*)(my + 4 * CAP * 4); LAS unsigned* hist = (LAS unsigned*)(my + 4 * CAP * 4 + 4 * CAP * 2);
    const unsigned ltm = (1u << c32) - 1u;
    unsigned* qctr = (unsigned*)(ws + OFF_CTRL) + 8192 + 64 * qslot;
    for (;;) {
        {
            int uq = 0; if (lane == 0) uq = (int)__hip_atomic_fetch_add(qctr, 1u, __ATOMIC_RELAXED, __HIP_MEMORY_SCOPE_AGENT);
            uq = __builtin_amdgcn_readfirstlane(uq); if (uq >= 4096) break;
            uq = 4095 - uq;
            const int tq0 = uq * 4;
            const int asel = (c32 >> 2) & 1, ah = (c32 & 3) + 4 * (c32 >> 3);
            h8 af[2][4]; float iw[2][16];
#pragma unroll
            for (int T = 0; T < 2; ++T) {
#pragma unroll
                for (int s = 0; s < 4; ++s) af[T][s] = *(const h8*)(IQ + (size_t)(tq0 + 2 * T + asel) * 1024 + ah * 64 + 16 * s + 8 * hi);
#pragma unroll
                for (int e = 0; e < 16; e += 4) { const f4 w4 = *(const f4*)(IW + (size_t)(tq0 + 2 * T + hi) * 16 + e); iw[T][e] = w4[0]; iw[T][e + 1] = w4[1]; iw[T][e + 2] = w4[2]; iw[T][e + 3] = w4[3]; } }
            float tau[2] = {-INFINITY, -INFINITY}; int cnt[2] = {0, 0};
#pragma unroll
            for (int T = 0; T < 2; ++T) { asm volatile("" :: "v"(af[T][0]), "v"(af[T][1]), "v"(af[T][2]), "v"(af[T][3]));
#pragma unroll
                for (int e = 0; e < 16; e += 4) asm volatile("" :: "v"(iw[T][e]), "v"(iw[T][e + 1]), "v"(iw[T][e + 2]), "v"(iw[T][e + 3])); }
            const int nkt = (tq0 + 3) / 32 + 1;
            h8 B0[4], B1[4], B2[4];
            const int ktl = nkt - 1;
#define IDX_GLD(dst, tile_, s_) asm volatile("global_load_dwordx4 %0, %1, %2 offset:%c3" : "=v"(dst) : "v"(lane16), "s"((const char*)IK + (size_t)(tile_) * 4096), "i"((s_) * 1024) : "memory")
#define IDX_WAIT(n, b) asm volatile("s_waitcnt vmcnt(" #n ")" : "+v"(b[0]), "+v"(b[1]), "+v"(b[2]), "+v"(b[3]) :: "memory")
            const unsigned lane16 = (unsigned)lane * 16u;
#pragma unroll
            for (int s = 0; s < 4; ++s) { IDX_GLD(B0[s], 0, s); }
#pragma unroll
            for (int s = 0; s < 4; ++s) { IDX_GLD(B1[s], (ktl < 1 ? ktl : 1), s); }
            auto tile = [&](h8 (&bu)[4], h8 (&bl)[4], const int kt) {
                const int key = kt * 32 + c32; const int ktn = (kt + 2 < ktl) ? kt + 2 : ktl;
#pragma unroll
                for (int s = 0; s < 4; ++s) { IDX_GLD(bl[s], ktn, s); }
                IDX_WAIT(8, bu);
                f16v acc[2];
#pragma unroll
                for (int T = 0; T < 2; ++T) { acc[T] = (f16v){0.f, 0.f, 0.f, 0.f, 0.f, 0.f, 0.f, 0.f, 0.f, 0.f, 0.f, 0.f, 0.f, 0.f, 0.f, 0.f};
#pragma unroll
                    for (int s = 0; s < 4; ++s) acc[T] = MFMA32(af[T][s], bu[s], acc[T]); }
#pragma unroll
                for (int T = 0; T < 2; ++T) { float v = 0.f;
#pragma unroll
                    for (int e = 0; e < 16; ++e)
                        v = __builtin_fmaf(__int_as_float(max(__float_as_int(acc[T][e]), 0)), iw[T][e], v);
                    const bool cand = (key <= tq0 + 2 * T + hi) && (v > tau[T]);
                    const unsigned long long bal = __builtin_amdgcn_ballot_w64(cand);
                    if (bal) { const unsigned m32 = hi ? (unsigned)(bal >> 32) : (unsigned)bal; const int pos = cnt[T] + __popc(m32 & ltm);
                        if (cand) { val[(2 * T + hi) * CAP + pos] = v; idxb[(2 * T + hi) * CAP + pos] = (u16)key; }
                        cnt[T] += __popc(m32); } }
            };
            for (int kt = 0; kt < nkt;) {
                for (; kt < nkt; kt += 3) { tile(B0, B2, kt); tile(B1, B0, kt + 1); tile(B2, B1, kt + 2);
                    if (__ballot(cnt[0] > CAP - 96 || cnt[1] > CAP - 96)) { kt += 3; break; } }
                IDX_WAIT(0, B0); IDX_WAIT(0, B1); IDX_WAIT(0, B2);
                __builtin_amdgcn_fence(__ATOMIC_ACQ_REL, "wavefront"); __builtin_amdgcn_wave_barrier();
#pragma unroll
                for (int T = 0; T < 2; ++T)
#pragma unroll
                    for (int hh = 0; hh < 2; ++hh) { const int nq = __builtin_amdgcn_readlane(cnt[T], 32 * hh);
                        if (nq > CAP - 96) { const int q = 2 * T + hh; int kept; float tn = prune<2>(val + q * CAP, idxb + q * CAP, hist, nq, lane, kept);
                            if (kept > CAP - 128) tn = prune<4>(val + q * CAP, idxb + q * CAP, hist, kept, lane, kept);
                            if (hi == hh) { tau[T] = tn; cnt[T] = kept; } } }
            }
            __builtin_amdgcn_fence(__ATOMIC_ACQ_REL, "wavefront"); __builtin_amdgcn_wave_barrier();
#undef IDX_GLD
#undef IDX_WAIT
#pragma unroll
            for (int T = 0; T < 2; ++T)
#pragma unroll
                for (int hh = 0; hh < 2; ++hh) { const int q = 2 * T + hh; int nq = __builtin_amdgcn_readlane(cnt[T], 32 * hh);
                    if (nq > TOPK) { int kept; prune<4>(val + q * CAP, idxb + q * CAP, hist, nq, lane, kept); nq = kept; }
#pragma unroll
                    for (int i = 0; i < 4; ++i) { const int e = lane + 64 * i; IDX[(size_t)(tq0 + q) * 256 + e] = (e < nq) ? idxb[q * CAP + e] : (u16)0; }
                    if (lane == 0) CNT[tq0 + q] = nq; }
            __builtin_amdgcn_fence(__ATOMIC_ACQ_REL, "wavefront"); __builtin_amdgcn_wave_barrier();
        }
    }
}

constexpr int SP_LD = 264;
constexpr int SP_WAVE_LDS = 32 * SP_LD * 2 + 512;
DEV void tr_read8(h4 (&lo)[4], h4 (&hi)[4], unsigned a0) {
    asm volatile("ds_read_b64_tr_b16 %0, %8\n\tds_read_b64_tr_b16 %1, %8 offset:32\n\tds_read_b64_tr_b16 %2, %8 offset:64\n\tds_read_b64_tr_b16 %3, %8 offset:96\n\t"
                 "ds_read_b64_tr_b16 %4, %8 offset:%c9\n\tds_read_b64_tr_b16 %5, %8 offset:%c10\n\tds_read_b64_tr_b16 %6, %8 offset:%c11\n\tds_read_b64_tr_b16 %7, %8 offset:%c12\n\ts_waitcnt lgkmcnt(0)"
                 : "=&v"(lo[0]), "=&v"(lo[1]), "=&v"(lo[2]), "=&v"(lo[3]), "=&v"(hi[0]), "=&v"(hi[1]), "=&v"(hi[2]), "=&v"(hi[3])
                 : "v"(a0), "i"(16 * SP_LD * 2), "i"(16 * SP_LD * 2 + 32), "i"(16 * SP_LD * 2 + 64), "i"(16 * SP_LD * 2 + 96) : "memory");
}
DEV void ph_sparse(const Params& p, LAS char* lds, int wv, int qslot) {
    TID_DECL
    char* ws = p.ws; const int lane = tidx & 63, wid = tidx >> 6, r = lane & 15, g = lane >> 4;
    half_t* DQ = (half_t*)(ws + OFF_DQ); const half_t* C = (const half_t*)(ws + OFF_C); const u16* IDX = (const u16*)(ws + OFF_IDX); const int* CNT = (const int*)(ws + OFF_CNT);
    LAS half_t* tile = (LAS half_t*)(lds + wid * SP_WAVE_LDS); const unsigned tile_addr = (unsigned)(uintptr_t)tile;
    LAS u16* idl = (LAS u16*)(lds + wid * SP_WAVE_LDS + 32 * SP_LD * 2);
    const int grow = lane >> 5, gc = (lane & 31) * 8;
    unsigned* qctr = (unsigned*)(ws + OFF_CTRL) + 8192 + 64 * (4 + qslot);
    for (;;) {
      int qb4 = 0; if (lane == 0) qb4 = (int)__hip_atomic_fetch_add(qctr, 1u, __ATOMIC_RELAXED, __HIP_MEMORY_SCOPE_AGENT);
      qb4 = __builtin_amdgcn_readfirstlane(qb4); if (qb4 >= TB / 4) break;
      for (int t = 4 * qb4; t < 4 * qb4 + 4; ++t) {
        const int n = CNT[t];
        { typedef unsigned u32x2_t __attribute__((ext_vector_type(2))); *(LAS u32x2_t*)(idl + lane * 4) = *(const u32x2_t*)(IDX + (size_t)t * 256 + lane * 4); }
        h8 qf[8];
#pragma unroll
        for (int ks = 0; ks < 8; ++ks) qf[ks] = (r < 8) ? *(const h8*)(DQ + (size_t)t * 2048 + r * 256 + 32 * ks + 8 * g) : zero8();
        f4 ob[16];
#pragma unroll
        for (int ct = 0; ct < 16; ++ct) ob[ct] = (f4){0.f, 0.f, 0.f, 0.f};
        float mrun = -INFINITY, lpart = 0.f;
        const int nkb = (n + 31) >> 5;
        __builtin_amdgcn_fence(__ATOMIC_ACQ_REL, "wavefront"); __builtin_amdgcn_wave_barrier();
        h8 pre[16];
#pragma unroll
        for (int i = 0; i < 16; ++i) pre[i] = *(const h8*)(C + (size_t)idl[grow + 2 * i] * 256 + gc);
        for (int kb = 0; kb < nkb; ++kb) {
#pragma unroll
            for (int i = 0; i < 16; ++i) *(LAS h8*)(tile + (grow + 2 * i) * SP_LD + gc) = pre[i];
            if (kb + 1 < nkb) {
#pragma unroll
                for (int i = 0; i < 16; ++i) pre[i] = *(const h8*)(C + (size_t)idl[32 * (kb + 1) + grow + 2 * i] * 256 + gc); }
            __builtin_amdgcn_fence(__ATOMIC_ACQ_REL, "wavefront"); __builtin_amdgcn_wave_barrier();
            f4 s[2];
#pragma unroll
            for (int st = 0; st < 2; ++st) { s[st] = (f4){0.f, 0.f, 0.f, 0.f};
#pragma unroll
                for (int ks = 0; ks < 8; ++ks) { const h8 a = *(const LAS h8*)(tile + (16 * st + r) * SP_LD + 32 * ks + 8 * g); s[st] = MFMA16(a, qf[ks], s[st]); }
#pragma unroll
                for (int e = 0; e < 4; ++e) if (32 * kb + 16 * st + 4 * g + e >= n) s[st][e] = -INFINITY; }
            float mx = fmaxf(fmaxf(fmaxf(s[0][0], s[0][1]), fmaxf(s[0][2], s[0][3])), fmaxf(fmaxf(s[1][0], s[1][1]), fmaxf(s[1][2], s[1][3])));
            mx = gmax(lane, mx); const float mn = fmaxf(mrun, mx); const float sc = exp2f(mrun - mn); mrun = mn;
            float ps = 0.f; f4 pp[2];
#pragma unroll
            for (int st = 0; st < 2; ++st)
#pragma unroll
                for (int e = 0; e < 4; ++e) { pp[st][e] = exp2f(s[st][e] - mn); ps += pp[st][e]; }
            lpart = lpart * sc + ps;
            const h8 pb = cat44(toh4(pp[0]), toh4(pp[1]));
            const unsigned a0 = tile_addr + (unsigned)(((4 * g + (r >> 2)) * SP_LD + 4 * (r & 3)) * 2);
            asm volatile("s_waitcnt lgkmcnt(0)" ::: "memory");
#pragma unroll
            for (int c4 = 0; c4 < 4; ++c4) { h4 lo[4], hi4[4]; tr_read8(lo, hi4, a0 + c4 * 128);
#pragma unroll
                for (int j = 0; j < 4; ++j) { const int ct = c4 * 4 + j; ob[ct] = ob[ct] * sc; ob[ct] = MFMA16(cat44(lo[j], hi4[j]), pb, ob[ct]); } }
        }
        const float inv = 1.f / gsum(lane, lpart);
        __builtin_amdgcn_fence(__ATOMIC_ACQ_REL, "wavefront"); __builtin_amdgcn_wave_barrier();
        if (r < 8) {
#pragma unroll
            for (int ct = 0; ct < 16; ++ct) *(LAS h4*)(tile + r * 256 + 16 * ct + 4 * g) = toh4(ob[ct] * inv); }
        __builtin_amdgcn_fence(__ATOMIC_ACQ_REL, "wavefront"); __builtin_amdgcn_wave_barrier();
#pragma unroll
        for (int i = 0; i < 4; ++i) { const int ch = lane + 64 * i; *(h8*)(DQ + (size_t)t * 2048 + ch * 8) = *(const LAS h8*)(tile + ch * 8); }
        __builtin_amdgcn_fence(__ATOMIC_ACQ_REL, "wavefront"); __builtin_amdgcn_wave_barrier();
      }
    }
}

DEV void ph_final(const Params& p, int l, int b, int wv) {
    TID_DECL
    const float* X = p.x + (size_t)b * TB * 2048; float* O = p.out + (size_t)b * TB * 2048; half_t* XH = (half_t*)(p.ws + OFF_X1H) + (size_t)b * TB * 2048;
    const half_t* OUTP = (const half_t*)(p.ws + OFF_OUTP); const float* g = p.post_g + l * 2048;
    const int lane = tidx & 63, wid = tidx >> 6;
    for (int t = bidx * NWAVE + wid; t < TB; t += nblk * NWAVE) {
        f4 ov[8], xv[8]; float ss = 0.f;
#pragma unroll
        for (int i = 0; i < 8; ++i) { const size_t off = (size_t)t * 2048 + i * 256 + lane * 4; const h4 oh = *(const h4*)(OUTP + off);
            if (l == 0) xv[i] = *(const f4*)(X + off); else { const h4 xh = *(const h4*)(XH + off); xv[i] = (f4){(float)xh[0], (float)xh[1], (float)xh[2], (float)xh[3]}; }
            ov[i] = (f4){(float)oh[0], (float)oh[1], (float)oh[2], (float)oh[3]}; ss += ov[i][0] * ov[i][0] + ov[i][1] * ov[i][1] + ov[i][2] * ov[i][2] + ov[i][3] * ov[i][3]; }
        ss = wave_sum(lane, ss); const float rs = rsqrtf(ss * (1.f / 2048.f) + NORM_EPS);
#pragma unroll
        for (int i = 0; i < 8; ++i) { const size_t off = (size_t)t * 2048 + i * 256 + lane * 4; const f4 gg = *(const f4*)(g + i * 256 + lane * 4); const f4 r = xv[i] + ov[i] * rs * gg;
            if (l == DEPTH - 1) *(f4*)(O + off) = r; else *(h4*)(XH + off) = toh4(r); }
    }
}

#define XB_TMO      128
#define XB_XCNT(j)  (256  + 64 * (j))
#define XB_XSUB(j)  (1280 + 64 * (j))
#define XB_XGEN(j)  (2304 + 64 * (j))
#define XB_TOP      3328
#define XB_TOPGEN   3392
#define XCD_BAR_WORDS 3456
#define XB_SPIN_CAP (1u << 22)

__device__ __forceinline__ unsigned xb_ld(unsigned* p)              { return __hip_atomic_load(p, __ATOMIC_RELAXED, __HIP_MEMORY_SCOPE_AGENT); }
__device__ __forceinline__ unsigned xb_add(unsigned* p, unsigned v) { return __hip_atomic_fetch_add(p, v, __ATOMIC_RELAXED, __HIP_MEMORY_SCOPE_AGENT); }
__device__ __forceinline__ unsigned xb_xcc_id() { return (unsigned)__builtin_amdgcn_s_getreg((3 << 11) | 20) & 0xFu; }
#define XB_SPIN(cond, bar) do { unsigned _sp = 0; while (cond) { __builtin_amdgcn_s_sleep(1); \
    if ((++_sp & 255u) == 0u) { if (xb_ld(&(bar)[XB_TMO])) break; if (_sp > XB_SPIN_CAP) { atomicAdd(&(bar)[XB_TMO], 1u); break; } } } } while (0)

struct XcdBarrier {
    unsigned* bar; unsigned x;
    volatile LAS unsigned* st;
};

__device__ __forceinline__ XcdBarrier xcd_barrier_post(unsigned* bar, volatile LAS unsigned* st, const bool t0) {
    XcdBarrier b; b.bar = bar; b.x = xb_xcc_id(); b.st = st;
    if (t0) (void)xb_add(&bar[XB_XCNT(b.x)], 1u);
    return b;
}
__device__ __forceinline__ void xcd_barrier_complete(unsigned* bar, unsigned x, unsigned& nloc, unsigned& nx) {
    const unsigned G = gridDim.x * gridDim.y * gridDim.z;
    unsigned sum, cnt, mine, sp = 0u;
    for (;;) {
        sum = 0u; cnt = 0u; mine = 0u;
#pragma unroll
        for (unsigned j = 0; j < 16; ++j) { const unsigned c = xb_ld(&bar[XB_XCNT(j)]); sum += c; cnt += (c > 0u) ? 1u : 0u; mine = (j == x) ? c : mine; }
        if (sum == G) break;
        __builtin_amdgcn_s_sleep(1);
        if ((++sp & 255u) == 0u) { if (xb_ld(&bar[XB_TMO])) break; if (sp > XB_SPIN_CAP) { atomicAdd(&bar[XB_TMO], 1u); break; } }
    }
    nloc = mine > 0u ? mine : 1u; nx = cnt > 0u ? cnt : 1u;
}

__device__ __forceinline__ void xcd_barrier(const XcdBarrier& b, const bool t0) {
    asm volatile("s_waitcnt vmcnt(0)" ::: "memory");
    __syncthreads();
    if (t0) {
        unsigned* bar = b.bar;
        __builtin_amdgcn_s_waitcnt(0);
        unsigned nloc = b.st[0], nx = b.st[1];
        if (nloc == 0u) { xcd_barrier_complete(bar, b.x, nloc, nx); b.st[0] = nloc; b.st[1] = nx; }
        const unsigned old = xb_add(&bar[XB_XSUB(b.x)], 1u);
        const unsigned gen = old / nloc;
        if (old + 1u == (gen + 1u) * nloc) {
            __builtin_amdgcn_fence(__ATOMIC_RELEASE, "agent");
            asm volatile("s_waitcnt vmcnt(0)" ::: "memory");
            const unsigned og = xb_add(&bar[XB_TOP], 1u);
            const unsigned tg = og / nx;
            if (og + 1u == (tg + 1u) * nx) xb_add(&bar[XB_TOPGEN], 1u);
            else XB_SPIN(xb_ld(&bar[XB_TOPGEN]) == tg, bar);
            __builtin_amdgcn_fence(__ATOMIC_ACQUIRE, "agent");
            xb_add(&bar[XB_XGEN(b.x)], 1u);
            asm volatile("s_waitcnt vmcnt(0)" ::: "memory");
        } else {
            XB_SPIN(xb_ld(&bar[XB_XGEN(b.x)]) == gen, bar);
            __builtin_amdgcn_fence(__ATOMIC_ACQUIRE, "agent");
            asm volatile("s_waitcnt vmcnt(0)" ::: "memory");
        }
    }
    __syncthreads();
}

constexpr int LDS_BYTES = 147456;
constexpr int LDS_HDR_OFF = LDS_BYTES - 256;
static_assert(8 * SP_WAVE_LDS <= LDS_HDR_OFF && pg8::STAGE_BYTES <= LDS_HDR_OFF && 8 * IDX_WAVE_LDS <= LDS_HDR_OFF, "LDS map");
constexpr int PH_PER_B = 9, PH_PER_L = 1 + NB * PH_PER_B, PH_TOTAL = DEPTH * PH_PER_L;
template <class T> DEV T* ldptr(const LAS unsigned* w) {
    const unsigned lo = __builtin_amdgcn_readfirstlane(w[0]), hi = __builtin_amdgcn_readfirstlane(w[1]);
    const unsigned long long v = ((unsigned long long)hi << 32) | lo;
    return (T*)(__attribute__((address_space(1))) T*)v;
}
DEV Params ldp(const LAS unsigned* w_in) { Params q;
    const LAS unsigned* w = (const LAS unsigned*)(size_t)(unsigned)ls((int)(unsigned)(size_t)w_in);
    q.x = ldptr<const float>(w + 0); q.pre_g = ldptr<const float>(w + 2); q.w_in = ldptr<const float>(w + 4); q.da_lambda = ldptr<const float>(w + 6); q.da_norm_g = ldptr<const float>(w + 8);
    q.ml_conv_w = ldptr<const float>(w + 10); q.ml_conv_b = ldptr<const float>(w + 12); q.ml_gate_b = ldptr<const float>(w + 14); q.ml_norm_g = ldptr<const float>(w + 16);
    q.kv_norm_g = ldptr<const float>(w + 18); q.ik_norm_g = ldptr<const float>(w + 20); q.w_uv = ldptr<const float>(w + 22); q.w_branch = ldptr<const float>(w + 24); q.w_out = ldptr<const float>(w + 26);
    q.post_g = ldptr<const float>(w + 28); q.out = ldptr<float>(w + 30); q.ws = ldptr<char>(w + 32); q.ph_lo = 0; q.ph_hi = 0; return q; }
DEV void stptr(LAS unsigned* w, const void* ptr) { const unsigned long long v = (unsigned long long)ptr; w[0] = (unsigned)v; w[1] = (unsigned)(v >> 32); }
__global__ void __launch_bounds__(NTHREADS, 2) fwd(Params p0) {
    extern __shared__ __attribute__((aligned(16))) char lds_raw[];
    LAS char* lds = (LAS char*)lds_raw; LAS char* lds0 = lds + LDS_HDR_OFF;
    const int wv = __builtin_amdgcn_readfirstlane((int)threadIdx.x >> 6);
    LAS unsigned* pw = (LAS unsigned*)(lds0 + 64);
    if (threadIdx.x == 0) { LAS unsigned* z = (LAS unsigned*)lds0; z[0] = 0u; z[1] = 0u; z[2] = 0u; z[3] = 0u;
        stptr(pw + 0, p0.x); stptr(pw + 2, p0.pre_g); stptr(pw + 4, p0.w_in); stptr(pw + 6, p0.da_lambda); stptr(pw + 8, p0.da_norm_g); stptr(pw + 10, p0.ml_conv_w); stptr(pw + 12, p0.ml_conv_b);
        stptr(pw + 14, p0.ml_gate_b); stptr(pw + 16, p0.ml_norm_g); stptr(pw + 18, p0.kv_norm_g); stptr(pw + 20, p0.ik_norm_g); stptr(pw + 22, p0.w_uv); stptr(pw + 24, p0.w_branch); stptr(pw + 26, p0.w_out);
        stptr(pw + 28, p0.post_g); stptr(pw + 30, p0.out); stptr(pw + 32, p0.ws); }
    __syncthreads();
    { XcdBarrier bar0 = xcd_barrier_post((unsigned*)(p0.ws + OFF_CTRL), (volatile LAS unsigned*)lds0, threadIdx.x == 0); (void)bar0; }
#define SEAM(id) if ((id) + 1 < PH_TOTAL) { XcdBarrier bar; bar.bar = (unsigned*)(ldptr<char>((const LAS unsigned*)(size_t)(unsigned)ls((int)(unsigned)(size_t)(pw + 32))) + OFF_CTRL); bar.x = xb_xcc_id(); bar.st = (volatile LAS unsigned*)lds0; \
        xcd_barrier(bar, ls(wv) == 0 && lane_id_v() == 0); }
#define RUN(id) true
    for (int l_ = 0; l_ < DEPTH; ++l_) {
        const int b_ = 0;
        { const int id = l_ * PH_PER_L; if (RUN(id)) { const Params p = ldp(pw); const int l = ls(l_), b = ls(b_); (void)l; (void)b; ph_weights(p, l, lds, wv); } SEAM(id); }
        for (int b_ = 0; b_ < NB; ++b_) {
            const int id0 = l_ * PH_PER_L + 1 + b_ * PH_PER_B;
            if (RUN(id0 + 0)) { const Params p = ldp(pw); const int l = ls(l_), b = ls(b_); (void)l; (void)b; ph_h(p, l, b, wv); }
            SEAM(id0 + 0);
            if (RUN(id0 + 1)) { const Params p = ldp(pw); const int l = ls(l_), b = ls(b_); (void)l; (void)b; char* ws = p.ws; { EpiIn E{ws, 0}; gemm8((const half_t*)(ws + OFF_H), (const half_t*)(ws + OFF_WT), TB, N16, 2048, E, lds, wv); }
                { EpiIn8 E8{ws, 0}; gemm8<EpiIn8, true>((const half_t*)(ws + OFF_H8), (const half_t*)(ws + OFF_WT8), TB, N8 - 512, 1024, E8, lds, wv); } }
            SEAM(id0 + 1);
            if (RUN(id0 + 2)) { const Params p = ldp(pw); const int l = ls(l_), b = ls(b_); (void)l; (void)b; ph_post(p, l, wv); }
            SEAM(id0 + 2);
            if (RUN(id0 + 3)) { const Params p = ldp(pw); const int l = ls(l_), b = ls(b_); (void)l; (void)b; { char* ws = p.ws; EpiIn8 E8{ws, (N8 - 512) / 256}; gemm8<EpiIn8, true>((const half_t*)(ws + OFF_H8), (const half_t*)(ws + OFF_WT8) + (size_t)(N8 - 512) * 1024, TB, 512, 1024, E8, lds, wv); }
                ph_attn(p, lds, wv); ph_ml_state(p, lds, wv); ph_index(p, lds, wv, 2 * l + b); }
            SEAM(id0 + 3);
            if (RUN(id0 + 4)) { const Params p = ldp(pw); const int l = ls(l_), b = ls(b_); (void)l; (void)b; ph_attn_comb(p, l, wv); ph_ml_scan(p, wv); ph_sparse(p, lds, wv, 2 * l + b); }
            SEAM(id0 + 4);
            if (RUN(id0 + 5)) { const Params p = ldp(pw); const int l = ls(l_), b = ls(b_); (void)l; (void)b; ph_ml_out(p, l, lds, wv);
                char* ws = p.ws; EpiMulH E{(half_t*)(ws + OFF_IQ), (const half_t*)(ws + OFF_DZ), 1024}; gemm8((const half_t*)(ws + OFF_DQ), (const half_t*)(ws + OFF_WUVT), TB, 1024, 512, E, lds, wv, 2048, 512); }
            SEAM(id0 + 5);
            if (RUN(id0 + 6)) { const Params p = ldp(pw); const int l = ls(l_), b = ls(b_); (void)l; (void)b; char* ws = p.ws;
                const half_t* Y[3] = {(const half_t*)(ws + OFF_QA), (const half_t*)(ws + OFF_YB), (const half_t*)(ws + OFF_IQ)};
#pragma unroll
                for (int i = 0; i < 3; ++i) { EpiGate E{(half_t*)(ws + OFF_MIX), (const unsigned char*)(ws + OFF_G), i * 2048, i == 0};
                    gemm8(Y[i], (const half_t*)(ws + OFF_WBT) + (size_t)i * 2048 * 1024, TB, 2048, 1024, E, lds, wv); } }
            SEAM(id0 + 6);
            if (RUN(id0 + 7)) { const Params p = ldp(pw); const int l = ls(l_), b = ls(b_); (void)l; (void)b; char* ws = p.ws; EpiOut E{(half_t*)(ws + OFF_OUTP)}; gemm8((const half_t*)(ws + OFF_MIX), (const half_t*)(ws + OFF_WOT), TB, 2048, 2048, E, lds, wv); }
            SEAM(id0 + 7);
            if (RUN(id0 + 8)) { const Params p = ldp(pw); const int l = ls(l_), b = ls(b_); (void)l; (void)b; ph_final(p, l, b, wv); }
            SEAM(id0 + 8);
        }
    }
#undef RUN
#undef SEAM
}

extern "C" void kernel_launch(void* const* d_in, const int* in_sizes, int n_in, void* d_out, int out_size, void* d_ws, size_t ws_size, hipStream_t stream) {
    (void)in_sizes; (void)n_in; (void)out_size;
    if (ws_size < WS_NEED) { fprintf(stderr, "workspace too small: %zu < %zu\n", ws_size, (size_t)WS_NEED); return; }
    static int grid = 0;
    if (!grid) {
        (void)hipFuncSetAttribute((const void*)fwd, hipFuncAttributeMaxDynamicSharedMemorySize, LDS_BYTES);
        int dev = 0, cus = 0, per_cu = 0; (void)hipGetDevice(&dev); (void)hipDeviceGetAttribute(&cus, hipDeviceAttributeMultiprocessorCount, dev);
        (void)hipOccupancyMaxActiveBlocksPerMultiprocessor(&per_cu, fwd, NTHREADS, LDS_BYTES);
        grid = (per_cu >= 1 && cus >= 256) ? 256 : 0;
        if (!grid) { fprintf(stderr, "kernel does not fit a CU\n"); return; }
    }
    Params p{};
    p.x = (const float*)d_in[0]; p.pre_g = (const float*)d_in[1]; p.w_in = (const float*)d_in[2]; p.da_lambda = (const float*)d_in[3]; p.da_norm_g = (const float*)d_in[4];
    p.ml_conv_w = (const float*)d_in[5]; p.ml_conv_b = (const float*)d_in[6]; p.ml_gate_b = (const float*)d_in[7]; p.ml_norm_g = (const float*)d_in[8];
    p.kv_norm_g = (const float*)d_in[9]; p.ik_norm_g = (const float*)d_in[10]; p.w_uv = (const float*)d_in[11]; p.w_branch = (const float*)d_in[12]; p.w_out = (const float*)d_in[13]; p.post_g = (const float*)d_in[14];
    p.out = (float*)d_out; p.ws = (char*)d_ws; p.ph_lo = 0; p.ph_hi = PH_TOTAL;
    (void)hipMemsetAsync((char*)d_ws + OFF_CTRL, 0, 65536, stream);
    hipLaunchKernelGGL(fwd, dim3(grid), dim3(NTHREADS), LDS_BYTES, stream, p);
}
```

```cpp
#include <hip/hip_runtime.h>
#include <stdint.h>
#include <stdio.h>

typedef _Float16 half_t;
typedef _Float16 h8 __attribute__((ext_vector_type(8)));
typedef _Float16 h4 __attribute__((ext_vector_type(4)));
typedef float f4 __attribute__((ext_vector_type(4)));
typedef float f16v __attribute__((ext_vector_type(16)));
typedef unsigned short u16;
#define LAS __attribute__((address_space(3)))
#define DEV __device__ __forceinline__

constexpr int D_MODEL = 2048, NB = 2, SEQ = 16384, DEPTH = 2, TB = SEQ;
constexpr int N_IN_SRC = 18776, N_IN = 18944;
constexpr int N16 = 16 * 256, N8 = 58 * 256;
constexpr float NORM_EPS = 1e-6f;
constexpr float LOG2E = 1.4426950408889634f;
constexpr int NTHREADS = 512, NWAVE = 8;
constexpr int TOPK = 256;

constexpr size_t U1 = (size_t)TB * 1024 * 2;
constexpr size_t OFF_CTRL = 0;
constexpr size_t OFF_WT   = 1 << 20;
constexpr size_t OFF_WT8  = OFF_WT + (size_t)N16 * 2048 * 2;
constexpr size_t OFF_WS8  = OFF_WT8 + (size_t)N8 * 2048;
constexpr size_t OFF_WBT  = (OFF_WS8 + (size_t)N8 * 4 + 4095) / 4096 * 4096;
constexpr size_t OFF_WOT  = OFF_WBT + (size_t)3 * 2048 * 1024 * 2;
constexpr size_t OFF_WUVT = OFF_WOT + (size_t)2048 * 2048 * 2;
constexpr size_t OFF_H    = OFF_WUVT + (size_t)1024 * 512 * 2;

constexpr size_t OFF_QA   = OFF_H + 2 * U1;
constexpr size_t OFF_KA   = OFF_QA + U1;
constexpr size_t OFF_VAT  = OFF_KA + U1;
constexpr size_t OFF_MIX  = OFF_KA;
constexpr size_t OFF_ST16 = OFF_KA;
constexpr size_t OFF_ZA   = OFF_VAT + U1;
constexpr size_t OFF_MQKR = OFF_ZA + U1;
constexpr size_t OFF_MVT  = OFF_MQKR + U1;
constexpr size_t OFF_MO   = OFF_MVT + U1;
constexpr size_t OFF_MZ   = OFF_MO + U1;
constexpr size_t OFF_DQ   = OFF_MZ + U1;
constexpr size_t OFF_IQ   = OFF_DQ + 2 * U1;
constexpr size_t OFF_DZ   = OFF_IQ + U1;
constexpr size_t OFF_G    = OFF_DZ + U1;
constexpr size_t OFF_ST   = OFF_G + 3 * U1;
constexpr size_t OFF_OUTP = OFF_ST;

constexpr size_t OFF_CKV  = OFF_ST + 4 * U1;
constexpr size_t OFF_SM   = OFF_CKV + (size_t)TB * 256 * 4;
constexpr size_t OFF_C    = OFF_SM + (size_t)TB * 96 * 4;
constexpr size_t OFF_IK   = OFF_C + (size_t)TB * 256 * 2;
constexpr size_t OFF_IW   = OFF_IK + (size_t)TB * 64 * 2;
constexpr size_t OFF_MG   = OFF_IW + (size_t)TB * 16 * 4;
constexpr size_t OFF_IDX  = OFF_MG + (size_t)TB * 8 * 4;
constexpr size_t OFF_CNT  = OFF_IDX + (size_t)TB * 256 * 2;
constexpr size_t OFF_NV   = OFF_CNT + (size_t)TB * 4;
constexpr size_t OFF_DEC  = OFF_NV + (size_t)4 * 256 * 128 * 4;
constexpr size_t OFF_SS   = OFF_DEC + 4096;
constexpr size_t OFF_OA0  = OFF_SS + (size_t)TB * 4;
constexpr size_t OFF_OA1  = OFF_OA0 + U1;
constexpr size_t OFF_MQKC = OFF_OA1 + U1;
constexpr size_t OFF_YB   = OFF_MQKR;
constexpr size_t OFF_H8   = OFF_MQKC + U1;
constexpr size_t OFF_HS   = OFF_H8 + U1;
constexpr size_t OFF_X1H  = OFF_HS + (size_t)TB * 4;
constexpr size_t WS_NEED  = OFF_X1H + (size_t)NB * TB * 2048 * 2;

struct Params {
    const float *x, *pre_g, *w_in, *da_lambda, *da_norm_g, *ml_conv_w, *ml_conv_b, *ml_gate_b, *ml_norm_g, *kv_norm_g, *ik_norm_g, *w_uv, *w_branch, *w_out, *post_g;
    float* out;
    char* ws;
    int ph_lo, ph_hi;
};

DEV int lv(int v) { asm volatile("" : "+v"(v)); return v; }
DEV int ls(int v) { asm volatile("" : "+s"(v)); return v; }
DEV int lane_id_v() { int l; asm volatile("v_mbcnt_lo_u32_b32 %0, -1, 0\n\tv_mbcnt_hi_u32_b32 %0, -1, %0" : "=v"(l)); return l; }
#define TID_DECL const int tidx = lv((ls(wv) << 6) | lane_id_v()); const int bidx = ls((int)blockIdx.x); const int nblk = ls((int)gridDim.x); (void)tidx; (void)bidx; (void)nblk;
DEV float silu_f(float v) { return v * __builtin_amdgcn_rcpf(1.f + __expf(-v)); }
DEV float sigm_f(float v) { return __builtin_amdgcn_rcpf(1.f + __expf(-v)); }
DEV float shi(float v, int src) { return __int_as_float(__builtin_amdgcn_ds_bpermute(src << 2, __float_as_int(v))); }
DEV int shi(int v, int src) { return __builtin_amdgcn_ds_bpermute(src << 2, v); }
DEV unsigned shi(unsigned v, int src) { return (unsigned)__builtin_amdgcn_ds_bpermute(src << 2, (int)v); }
DEV float shx(int lane, float v, int m) { return shi(v, lane ^ m); }
DEV float wave_sum(int lane, float v) {
#pragma unroll
    for (int o = 32; o >= 1; o >>= 1) v += shx(lane, v, o);
    return v;
}
DEV float gsum(int lane, float v) { v += shx(lane, v, 16); v += shx(lane, v, 32); return v; }
DEV float gmax(int lane, float v) { v = fmaxf(v, shx(lane, v, 16)); v = fmaxf(v, shx(lane, v, 32)); return v; }
DEV h8 cat44(h4 a, h4 b) { return (h8){a[0], a[1], a[2], a[3], b[0], b[1], b[2], b[3]}; }
DEV h4 toh4(f4 v) { return (h4){(half_t)v[0], (half_t)v[1], (half_t)v[2], (half_t)v[3]}; }
DEV h8 zero8() { return (h8){0, 0, 0, 0, 0, 0, 0, 0}; }
#define MFMA16(a, b, c) __builtin_amdgcn_mfma_f32_16x16x32_f16((a), (b), (c), 0, 0, 0)
#define MFMA32(a, b, c) __builtin_amdgcn_mfma_f32_32x32x16_f16((a), (b), (c), 0, 0, 0)

DEV int in_src_col(int n) {
    if (n < 2048) return n;
    if (n < 2304) return n - 2048 + 10248;
    if (n < 3328) return n - 2304 + 10504;
    if (n < 3584) { const int c = n - 3328; return c < 64 ? 11528 + c : c < 80 ? 11592 + (c - 64) : c < 88 ? 6144 + (c - 80) : -1; }
    return n - 3584 + 8200;
}
DEV int in_src_col8(int n) {
    if (n < 1024) return 3072 + n;
    if (n < 2048) return 6152 + (n - 1024);
    if (n < 3072) return 7176 + (n - 2048);
    if (n < 4096) return 11608 + (n - 3072);
    if (n < 5120) return 2048 + (n - 4096);
    if (n < 6144) return n;
    if (n < 7168) return 4096 + (n - 6144);
    if (n < 13312) return 12632 + (n - 7168);
    return 8200 + 512 + (n - 13312);
}
template <class F> DEV void tr_tile(half_t* dst, int Kd, int n0, int k0, F src, LAS float* tile  , int tidx) {
    const int tid = tidx;
    __syncthreads();
#pragma unroll
    for (int j = 0; j < 8; ++j) { const int kk = (tid >> 6) + 8 * j, nn = tid & 63; tile[kk * 65 + nn] = src(k0 + kk, n0 + nn); }
    __syncthreads();
#pragma unroll
    for (int j = 0; j < 8; ++j) { const int nn = (tid >> 6) + 8 * j, kk = tid & 63; dst[(size_t)(n0 + nn) * Kd + k0 + kk] = (half_t)tile[kk * 65 + nn]; }
}
DEV void ph_weights(const Params& p, int l, LAS char* lds, int wv) {
    TID_DECL
    LAS float* tile = (LAS float*)lds;
    half_t* Wt = (half_t*)(p.ws + OFF_WT); half_t* Wbt = (half_t*)(p.ws + OFF_WBT); half_t* Wot = (half_t*)(p.ws + OFF_WOT); half_t* Wuvt = (half_t*)(p.ws + OFF_WUVT);
    const float* w_in = p.w_in + (size_t)l * 2048 * N_IN_SRC;
    const float* w_br = p.w_branch + (size_t)l * 3 * 1024 * 2048;
    const float* w_out = p.w_out + (size_t)l * 2048 * 2048;
    const float* w_uv = p.w_uv + (size_t)l * 8 * 256 * 128;
    constexpr int T_I8 = N8 / 64, T_IN = (N16 / 64) * 32, T_BR = 3 * 32 * 16, T_OUT = 32 * 32, T_UV = 16 * 8;
    for (int u0 = bidx; u0 < T_I8 + T_IN + T_BR + T_OUT + T_UV; u0 += nblk) {
        if (u0 < T_I8) {
            const int n0 = u0 * 64, nn = tidx & 63, kg = tidx >> 6; const int s = in_src_col8(n0 + nn);
            LAS float* red = tile + 64 * 65;
            float mx = 0.f;
            for (int kk = kg; kk < 2048; kk += 8) mx = fmaxf(mx, fabsf(w_in[(size_t)kk * N_IN_SRC + s]));
            __syncthreads(); red[kg * 64 + nn] = mx; __syncthreads();
            if (tidx < 64) { float m = red[nn];
#pragma unroll
                for (int j = 1; j < 8; ++j) m = fmaxf(m, red[j * 64 + nn]);
                red[512 + nn] = m > 0.f ? 127.f / m : 0.f; ((float*)(p.ws + OFF_WS8))[n0 + nn] = m * (1.f / 127.f); }
            __syncthreads();
            const float inv = red[512 + nn];
            unsigned char* W8 = (unsigned char*)(p.ws + OFF_WT8);
            for (int kt = 0; kt < 32; ++kt) {
                __syncthreads();
#pragma unroll
                for (int j = 0; j < 8; ++j) { const int kk = kg + 8 * j; tile[kk * 65 + nn] = w_in[(size_t)(kt * 64 + kk) * N_IN_SRC + s] * inv; }
                __syncthreads();
                const int n2 = tidx >> 3, kq = tidx & 7; unsigned w0 = 0u, w1 = 0u;
#pragma unroll
                for (int j = 0; j < 4; ++j) { w0 |= ((unsigned)(int)__builtin_rintf(tile[(8 * kq + j) * 65 + n2]) & 255u) << (8 * j); w1 |= ((unsigned)(int)__builtin_rintf(tile[(8 * kq + 4 + j) * 65 + n2]) & 255u) << (8 * j); }
                *(uint2*)(W8 + (size_t)(n0 + n2) * 2048 + kt * 64 + 8 * kq) = make_uint2(w0, w1);
            }
            continue;
        }
        const int u = u0 - T_I8;
        if (u < T_IN) { const int nt = u / 32, kt = u % 32;
            tr_tile(Wt, 2048, nt * 64, kt * 64, [&](int k, int n) { const int s = in_src_col(n); return s < 0 ? 0.f : w_in[(size_t)k * N_IN_SRC + s]; }, tile, tidx);
        } else if (u < T_IN + T_BR) { const int v = u - T_IN, i = v / 512, r = v % 512, nt = r / 16, kt = r % 16;
            const float* src = w_br + (size_t)i * 1024 * 2048;
            tr_tile(Wbt + (size_t)i * 2048 * 1024, 1024, nt * 64, kt * 64, [&](int k, int n) { return src[(size_t)k * 2048 + n]; }, tile, tidx);
        } else if (u < T_IN + T_BR + T_OUT) { const int v = u - T_IN - T_BR, nt = v / 32, kt = v % 32;
            tr_tile(Wot, 2048, nt * 64, kt * 64, [&](int k, int n) { return w_out[(size_t)k * 2048 + n]; }, tile, tidx);
        } else { const int v = u - T_IN - T_BR - T_OUT, nt = v / 8, kt = v % 8;
            tr_tile(Wuvt, 512, nt * 64, kt * 64, [&](int k, int n) { const int hh = n >> 7, vv = n & 127; const int c = k - (hh & 1) * 256; return (c >= 0 && c < 256) ? w_uv[((size_t)hh * 256 + c) * 128 + vv] : 0.f; }, tile, tidx);
        }
    }
}

DEV void ph_h(const Params& p, int l, int b, int wv) {
    TID_DECL
    const float* X = p.x + (size_t)b * TB * 2048; const half_t* XH = (const half_t*)(p.ws + OFF_X1H) + (size_t)b * TB * 2048;
    const float* g = p.pre_g + l * 2048;
    half_t* H = (half_t*)(p.ws + OFF_H); unsigned char* H8 = (unsigned char*)(p.ws + OFF_H8); float* HS = (float*)(p.ws + OFF_HS);
    const int lane = tidx & 63, wid = tidx >> 6;
    for (int t = bidx * NWAVE + wid; t < TB; t += nblk * NWAVE) {
        const float* xr = X + (size_t)t * 2048; f4 v[8]; float ss = 0.f;
#pragma unroll
        for (int i = 0; i < 8; ++i) { if (l == 0) v[i] = *(const f4*)(xr + i * 256 + lane * 4); else { const h4 xh = *(const h4*)(XH + (size_t)t * 2048 + i * 256 + lane * 4); v[i] = (f4){(float)xh[0], (float)xh[1], (float)xh[2], (float)xh[3]}; }
            ss += v[i][0] * v[i][0] + v[i][1] * v[i][1] + v[i][2] * v[i][2] + v[i][3] * v[i][3]; }
        ss = wave_sum(lane, ss); const float rs = rsqrtf(ss * (1.f / 2048.f) + NORM_EPS);
#pragma unroll
        for (int i = 0; i < 8; ++i) { const f4 gg = *(const f4*)(g + i * 256 + lane * 4); v[i] = v[i] * rs * gg; *(h4*)(H + (size_t)t * 2048 + i * 256 + lane * 4) = toh4(v[i]); }
        float mx = 0.f;
#pragma unroll
        for (int i = 0; i < 8; ++i) mx = fmaxf(fmaxf(mx, fmaxf(fabsf(v[i][0]), fabsf(v[i][1]))), fmaxf(fabsf(v[i][2]), fabsf(v[i][3])));
#pragma unroll
        for (int o = 32; o >= 1; o >>= 1) mx = fmaxf(mx, shx(lane, mx, o));
        const float inv = mx > 0.f ? 127.f / mx : 0.f;
#pragma unroll
        for (int i = 0; i < 8; ++i) { unsigned w = 0u;
#pragma unroll
            for (int e = 0; e < 4; ++e) w |= ((unsigned)(int)__builtin_rintf(v[i][e] * inv) & 255u) << (8 * e);
            *(unsigned*)(H8 + (size_t)t * 2048 + i * 256 + lane * 4) = w; }
        if (lane == 0) HS[t] = mx * (1.f / 127.f);
    }
}

template <class Epi> DEV void gemm_simple(const half_t* A, int lda, const half_t* Bt, int ldb, int M, int N, int K, int a_koff, const Epi& E, int wv) {
    TID_DECL
    const int lane = tidx & 63, wid = tidx >> 6, r = lane & 15, g = lane >> 4, wm = wid & 1, wn = wid >> 1;
    const int nM = M / 128, nN = N / 256;
    for (int u = bidx; u < nM * nN; u += nblk) {
        const int pn = u / nM, pm = u % nM; const int m0 = pm * 128 + wm * 64, n0 = pn * 256 + wn * 64;
        const half_t* Ab = A + (size_t)(m0 + r) * lda + (size_t)pn * a_koff + 8 * g;
        const half_t* Bb = Bt + (size_t)(n0 + r) * ldb + 8 * g;
        f4 acc[4][4];
#pragma unroll
        for (int i = 0; i < 4; ++i)
#pragma unroll
            for (int j = 0; j < 4; ++j) acc[i][j] = (f4){0.f, 0.f, 0.f, 0.f};
        for (int k0 = 0; k0 < K; k0 += 32) {
            h8 a[4], bb[4];
#pragma unroll
            for (int i = 0; i < 4; ++i) { a[i] = *(const h8*)(Ab + (size_t)i * 16 * lda + k0); bb[i] = *(const h8*)(Bb + (size_t)i * 16 * ldb + k0); }
#pragma unroll
            for (int i = 0; i < 4; ++i)
#pragma unroll
                for (int j = 0; j < 4; ++j) acc[i][j] = MFMA16(bb[j], a[i], acc[i][j]);
        }
#pragma unroll
        for (int i = 0; i < 4; ++i)
#pragma unroll
            for (int j = 0; j < 4; ++j) E.store4(m0 + 16 * i + r, n0 + 16 * j + 4 * g, acc[i][j]);
    }
}

typedef unsigned u32x4_t __attribute__((ext_vector_type(4)));
template <int ND> DEV void xchg_rows(u32x4_t& a, u32x4_t& b) { u32x4_t a2 = a, b2 = b;
#pragma unroll
    for (int d = 0; d < ND; ++d) { a2[d] = (unsigned)__builtin_amdgcn_update_dpp((int)a[d], (int)b[d], 0x118  , 0xF, 0xF, false);
                                   b2[d] = (unsigned)__builtin_amdgcn_update_dpp((int)b[d], (int)a[d], 0x108  , 0xF, 0xF, false); }
    a = a2; b = b2; }
template <int ND> DEV void store_nd(char* p, const u32x4_t& v) { typedef unsigned u32x2_t __attribute__((ext_vector_type(2)));
    if constexpr (ND == 4) __builtin_nontemporal_store(v, (u32x4_t*)p); else __builtin_nontemporal_store((u32x2_t){v[0], v[1]}, (u32x2_t*)p); }
template <int ND, class DST> DEV void store_pair(int row, int c, u32x4_t a, u32x4_t b, const DST& dst) {
    xchg_rows<ND>(a, b); const int f8 = row & 8;
    store_nd<ND>(dst(row - f8, c + 4 * f8), a); store_nd<ND>(dst(row + 8 - f8, c + 4 * f8), b); }
struct EpiIn {
    char* ws; int pn_base;
    static constexpr bool HAS_TILE = true;
    template <int SEG> DEV void st(int row, int c, f4 v) const {
        if constexpr (SEG == 0) *(h4*)((half_t*)(ws + OFF_QA) + (size_t)row * 1024 + c) = toh4(v * (0.125f * LOG2E));
        else if constexpr (SEG == 1) *(h4*)((half_t*)(ws + OFF_KA) + (size_t)row * 1024 + c) = toh4(v);
        else if constexpr (SEG == 2) *(h4*)((half_t*)(ws + OFF_VAT) + (size_t)row * 1024 + c) = toh4(v);
        else if constexpr (SEG == 3) *(h4*)((half_t*)(ws + OFF_ZA) + (size_t)row * 1024 + c) = toh4((f4){silu_f(v[0]), silu_f(v[1]), silu_f(v[2]), silu_f(v[3])});
        else if constexpr (SEG == 4) *(h4*)((half_t*)(ws + OFF_MQKR) + (size_t)row * 1024 + c) = toh4(v);
        else if constexpr (SEG == 5) { half_t* d = (half_t*)(ws + OFF_MVT) + (size_t)c * TB + row;
#pragma unroll
            for (int e = 0; e < 4; ++e) d[(size_t)e * TB] = (half_t)v[e]; }
        else if constexpr (SEG == 6) *(h4*)((half_t*)(ws + OFF_MO) + (size_t)row * 1024 + c) = toh4((f4){sigm_f(v[0]), sigm_f(v[1]), sigm_f(v[2]), sigm_f(v[3])});
        else if constexpr (SEG == 7) *(h4*)((half_t*)(ws + OFF_MZ) + (size_t)row * 1024 + c) = toh4((f4){silu_f(v[0]), silu_f(v[1]), silu_f(v[2]), silu_f(v[3])});
        else if constexpr (SEG == 8) *(h4*)((half_t*)(ws + OFF_DQ) + (size_t)row * 2048 + c) = toh4(v * (0.0625f * LOG2E));
        else if constexpr (SEG == 9) *(f4*)((float*)(ws + OFF_CKV) + (size_t)row * 256 + c) = v;
        else if constexpr (SEG == 10) *(h4*)((half_t*)(ws + OFF_IQ) + (size_t)row * 1024 + c) = toh4(v);
        else if constexpr (SEG == 11) { if (c < 96) *(f4*)((float*)(ws + OFF_SM) + (size_t)row * 96 + c) = v; }
        else if constexpr (SEG == 12) *(h4*)((half_t*)(ws + OFF_DZ) + (size_t)row * 1024 + c) = toh4((f4){silu_f(v[0]), silu_f(v[1]), silu_f(v[2]), silu_f(v[3])});
        else *(h4*)((half_t*)(ws + OFF_G) + (size_t)row * 6144 + c) = toh4((f4){sigm_f(v[0]), sigm_f(v[1]), sigm_f(v[2]), sigm_f(v[3])});
    }
    DEV static h8 pack8(f4 a, f4 b) { return (h8){(half_t)a[0], (half_t)a[1], (half_t)a[2], (half_t)a[3], (half_t)b[0], (half_t)b[1], (half_t)b[2], (half_t)b[3]}; }
    DEV static f4 silu4(f4 v) { return (f4){silu_f(v[0]), silu_f(v[1]), silu_f(v[2]), silu_f(v[3])}; }
    DEV static f4 sigm4(f4 v) { return (f4){sigm_f(v[0]), sigm_f(v[1]), sigm_f(v[2]), sigm_f(v[3])}; }
    template <int SEG> DEV void st8(int row, int c, f4 a, f4 b) const {
        if constexpr (SEG == 0) __builtin_nontemporal_store(pack8(a * (0.125f * LOG2E), b * (0.125f * LOG2E)), (h8*)((half_t*)(ws + OFF_QA) + (size_t)row * 1024 + c));
        else if constexpr (SEG == 1) __builtin_nontemporal_store(pack8(a, b), (h8*)((half_t*)(ws + OFF_KA) + (size_t)row * 1024 + c));
        else if constexpr (SEG == 2) __builtin_nontemporal_store(pack8(a, b), (h8*)((half_t*)(ws + OFF_VAT) + (size_t)row * 1024 + c));
        else if constexpr (SEG == 3) __builtin_nontemporal_store(pack8(silu4(a), silu4(b)), (h8*)((half_t*)(ws + OFF_ZA) + (size_t)row * 1024 + c));
        else if constexpr (SEG == 4) __builtin_nontemporal_store(pack8(a, b), (h8*)((half_t*)(ws + OFF_MQKR) + (size_t)row * 1024 + c));
        else if constexpr (SEG == 5) __builtin_nontemporal_store(pack8(a, b), (h8*)((half_t*)(ws + OFF_MVT) + (size_t)row * 1024 + c));
        else if constexpr (SEG == 6) __builtin_nontemporal_store(pack8(sigm4(a), sigm4(b)), (h8*)((half_t*)(ws + OFF_MO) + (size_t)row * 1024 + c));
        else if constexpr (SEG == 7) __builtin_nontemporal_store(pack8(silu4(a), silu4(b)), (h8*)((half_t*)(ws + OFF_MZ) + (size_t)row * 1024 + c));
        else if constexpr (SEG == 8) __builtin_nontemporal_store(pack8(a * (0.0625f * LOG2E), b * (0.0625f * LOG2E)), (h8*)((half_t*)(ws + OFF_DQ) + (size_t)row * 2048 + c));
        else if constexpr (SEG == 10) __builtin_nontemporal_store(pack8(a, b), (h8*)((half_t*)(ws + OFF_IQ) + (size_t)row * 1024 + c));
        else if constexpr (SEG == 12) __builtin_nontemporal_store(pack8(silu4(a), silu4(b)), (h8*)((half_t*)(ws + OFF_DZ) + (size_t)row * 1024 + c));
        else if constexpr (SEG == 13) { const f4 sa = sigm4(a) * 255.f, sb = sigm4(b) * 255.f; typedef unsigned u32x2_t __attribute__((ext_vector_type(2)));
            unsigned w0 = 0u, w1 = 0u;
            w0 = __builtin_amdgcn_cvt_pk_u8_f32(sa[0], 0, w0); w0 = __builtin_amdgcn_cvt_pk_u8_f32(sa[1], 1, w0); w0 = __builtin_amdgcn_cvt_pk_u8_f32(sa[2], 2, w0); w0 = __builtin_amdgcn_cvt_pk_u8_f32(sa[3], 3, w0);
            w1 = __builtin_amdgcn_cvt_pk_u8_f32(sb[0], 0, w1); w1 = __builtin_amdgcn_cvt_pk_u8_f32(sb[1], 1, w1); w1 = __builtin_amdgcn_cvt_pk_u8_f32(sb[2], 2, w1); w1 = __builtin_amdgcn_cvt_pk_u8_f32(sb[3], 3, w1);
            __builtin_nontemporal_store((u32x2_t){w0, w1}, (u32x2_t*)((unsigned char*)(ws + OFF_G) + (size_t)row * 6144 + c)); }
        else { st<SEG>(row, c, a); st<SEG>(row, c + 4, b); }
    }
    template <int SEG> DEV static u32x4_t pk8(f4 a, f4 b) {
        if constexpr (SEG == 0) return __builtin_bit_cast(u32x4_t, pack8(a * (0.125f * LOG2E), b * (0.125f * LOG2E)));
        else if constexpr (SEG == 8) return __builtin_bit_cast(u32x4_t, pack8(a * (0.0625f * LOG2E), b * (0.0625f * LOG2E)));
        else if constexpr (SEG == 3 || SEG == 7 || SEG == 12) return __builtin_bit_cast(u32x4_t, pack8(silu4(a), silu4(b)));
        else if constexpr (SEG == 6) return __builtin_bit_cast(u32x4_t, pack8(sigm4(a), sigm4(b)));
        else if constexpr (SEG == 13) { const f4 sa = sigm4(a) * 255.f, sb = sigm4(b) * 255.f; unsigned w0 = 0u, w1 = 0u;
            w0 = __builtin_amdgcn_cvt_pk_u8_f32(sa[0], 0, w0); w0 = __builtin_amdgcn_cvt_pk_u8_f32(sa[1], 1, w0); w0 = __builtin_amdgcn_cvt_pk_u8_f32(sa[2], 2, w0); w0 = __builtin_amdgcn_cvt_pk_u8_f32(sa[3], 3, w0);
            w1 = __builtin_amdgcn_cvt_pk_u8_f32(sb[0], 0, w1); w1 = __builtin_amdgcn_cvt_pk_u8_f32(sb[1], 1, w1); w1 = __builtin_amdgcn_cvt_pk_u8_f32(sb[2], 2, w1); w1 = __builtin_amdgcn_cvt_pk_u8_f32(sb[3], 3, w1);
            return (u32x4_t){w0, w1, 0u, 0u}; }
        else return __builtin_bit_cast(u32x4_t, pack8(a, b));
    }
    template <int SEG> DEV char* dst8(int row, int c) const {
        if constexpr (SEG == 0) return ws + OFF_QA + ((size_t)row * 1024 + c) * 2; else if constexpr (SEG == 1) return ws + OFF_KA + ((size_t)row * 1024 + c) * 2;
        else if constexpr (SEG == 2) return ws + OFF_VAT + ((size_t)row * 1024 + c) * 2; else if constexpr (SEG == 3) return ws + OFF_ZA + ((size_t)row * 1024 + c) * 2;
        else if constexpr (SEG == 4) return ws + OFF_MQKR + ((size_t)row * 1024 + c) * 2; else if constexpr (SEG == 5) return ws + OFF_MVT + ((size_t)row * 1024 + c) * 2;
        else if constexpr (SEG == 6) return ws + OFF_MO + ((size_t)row * 1024 + c) * 2; else if constexpr (SEG == 7) return ws + OFF_MZ + ((size_t)row * 1024 + c) * 2;
        else if constexpr (SEG == 8) return ws + OFF_DQ + ((size_t)row * 2048 + c) * 2; else if constexpr (SEG == 10) return ws + OFF_IQ + ((size_t)row * 1024 + c) * 2;
        else if constexpr (SEG == 12) return ws + OFF_DZ + ((size_t)row * 1024 + c) * 2; else return ws + OFF_G + (size_t)row * 6144 + c;
    }
    template <int SEG> DEV void pair(int row, int c, f4 a0, f4 a1, f4 b0, f4 b1) const {
        if constexpr (SEG == 9 || SEG == 11) { st8<SEG>(row, c, a0, a1); st8<SEG>(row, c + 32, b0, b1); }
        else store_pair<(SEG == 13 ? 2 : 4)>(row, c, pk8<SEG>(a0, a1), pk8<SEG>(b0, b1), [&](int r_, int c_) { return dst8<SEG>(r_, c_); });
    }
    template <int SEG> DEV void run(const f4 (&acc)[2][2][4][2], int row0, int c0) const {
#pragma unroll
        for (int ai = 0; ai < 2; ++ai)
#pragma unroll
            for (int m = 0; m < 4; ++m) { const int row = row0 + ai * 128 + m * 16;
                pair<SEG>(row, c0, acc[ai][0][m][0], acc[ai][0][m][1], acc[ai][1][m][0], acc[ai][1][m][1]); }
    }
    DEV void tile(const f4 (&acc)[2][2][4][2], int pm, int pn, int wr, int wc, int fr, int fq) const {
        const int t = __builtin_amdgcn_readfirstlane(pn) + pn_base; const int row0 = pm * 256 + wr * 64 + fr, cw = wc * 64 + 8 * fq;
        if (t < 4) run<0>(acc, row0, t * 256 + cw); else if (t < 8) run<1>(acc, row0, (t - 4) * 256 + cw); else if (t < 9) run<9>(acc, row0, cw);
        else if (t < 13) run<10>(acc, row0, (t - 9) * 256 + cw); else if (t < 14) run<11>(acc, row0, cw); else run<8>(acc, row0, (t - 14) * 256 + cw);
    }
};
struct EpiIn8 {
    char* ws; int pn_base;
    static constexpr bool HAS_TILE = true;
    DEV static f4 cvt(const f4& a, const f4& s) { return (f4){(float)__float_as_int(a[0]) * s[0], (float)__float_as_int(a[1]) * s[1], (float)__float_as_int(a[2]) * s[2], (float)__float_as_int(a[3]) * s[3]}; }
    template <int SEG> DEV void run(const f4 (&acc)[2][2][4][2], int row0, int c0, int cg) const {
        const EpiIn e{ws, 0}; const float* HS = (const float*)(ws + OFF_HS); const float* WS8 = (const float*)(ws + OFF_WS8);
        const f4 s00 = *(const f4*)(WS8 + cg), s01 = *(const f4*)(WS8 + cg + 4), s10 = *(const f4*)(WS8 + cg + 32), s11 = *(const f4*)(WS8 + cg + 36);
#pragma unroll
        for (int ai = 0; ai < 2; ++ai)
#pragma unroll
            for (int m = 0; m < 4; ++m) { const int row = row0 + ai * 128 + m * 16; const float hs = HS[row];
                e.template pair<SEG>(row, c0, cvt(acc[ai][0][m][0], s00 * hs), cvt(acc[ai][0][m][1], s01 * hs), cvt(acc[ai][1][m][0], s10 * hs), cvt(acc[ai][1][m][1], s11 * hs)); }
    }
    DEV void tile(const f4 (&acc)[2][2][4][2], int pm, int pn, int wr, int wc, int fr, int fq) const {
        const int t = __builtin_amdgcn_readfirstlane(pn) + pn_base; const int row0 = pm * 256 + wr * 64 + fr, cw = wc * 64 + 8 * fq, cg = t * 256 + cw;
        if (t < 4) run<3>(acc, row0, t * 256 + cw, cg); else if (t < 8) run<6>(acc, row0, (t - 4) * 256 + cw, cg); else if (t < 12) run<7>(acc, row0, (t - 8) * 256 + cw, cg);
        else if (t < 16) run<12>(acc, row0, (t - 12) * 256 + cw, cg); else if (t < 20) run<2>(acc, row0, (t - 16) * 256 + cw, cg); else if (t < 24) run<5>(acc, row0, (t - 20) * 256 + cw, cg);
        else if (t < 28) run<4>(acc, row0, (t - 24) * 256 + cw, cg); else if (t < 52) run<13>(acc, row0, (t - 28) * 256 + cw, cg); else run<8>(acc, row0, (t - 50) * 256 + cw, cg);
    }
};
struct EpiMulH {
    static constexpr bool HAS_TILE = false;
    half_t* O; const half_t* Z; int ld;
    DEV u32x4_t make8(int row, int col, f4 v0, f4 v1) const { const h8 z = *(const h8*)(Z + (size_t)row * ld + col);
        return __builtin_bit_cast(u32x4_t, (h8){(half_t)(v0[0] * (float)z[0]), (half_t)(v0[1] * (float)z[1]), (half_t)(v0[2] * (float)z[2]), (half_t)(v0[3] * (float)z[3]),
                                                   (half_t)(v1[0] * (float)z[4]), (half_t)(v1[1] * (float)z[5]), (half_t)(v1[2] * (float)z[6]), (half_t)(v1[3] * (float)z[7])}); }
    DEV char* dst(int row, int col) const { return (char*)(O + (size_t)row * ld + col); }
};
struct EpiGate {
    static constexpr bool HAS_TILE = false;
    half_t* MIXp; const unsigned char* G; int goff; bool first;
    DEV char* dst(int row, int col) const { return (char*)(MIXp + (size_t)row * 2048 + col); }
    DEV u32x4_t make8(int row, int col, f4 v0, f4 v1) const { typedef unsigned u32x2_t __attribute__((ext_vector_type(2)));
        const u32x2_t gw = *(const u32x2_t*)(G + (size_t)row * 6144 + goff + col);
        float o[8];
#pragma unroll
        for (int e = 0; e < 4; ++e) { o[e] = v0[e] * ((float)((gw[0] >> (8 * e)) & 255u) * (1.f / 255.f)); o[4 + e] = v1[e] * ((float)((gw[1] >> (8 * e)) & 255u) * (1.f / 255.f)); }
        half_t* d = MIXp + (size_t)row * 2048 + col;
        if (!first) { const h8 pz = *(const h8*)d;
#pragma unroll
            for (int e = 0; e < 8; ++e) o[e] += (float)pz[e]; }
        h8 r8;
#pragma unroll
        for (int e = 0; e < 8; ++e) r8[e] = (half_t)o[e];
        return __builtin_bit_cast(u32x4_t, r8); }
};
struct EpiOut {
    static constexpr bool HAS_TILE = false;
    half_t* O;
    DEV u32x4_t make8(int, int, f4 v0, f4 v1) const { return __builtin_bit_cast(u32x4_t, (h8){(half_t)v0[0], (half_t)v0[1], (half_t)v0[2], (half_t)v0[3], (half_t)v1[0], (half_t)v1[1], (half_t)v1[2], (half_t)v1[3]}); }
    DEV char* dst(int row, int col) const { return (char*)(O + (size_t)row * 2048 + col); }
};

namespace pg8 {
#define PG8_LAS __attribute__((address_space(3)))
typedef unsigned short bf16_t;
typedef _Float16 bf16x8 __attribute__((ext_vector_type(8)));
typedef float f32x4 __attribute__((ext_vector_type(4)));
typedef unsigned u32x4 __attribute__((ext_vector_type(4)));
constexpr int BM = 256, BK = 64, HALF = 128, HTB = HALF * BK * 2  , STAGE_BYTES = 8 * HTB, NXCD = 8, WGM = 8;

__host__ __device__ __forceinline__ int lds_byte(int r, int c) { const int st = (r >> 4) * 2 + (c >> 5), rr = r & 15, cc = c & 31, ob = rr * 64 + cc * 2; return st * 1024 + (ob ^ (((ob >> 9) & 1) << 5)); }
__host__ __device__ __forceinline__ void stage_rc(int b, int& R, int& C) { const int st = b / 1024, sb = b % 1024, swz = sb ^ (((sb >> 9) & 1) << 5); R = (st >> 1) * 16 + swz / 64; C = (st & 1) * 32 + (swz % 64) / 2; }
__host__ __device__ __forceinline__ int perm32(int rho) { const int n = rho >> 4, i = rho & 15; return 8 * (i >> 2) + 4 * n + (i & 3); }

struct Unit { int pm, pn; };
struct Gemm { const bf16_t* A; const bf16_t* Bt; int M, N, K; int lda, a_koff; };

struct StaticOrder {
    int nM, nN, nwg, G, c;
    __host__ __device__ void init(int M, int N, int G_, int c_) { nM = M / BM; nN = N / BM; nwg = nM * nN; G = G_; c = c_; }
    __host__ __device__ bool next(int i, Unit& u) const {
        const long L = (long)i * G + c; if (L >= nwg) return false;
        int wgid = (int)L; { const int q = nwg / NXCD, r = nwg % NXCD, xcd = wgid % NXCD, off = wgid / NXCD; wgid = (xcd < r ? xcd * (q + 1) : r * (q + 1) + (xcd - r) * q) + off; }
        const int nig = WGM * nN, gid = wgid / nig, fm = gid * WGM, gsz = (nM - fm) < WGM ? (nM - fm) : WGM;
        u.pm = fm + ((wgid % nig) % gsz); u.pn = (wgid % nig) / gsz; return true;
    }
    __device__ __forceinline__ void a_ready(const Unit&) const {}
    __device__ __forceinline__ void done(const Unit&) const {}
};
typedef int i32x4 __attribute__((ext_vector_type(4)));
template <class Epi, class Sched, bool ALIGN_EPI = false, bool SP2 = false, bool I8 = false>
__device__ __forceinline__ void gemm_phase(PG8_LAS unsigned char* lds, const Gemm g, const Sched& S, const Epi& E, const int tid) {
    const int wid = __builtin_amdgcn_readfirstlane(tid >> 6), lane = tid & 63, wr = wid >> 2, wc = wid & 3, fr = lane & 15, fq = lane >> 4;
    const int K = g.K, nt = K / BK;
    unsigned voffA[2], voffB[2];
#pragma unroll
    for (int i = 0; i < 2; ++i) { int R, C; stage_rc(tid * 16 + i * 8192, R, C); const int Rb = Epi::PERM ? ((R & ~31) + perm32(R & 31)) : R;
        voffA[i] = (unsigned)(R * g.lda + C) * 2u; voffB[i] = (unsigned)((Epi::PERM ? ((R >> 5) * 64 + perm32(R & 31)) : Rb) * K + C) * 2u; }
    const size_t kstep = (size_t)(BK * 2);
    const size_t hstepA = (size_t)HALF * g.lda * 2, tstepA = 2 * hstepA, akoff = (size_t)g.a_koff * 2;
    const size_t hstep = (size_t)(Epi::PERM ? 32 : HALF) * K * 2;
    const size_t tstep = (size_t)BM * K * 2;
    const unsigned ldsw = (unsigned)wid * 1024u;
    const int aoff = lds_byte(wr * 64 + fr, fq * 8), boff = lds_byte(wc * 32 + fr, fq * 8);
#define PG8_SA(b, h) (((b) * 2 + (h)) * HTB)
#define PG8_SB(b, h) ((4 + (b) * 2 + (h)) * HTB)
#define PG8_STAGE(bufoff, gbase, voff) do { _Pragma("unroll") for (int _i = 0; _i < 2; ++_i) \
        __builtin_amdgcn_global_load_lds((const unsigned*)((const char*)(gbase) + (voff)[_i]), (PG8_LAS unsigned*)(lds + (bufoff) + ldsw + _i * 8192), 16, 0, 0); } while (0)
#define PG8_LDA(dst, b, h) do { _Pragma("unroll") for (int m = 0; m < 4; ++m) _Pragma("unroll") for (int k = 0; k < 2; ++k) dst[m][k] = *(const PG8_LAS bf16x8*)(lds + PG8_SA(b, h) + aoff + m * 2048 + k * 1024); } while (0)
#define PG8_LDB(dst, b, h) do { _Pragma("unroll") for (int n = 0; n < 2; ++n) _Pragma("unroll") for (int k = 0; k < 2; ++k) dst[n][k] = *(const PG8_LAS bf16x8*)(lds + PG8_SB(b, h) + boff + n * 2048 + k * 1024); } while (0)
#define PG8_MMA(ai, bj, At, Bt) do { __builtin_amdgcn_s_setprio(1); _Pragma("unroll") for (int m = 0; m < 4; ++m) _Pragma("unroll") for (int n = 0; n < 2; ++n) _Pragma("unroll") for (int k = 0; k < 2; ++k) \
        { if constexpr (I8) acc[ai][bj][m][n] = __builtin_bit_cast(f32x4, __builtin_amdgcn_mfma_i32_16x16x64_i8(__builtin_bit_cast(i32x4, Bt[n][k]), __builtin_bit_cast(i32x4, At[m][k]), __builtin_bit_cast(i32x4, acc[ai][bj][m][n]), 0, 0, 0)); \
          else acc[ai][bj][m][n] = __builtin_amdgcn_mfma_f32_16x16x32_f16(Bt[n][k], At[m][k], acc[ai][bj][m][n], 0, 0, 0); } __builtin_amdgcn_s_setprio(0); } while (0)
#define PG8_WAIT_V(n) asm volatile("s_waitcnt vmcnt(" #n ")" ::: "memory")
#define PG8_WAIT_L(n) asm volatile("s_waitcnt lgkmcnt(" #n ")" ::: "memory")
#define PG8_BAR __builtin_amdgcn_s_barrier()
#define PG8_SCHED __builtin_amdgcn_sched_barrier(0)
    Unit cur, nxt; int ui = 0;
    if (!S.next(0, cur)) return;
    f32x4 acc[2][2][4][2];
#pragma unroll
    for (int a = 0; a < 2; ++a)
#pragma unroll
        for (int b = 0; b < 2; ++b)
#pragma unroll
            for (int m = 0; m < 4; ++m)
#pragma unroll
                for (int n = 0; n < 2; ++n) acc[a][b][m][n] = (f32x4){0.f, 0.f, 0.f, 0.f};
    bf16x8 At[4][2], B0[2][2], B1[2][2];
    const char* cA = (const char*)g.A + (size_t)cur.pm * tstepA + (size_t)cur.pn * akoff; const char* cB = (const char*)g.Bt + (size_t)cur.pn * tstep;
    S.a_ready(cur);
    if constexpr (SP2) {
        PG8_STAGE(PG8_SB(0, 0), cB, voffB); PG8_STAGE(PG8_SB(0, 1), cB + hstep, voffB); PG8_STAGE(PG8_SA(0, 0), cA, voffA); PG8_STAGE(PG8_SA(0, 1), cA + hstepA, voffA);
        if (wr == 1) PG8_BAR;
        PG8_WAIT_V(2); PG8_BAR;
        PG8_STAGE(PG8_SB(1, 0), cB + kstep, voffB); PG8_STAGE(PG8_SA(1, 0), cA + kstep, voffA); PG8_STAGE(PG8_SB(1, 1), cB + hstep + kstep, voffB);
        PG8_WAIT_V(6); PG8_BAR;
    } else {
        PG8_STAGE(PG8_SB(0, 0), cB, voffB); PG8_STAGE(PG8_SA(0, 0), cA, voffA); PG8_STAGE(PG8_SB(0, 1), cB + hstep, voffB); PG8_STAGE(PG8_SA(0, 1), cA + hstepA, voffA);
        if (wr == 1) PG8_BAR;
        PG8_WAIT_V(4); PG8_BAR;
        PG8_STAGE(PG8_SB(1, 0), cB + kstep, voffB); PG8_STAGE(PG8_SA(1, 0), cA + kstep, voffA); PG8_STAGE(PG8_SB(1, 1), cB + hstep + kstep, voffB);
        PG8_WAIT_V(6); PG8_BAR;
    }
    for (;;) {
        const bool has_next = S.next(ui + 1, nxt);
        const char* nA = has_next ? (const char*)g.A + (size_t)nxt.pm * tstepA + (size_t)nxt.pn * akoff : cA; const char* nB = has_next ? (const char*)g.Bt + (size_t)nxt.pn * tstep : cB;
        for (int t = 0; t < nt; t += 2) {
            const bool last = (t == nt - 2);
            const char* a1 = cA + (size_t)(t + 1) * kstep;
            const char* a2 = last ? nA : cA + (size_t)(t + 2) * kstep; const char* b2 = last ? nB : cB + (size_t)(t + 2) * kstep;
            const char* a3 = a2 + kstep; const char* b3 = b2 + kstep;
            if (last && has_next) S.a_ready(nxt);
            if constexpr (SP2) {
            PG8_LDB(B0, 0, 0); PG8_LDB(B1, 0, 1); PG8_SCHED; PG8_LDA(At, 0, 0); PG8_STAGE(PG8_SA(1, 1), a1 + hstepA, voffA);
            PG8_WAIT_V(8); PG8_WAIT_L(0); PG8_BAR; PG8_MMA(0, 0, At, B0); PG8_MMA(0, 1, At, B1); PG8_BAR; PG8_SCHED;
            PG8_LDA(At, 0, 1); PG8_STAGE(PG8_SB(0, 0), b2, voffB); PG8_STAGE(PG8_SB(0, 1), b2 + hstep, voffB); PG8_STAGE(PG8_SA(0, 0), a2, voffA);
            PG8_WAIT_V(8); PG8_WAIT_L(0); PG8_BAR; PG8_MMA(1, 0, At, B0); PG8_MMA(1, 1, At, B1); PG8_BAR; PG8_SCHED;
            PG8_LDB(B0, 1, 0); PG8_LDB(B1, 1, 1); PG8_SCHED; PG8_LDA(At, 1, 0); PG8_STAGE(PG8_SA(0, 1), a2 + hstepA, voffA);
            PG8_WAIT_V(8); PG8_WAIT_L(0); PG8_BAR; PG8_MMA(0, 0, At, B0); PG8_MMA(0, 1, At, B1); PG8_BAR; PG8_SCHED;
            PG8_LDA(At, 1, 1); PG8_STAGE(PG8_SB(1, 0), b3, voffB); PG8_STAGE(PG8_SB(1, 1), b3 + hstep, voffB); PG8_STAGE(PG8_SA(1, 0), a3, voffA);
            PG8_WAIT_V(8); PG8_WAIT_L(0); PG8_BAR; PG8_MMA(1, 0, At, B0); PG8_MMA(1, 1, At, B1); PG8_BAR; PG8_SCHED;
            } else {
            PG8_LDB(B0, 0, 0); PG8_SCHED; PG8_LDA(At, 0, 0); PG8_STAGE(PG8_SA(1, 1), a1 + hstepA, voffA);
            PG8_WAIT_L(8); PG8_BAR; PG8_WAIT_L(0); PG8_MMA(0, 0, At, B0); PG8_BAR; PG8_SCHED;
            PG8_LDB(B1, 0, 1); PG8_STAGE(PG8_SB(0, 0), b2, voffB);
            PG8_BAR; PG8_WAIT_L(0); PG8_MMA(0, 1, At, B1); PG8_BAR;
            PG8_LDA(At, 0, 1); PG8_STAGE(PG8_SA(0, 0), a2, voffA);
            PG8_BAR; PG8_WAIT_L(0); PG8_MMA(1, 0, At, B0); PG8_BAR; PG8_SCHED;
            PG8_STAGE(PG8_SB(0, 1), b2 + hstep, voffB);
            PG8_WAIT_V(6); PG8_BAR; PG8_MMA(1, 1, At, B1); PG8_BAR;
            PG8_LDB(B0, 1, 0); PG8_SCHED; PG8_LDA(At, 1, 0); PG8_STAGE(PG8_SA(0, 1), a2 + hstepA, voffA);
            PG8_WAIT_L(8); PG8_BAR; PG8_WAIT_L(0); PG8_MMA(0, 0, At, B0); PG8_BAR; PG8_SCHED;
            PG8_LDB(B1, 1, 1); PG8_STAGE(PG8_SB(1, 0), b3, voffB);
            PG8_BAR; PG8_WAIT_L(0); PG8_MMA(0, 1, At, B1); PG8_BAR;
            PG8_LDA(At, 1, 1); PG8_STAGE(PG8_SA(1, 0), a3, voffA);
            PG8_BAR; PG8_WAIT_L(0); PG8_MMA(1, 0, At, B0); PG8_BAR; PG8_SCHED;
            PG8_STAGE(PG8_SB(1, 1), b3 + hstep, voffB);
            PG8_WAIT_V(6); PG8_BAR; PG8_MMA(1, 1, At, B1); PG8_BAR;
            }
        }
        if constexpr (ALIGN_EPI) { if (wr == 0) PG8_BAR; }
        if constexpr (!Epi::AFTER_DRAIN) { E(acc, cur, wr, wc, fr, fq); S.done(cur); }
        if (!has_next) break;
#pragma unroll
        for (int a = 0; a < 2; ++a)
#pragma unroll
            for (int b = 0; b < 2; ++b)
#pragma unroll
                for (int m = 0; m < 4; ++m)
#pragma unroll
                    for (int n = 0; n < 2; ++n) acc[a][b][m][n] = (f32x4){0.f, 0.f, 0.f, 0.f};
        cur = nxt; cA = nA; cB = nB; ++ui;
        if constexpr (ALIGN_EPI) { if (wr == 1) PG8_BAR; }
    }
    PG8_WAIT_V(0);
    if constexpr (!ALIGN_EPI) { if (wr == 0) PG8_BAR; }
    PG8_BAR;
    if constexpr (Epi::AFTER_DRAIN) { E.fused(acc, cur, wr, wc, fr, fq, lds, wid, lane); S.done(cur); }
#undef PG8_SA
#undef PG8_SB
#undef PG8_STAGE
#undef PG8_LDA
#undef PG8_LDB
#undef PG8_MMA
#undef PG8_WAIT_V
#undef PG8_WAIT_L
#undef PG8_BAR
#undef PG8_SCHED
}
}

template <class E4> struct EpiAdapt { static constexpr bool PERM = true, AFTER_DRAIN = false; E4 e;
    DEV void rowgrp(int row, int col, const pg8::f32x4& a00, const pg8::f32x4& a01, const pg8::f32x4& a10, const pg8::f32x4& a11) const {
        store_pair<4>(row, col, e.make8(row, col, a00, a01), e.make8(row, col + 32, a10, a11), [&](int r_, int c_) { return e.dst(r_, c_); }); }
    DEV void operator()(const pg8::f32x4 (&acc)[2][2][4][2], const pg8::Unit& u, int wr, int wc, int fr, int fq) const {
        if constexpr (E4::HAS_TILE) { e.tile(acc, u.pm, u.pn, wr, wc, fr, fq); }
        else {
        const int row0 = u.pm * 256 + wr * 64 + fr, col0 = u.pn * 256 + wc * 64 + 8 * fq;
#define EA_RG(ai, m) rowgrp(row0 + (ai) * 128 + (m) * 16, col0, acc[ai][0][m][0], acc[ai][0][m][1], acc[ai][1][m][0], acc[ai][1][m][1])
        EA_RG(0, 0); EA_RG(0, 1); EA_RG(0, 2); EA_RG(0, 3); EA_RG(1, 0); EA_RG(1, 1); EA_RG(1, 2); EA_RG(1, 3);
#undef EA_RG
        }
    }
};
template <class E4, bool I8 = false> DEV void gemm8(const half_t* A, const half_t* Bt, int M, int N, int K, const E4& e, LAS char* lds, int wv, int lda = 0, int a_koff = 0) {
    TID_DECL
    const pg8::Gemm g{(const pg8::bf16_t*)A, (const pg8::bf16_t*)Bt, M, N, K, lda ? lda : K, a_koff};
    pg8::StaticOrder S; S.init(M, N, nblk, bidx);
    const EpiAdapt<E4> E{e};
    pg8::gemm_phase<EpiAdapt<E4>, pg8::StaticOrder, true, true, I8>((LAS unsigned char*)lds, g, S, E, tidx);
}

DEV void ph_post(const Params& p, int l, int wv) {
    TID_DECL
    char* ws = p.ws; const int lane = tidx & 63, wid = tidx >> 6;
    const float* CKV = (const float*)(ws + OFF_CKV); const float* SM = (const float*)(ws + OFF_SM);
    half_t* C = (half_t*)(ws + OFF_C); half_t* IK = (half_t*)(ws + OFF_IK); float* IW = (float*)(ws + OFF_IW); float* MG = (float*)(ws + OFF_MG);
    const half_t* MQKR = (const half_t*)(ws + OFF_MQKR); half_t* MQKC = (half_t*)(ws + OFF_MQKC);
    const float* kvg = p.kv_norm_g + l * 256; const float* ikg = p.ik_norm_g + l * 64; const float* gb = p.ml_gate_b + l * 8;
    const float* cw = p.ml_conv_w + (size_t)l * 4 * 1024; const float* cb = p.ml_conv_b + l * 1024;
    for (int t = bidx * NWAVE + wid; t < TB; t += nblk * NWAVE) {
        { const f4 v = *(const f4*)(CKV + (size_t)t * 256 + lane * 4); float ss = wave_sum(lane, v[0] * v[0] + v[1] * v[1] + v[2] * v[2] + v[3] * v[3]);
          const float rs = rsqrtf(ss * (1.f / 256.f) + NORM_EPS); const f4 gg = *(const f4*)(kvg + lane * 4); *(h4*)(C + (size_t)t * 256 + lane * 4) = toh4(v * rs * gg); }
        { f4 v = (f4){0.f, 0.f, 0.f, 0.f}; if (lane < 24) v = *(const f4*)(SM + (size_t)t * 96 + lane * 4);
          float ss = (lane < 16) ? (v[0] * v[0] + v[1] * v[1] + v[2] * v[2] + v[3] * v[3]) : 0.f; ss = wave_sum(lane, ss);
          const float rs = rsqrtf(ss * (1.f / 64.f) + NORM_EPS);
          if (lane < 16) { const f4 gg = *(const f4*)(ikg + lane * 4);
              *(h4*)(IK + ((((size_t)(t >> 5) * 4 + (lane >> 2)) * 2 + ((lane >> 1) & 1)) * 32 + (t & 31)) * 8 + (lane & 1) * 4) = toh4(v * rs * gg); }
          else if (lane < 20) { *(f4*)(IW + (size_t)t * 16 + (lane - 16) * 4) = v * (1.f / 32.f); }
          else if (lane == 20) { const f4 bb = *(const f4*)(gb); *(f4*)(MG + (size_t)t * 8) = v + bb; }
          else if (lane == 21) { const f4 bb = *(const f4*)(gb + 4); f4 o;
#pragma unroll
              for (int e = 0; e < 4; ++e) { const float xg = v[e] + bb[e]; o[e] = fminf(xg, 0.f) - log1pf(__expf(-fabsf(xg))); }
              *(f4*)(MG + (size_t)t * 8 + 4) = o; }
        }
        { const int c0 = lane * 16; float acc[16];
#pragma unroll
          for (int e = 0; e < 16; ++e) acc[e] = cb[c0 + e];
#pragma unroll
          for (int j = 0; j < 4; ++j) { const int tt = t - 3 + j; if (tt >= 0) {
              const h8 x0 = *(const h8*)(MQKR + (size_t)tt * 1024 + c0), x1 = *(const h8*)(MQKR + (size_t)tt * 1024 + c0 + 8);
#pragma unroll
              for (int e = 0; e < 8; ++e) { acc[e] += cw[j * 1024 + c0 + e] * (float)x0[e]; acc[8 + e] += cw[j * 1024 + c0 + 8 + e] * (float)x1[e]; } } }
          const float sc = (c0 >= 512) ? 0.08838834764831845f : 1.f; h8 o0, o1;
#pragma unroll
          for (int e = 0; e < 8; ++e) { o0[e] = (half_t)(silu_f(acc[e]) * sc); o1[e] = (half_t)(silu_f(acc[8 + e]) * sc); }
          *(h8*)(MQKC + (size_t)t * 1024 + c0) = o0; *(h8*)(MQKC + (size_t)t * 1024 + c0 + 8) = o1;
        }
    }
}

namespace attn_body {
using bf16=_Float16;
using bf16x8=__attribute__((ext_vector_type(8)))short;
using s16x4=__attribute__((ext_vector_type(4)))short;
using f32x16=__attribute__((ext_vector_type(16)))float;
using u32x4=__attribute__((ext_vector_type(4)))unsigned;
using h8v=__attribute__((ext_vector_type(8)))_Float16;
#define MFMA_H(a,b,c,x,y,z) __builtin_amdgcn_mfma_f32_32x32x16_f16(__builtin_bit_cast(h8v,(a)),__builtin_bit_cast(h8v,(b)),(c),x,y,z)
constexpr int BATCH=1,NHEAD=16,SEQ=16384,D=64,DM=NHEAD*D;
constexpr int NW=8,QBLK=32,QB=QBLK*NW,KVBLK=64,NQB=SEQ/QB;
constexpr int ATTN_PITCH=DM, ATTN_UNIT_ROWS=QB;
__device__ __forceinline__ int crow(int r,int hi){return (r&3)+8*(r>>2)+4*hi;}
#define SBAR() __builtin_amdgcn_sched_barrier(0)
__device__ __forceinline__ void cmask(f32x16&p0,f32x16&p1,int jb,int qrel_in,int hi){
  const float NEG=-INFINITY; int kb=64*jb+4*hi, qrel=qrel_in; asm volatile("":"+v"(kb),"+v"(qrel));
  #pragma unroll
  for(int r=0;r<16;++r){int kv=kb+(r&3)+8*(r>>2); if(kv>qrel)p0[r]=NEG; if(kv+32>qrel)p1[r]=NEG;}
}

constexpr int NSLOT=3, SLOTB=8192;
constexpr int LDS_K=0, LDS_V=NSLOT*SLOTB, LDS_WS=2*NSLOT*SLOTB, LDS_OST=LDS_WS+NW*64*4, LDS_BYTES=LDS_OST+NW*4096;
constexpr float C2=0.125f*1.4426950408889634f;
__device__ __forceinline__ void glds16(const void*gsrc,unsigned lds_dst){unsigned keep;
  asm volatile("s_mov_b32 %0, m0\n\ts_mov_b32 m0, %2\n\ts_nop 0\n\tglobal_load_lds_dwordx4 %1, off\n\ts_mov_b32 m0, %0":"=&s"(keep):"v"(gsrc),"s"(lds_dst):"memory");}
__device__ __forceinline__ float max3f(float a,float b,float c){float r;asm("v_max3_f32 %0, %1, %2, %3":"=v"(r):"v"(a),"v"(b),"v"(c));return r;}
__device__ __forceinline__ float max2f(float a,float b){float r;asm("v_max_f32_e32 %0, %1, %2":"=v"(r):"v"(a),"v"(b));return r;}
__device__ __forceinline__ float fadd_s(float a,float b){float r;asm("v_add_f32_e32 %0, %1, %2":"=v"(r):"v"(a),"v"(b));return r;}
__device__ __forceinline__ float fsub_s(float a,float b){float r;asm("v_sub_f32_e32 %0, %1, %2":"=v"(r):"v"(a),"v"(b));return r;}
typedef float f32x2_t __attribute__((ext_vector_type(2))); typedef _Float16 bf16x2_t __attribute__((ext_vector_type(2)));
__device__ __forceinline__ unsigned cvtpk_s(float lo,float hi){f32x2_t v={lo,hi};bf16x2_t b=__builtin_convertvector(v,bf16x2_t);return __builtin_bit_cast(unsigned,b);}
#define WAIT_BAR(N) asm volatile("s_waitcnt vmcnt(" #N ") lgkmcnt(0)\n\ts_barrier":::"memory")

__device__ __forceinline__ void qkt(f32x16&p0,f32x16&p1,const char*Kslot,const bf16x8*qr,const f32x16&negm,int r32,int hi){
  const char*kb=Kslot+hi*1024+r32*16;
  #pragma unroll
  for(int d0=0;d0<4;++d0){
    const bf16x8 b0=*reinterpret_cast<const bf16x8*>(kb+d0*2048);
    const bf16x8 b1=*reinterpret_cast<const bf16x8*>(kb+d0*2048+512);
    if(d0==0){p0=MFMA_H(b0,qr[0],negm,0,0,0);p1=MFMA_H(b1,qr[0],negm,0,0,0);}
    else{p0=MFMA_H(b0,qr[d0],p0,0,0,0);p1=MFMA_H(b1,qr[d0],p1,0,0,0);}}
}
typedef __attribute__((address_space(3))) const char* lds_cptr;
typedef short v4i16_t __attribute__((ext_vector_type(4)));
__device__ __forceinline__ void kload8(bf16x8*kf,lds_cptr kp){
  kf[0]=*(const __attribute__((address_space(3))) bf16x8*)(kp);      kf[1]=*(const __attribute__((address_space(3))) bf16x8*)(kp+512);
  kf[2]=*(const __attribute__((address_space(3))) bf16x8*)(kp+2048); kf[3]=*(const __attribute__((address_space(3))) bf16x8*)(kp+2560);
  kf[4]=*(const __attribute__((address_space(3))) bf16x8*)(kp+4096); kf[5]=*(const __attribute__((address_space(3))) bf16x8*)(kp+4608);
  kf[6]=*(const __attribute__((address_space(3))) bf16x8*)(kp+6144); kf[7]=*(const __attribute__((address_space(3))) bf16x8*)(kp+6656);
}
__device__ __forceinline__ void kload2(bf16x8*kf,lds_cptr kp,int j){ kf[2*j]=*(const __attribute__((address_space(3))) bf16x8*)(kp+j*2048); kf[2*j+1]=*(const __attribute__((address_space(3))) bf16x8*)(kp+j*2048+512); }
__device__ __forceinline__ s16x4 vtr(lds_cptr p){ return __builtin_bit_cast(s16x4,__builtin_amdgcn_ds_read_tr16_b64_v4i16((__attribute__((address_space(3))) v4i16_t*)p)); }
__device__ __forceinline__ float rowmax(const f32x16&p0,const f32x16&p1){
  float a=max3f(p0[0],p0[1],p1[0]),b=max3f(p0[2],p0[3],p1[1]);a=max3f(a,p1[2],p1[3]);
  #pragma unroll
  for(int r=4;r<16;r+=4){a=max3f(a,p0[r],p0[r+1]);b=max3f(b,p0[r+2],p0[r+3]);a=max3f(a,p1[r],p1[r+1]);b=max3f(b,p1[r+2],p1[r+3]);}
  const float m=max2f(a,b);
  auto rr=__builtin_amdgcn_permlane32_swap(__float_as_uint(m),__float_as_uint(m),false,false);
  return max2f(__uint_as_float(rr[0]),__uint_as_float(rr[1]));
}
__device__ __forceinline__ void pv(f32x16*o,int vb,bf16x8 pa0,bf16x8 pa1,bf16x8 pa2,bf16x8 pa3){
  #pragma unroll
  for(int d0=0;d0<2;++d0){s16x4 lo[4],hi[4];
    #pragma unroll
    for(int ks=0;ks<4;++ks){
      asm volatile("ds_read_b64_tr_b16 %0,%1 offset:%c2":"=&v"(lo[ks]):"v"(vb),"i"(d0*4096+ks*1024):"memory");
      asm volatile("ds_read_b64_tr_b16 %0,%1 offset:%c2":"=&v"(hi[ks]):"v"(vb),"i"(d0*4096+ks*1024+512):"memory");}
    asm volatile("s_waitcnt lgkmcnt(0)":::"memory");SBAR();
    #define PK(k) (bf16x8){lo[k][0],lo[k][1],lo[k][2],lo[k][3],hi[k][0],hi[k][1],hi[k][2],hi[k][3]}
    o[d0]=MFMA_H(pa0,PK(0),o[d0],0,0,0);
    o[d0]=MFMA_H(pa1,PK(1),o[d0],0,0,0);
    o[d0]=MFMA_H(pa2,PK(2),o[d0],0,0,0);
    o[d0]=MFMA_H(pa3,PK(3),o[d0],0,0,0);
    #undef PK
  }
}

#ifndef ATTN_STORE16
#define ATTN_STORE16(p,v) (*(u32x4*)(p)=(v))
#endif
template<int THRL> __device__ __forceinline__ void attn_unit(int b,int h,int qb,const bf16*Q,const bf16*__restrict__ K,const bf16*__restrict__ V,bf16*O,char*shm,const int wv_in,const int vhalf){
  int tid=(wv_in<<6)|lane_id_v();
  const int lane=tid&63,r32=lane&31,hi=lane>>5; const int wid=__builtin_amdgcn_readfirstlane(tid>>6);
  const long rowbase=(long)b*SEQ; const int q0=qb*QB;
  const bf16*Qw=Q+(rowbase+q0+wid*QBLK)*DM+h*D;
  const bf16*Kh=K+rowbase*DM+h*D,*Vh=V+rowbase*DM+(h>>1)*128+vhalf*64;
  const unsigned lds0=(unsigned)(uintptr_t)shm;
  float*wsf=(float*)(shm+LDS_WS)+wid*64;
  const bf16*ksrc=Kh+(long)lane*DM+wid*8;
  const bf16*vsrc=Vh+(long)(16*(wid&3)+(lane>>2))*DM+(wid>>2)*32+(lane&3)*8;
  const unsigned kdst=lds0+LDS_K+wid*1024, vdst=lds0+LDS_V+wid*1024;
  #define DMA_K(t,slot) glds16(ksrc+(long)(t)*KVBLK*DM,(unsigned)__builtin_amdgcn_readfirstlane(kdst+(slot)))
  #define DMA_V(t,slot) glds16(vsrc+(long)(t)*KVBLK*DM,(unsigned)__builtin_amdgcn_readfirstlane(vdst+(slot)))
  const int vb0=(int)(lds0+LDS_V)+((lane>>4)&1)*32+(lane&3)*8+(4*hi+((lane&15)>>2))*64;
  const char*Kbase=shm+LDS_K; bf16x8 kf[8];
  const lds_cptr shm3=(lds_cptr)shm; const lds_cptr kp0=shm3+LDS_K+hi*1024+r32*16; const lds_cptr vp0=shm3+LDS_V+((lane>>4)&1)*32+(lane&3)*8+(4*hi+((lane&15)>>2))*64;
  const int NT=(q0+QB)/KVBLK;
  DMA_K(0,0);DMA_V(0,0);DMA_K(1,SLOTB);
  bf16x8 qr[4];
  #pragma unroll
  for(int d0=0;d0<4;++d0)qr[d0]=*reinterpret_cast<const bf16x8*>(&Qw[(long)r32*DM+d0*16+hi*8]);
  float mhat=0.f,l_reg=0.f;f32x16 o[2];o[0]=f32x16{};o[1]=f32x16{};f32x16 negm=f32x16{};asm volatile("":"+v"(negm));
  const int qrel=wid*QBLK+r32;
  #define CMASK(P0,P1,t) do{int jb_=(t)-(NT-4); if(jb_>=0)cmask(P0,P1,jb_,qrel,hi);}while(0)
  bool resc=false;
  #define START(P0,P1) do{ const float rm=rowmax(P0,P1); resc=false; \
    { const float dl=rm; mhat=fadd_s(mhat,dl); \
      _Pragma("unroll") for(int r=0;r<16;++r){P0[r]=fsub_s(P0[r],dl);P1[r]=fsub_s(P1[r],dl);} \
      _Pragma("unroll") for(int r=0;r<16;++r)negm[r]=-mhat; asm volatile("":"+v"(negm)); } \
    _Pragma("unroll") for(int r=0;r<16;++r)P0[r]=__builtin_amdgcn_exp2f(P0[r]); }while(0)
  #define RESC() do{ if(resc){ asm volatile("s_waitcnt lgkmcnt(0)":::"memory"); \
      _Pragma("unroll") for(int d_=0;d_<2;++d_) _Pragma("unroll") for(int r=0;r<16;++r)o[d_][r]*=wsf[crow(r,hi)]; } }while(0)
  f32x16 pA0,pA1,pB0,pB1;
  int sl_prev=0,sl_cur=0,sl_next=SLOTB;
  #define ROT() do{sl_prev=sl_cur;sl_cur=sl_next;sl_next=(sl_next==(NSLOT-1)*SLOTB)?0:sl_next+SLOTB;}while(0)
  DMA_K(2,2*SLOTB);
  WAIT_BAR(3);
  qkt(pA0,pA1,Kbase,qr,negm,r32,hi);asm volatile("s_nop 15\n\ts_nop 7":"+v"(pA0),"+v"(pA1));CMASK(pA0,pA1,0);
  START(pA0,pA1);
  _Pragma("unroll") for(int r=0;r<16;++r)pA1[r]=__builtin_amdgcn_exp2f(pA1[r]);
  WAIT_BAR(0);
  DMA_K(3,0);DMA_V(1,SLOTB);
  ROT();
  kload8(kf,kp0+sl_cur);
  WAIT_BAR(2);
  s16x4 vlo[8],vhi[8]; u32x4 pw0,pw1,pw2,pw3;
  #define PKW(P,B) cvtpk_s(P[B],P[B+1])
  #define PAF(k) __builtin_bit_cast(bf16x8,pw##k)
  #define VFR(i) (bf16x8){vlo[i][0],vlo[i][1],vlo[i][2],vlo[i][3],vhi[i][0],vhi[i][1],vhi[i][2],vhi[i][3]}
  #define PIN(x) asm volatile("":"+v"(x))
  #define MX3(a,b,c) __builtin_fmaxf(__builtin_fmaxf((a),(b)),(c))
  #define GAPA(MF,A0,A1,A2,A3,W0,W1,PW) do{ MF; sacc+=A0; sacc+=A1; sacc+=A2; sacc+=A3; PIN(sacc); W0; W1; PIN(PW); SBAR(); }while(0)
  #define EX(v) __builtin_amdgcn_exp2f(v)
  #define GAPB(MF,X,B) do{ MF; X[B]=EX(X[B]); X[B+1]=EX(X[B+1]); X[B+2]=EX(X[B+2]); X[B+3]=EX(X[B+3]); PIN(X); SBAR(); }while(0)
  #define VRD(i) do{ vlo[i]=vtr(vp_+(((i)>>2)*4096+((i)&3)*1024)); vhi[i]=vtr(vp_+(((i)>>2)*4096+((i)&3)*1024+512)); }while(0)
  #define KRD(G,j) do{ if(G){ kload2(kf,kp0+sl_next,j); SBAR(); } }while(0)
  #define STEP(C0,C1,P0,P1,t,GK,GV,GL) do{ SBAR(); \
    const lds_cptr vp_=vp0+sl_prev; \
    VRD(0); SBAR(); float sacc=(P0[0]+P0[1]); \
    GAPA(C0=MFMA_H(kf[0],qr[0],negm,0,0,0), P0[2],P0[3],P0[4],P0[5],     pw0[0]=PKW(P0,0), pw0[1]=PKW(P0,2), pw0); \
    VRD(4); SBAR(); GAPA(C1=MFMA_H(kf[1],qr[0],negm,0,0,0), P0[6],P0[7],P0[8],P0[9],     pw0[2]=PKW(P0,4), pw0[3]=PKW(P0,6), pw0); \
    VRD(1); SBAR(); GAPA(C0=MFMA_H(kf[2],qr[1],C0,0,0,0),   P0[10],P0[11],P0[12],P0[13], pw1[0]=PKW(P0,8), pw1[1]=PKW(P0,10), pw1); \
    VRD(5); SBAR(); GAPA(C1=MFMA_H(kf[3],qr[1],C1,0,0,0),   P0[14],P0[15],P1[0],P1[1],   pw1[2]=PKW(P0,12),pw1[3]=PKW(P0,14), pw1); \
    VRD(2); SBAR(); GAPA(C0=MFMA_H(kf[4],qr[2],C0,0,0,0),   P1[2],P1[3],P1[4],P1[5],     pw2[0]=PKW(P1,0), pw2[1]=PKW(P1,2), pw2); \
    VRD(6); SBAR(); GAPA(C1=MFMA_H(kf[5],qr[2],C1,0,0,0),   P1[6],P1[7],P1[8],P1[9],     pw2[2]=PKW(P1,4), pw2[3]=PKW(P1,6), pw2); \
    VRD(3); SBAR(); GAPA(C0=MFMA_H(kf[6],qr[3],C0,0,0,0),   P1[10],P1[11],P1[12],P1[13], pw3[0]=PKW(P1,8), pw3[1]=PKW(P1,10), pw3); \
    VRD(7); SBAR(); GAPA(C1=MFMA_H(kf[7],qr[3],C1,0,0,0),   P1[14],P1[15],0.f,0.f,       pw3[2]=PKW(P1,12),pw3[3]=PKW(P1,14), pw3); \
    l_reg+=sacc; \
    if(GK){DMA_K((t)+3,sl_cur);} if(GV){DMA_V((t)+1,sl_next);} \
    CMASK(C0,C1,t); \
    { float a=MX3(C0[0],C0[1],C1[0]),b=MX3(C0[2],C0[3],C1[1]); a=MX3(a,C1[2],C1[3]); \
      _Pragma("unroll") for(int r=4;r<16;r+=4){a=MX3(a,C0[r],C0[r+1]);b=MX3(b,C0[r+2],C0[r+3]);a=MX3(a,C1[r],C1[r+1]);b=MX3(b,C1[r+2],C1[r+3]);} \
      float rm=__builtin_fmaxf(a,b); { auto rr=__builtin_amdgcn_permlane32_swap(__float_as_uint(rm),__float_as_uint(rm),false,false); rm=__builtin_fmaxf(__uint_as_float(rr[0]),__uint_as_float(rr[1])); } \
      resc=false; \
      if(__builtin_expect(__any(rm>(float)THRL),0)){ const float dl=__builtin_fmaxf(rm,0.f); mhat+=dl; \
        _Pragma("unroll") for(int r=0;r<16;++r){C0[r]-=dl;C1[r]-=dl;} \
        _Pragma("unroll") for(int r=0;r<16;++r)negm[r]=-mhat; asm volatile("":"+v"(negm)); \
        const float f=__builtin_amdgcn_exp2f(-dl); l_reg*=f; { const int le_=lane_id_v(); if(le_<32)wsf[le_]=f; } resc=true; } } \
    SBAR(); \
    GAPB(o[0]=MFMA_H(PAF(0),VFR(0),o[0],0,0,0), C0,0); \
    GAPB(o[1]=MFMA_H(PAF(0),VFR(4),o[1],0,0,0), C0,4); \
    KRD(GL,0); GAPB(o[0]=MFMA_H(PAF(1),VFR(1),o[0],0,0,0), C0,8); \
    KRD(GL,1); GAPB(o[1]=MFMA_H(PAF(1),VFR(5),o[1],0,0,0), C0,12); \
    KRD(GL,2); GAPB(o[0]=MFMA_H(PAF(2),VFR(2),o[0],0,0,0), C1,0); \
    KRD(GL,3); GAPB(o[1]=MFMA_H(PAF(2),VFR(6),o[1],0,0,0), C1,4); \
    GAPB(o[0]=MFMA_H(PAF(3),VFR(3),o[0],0,0,0), C1,8); \
    GAPB(o[1]=MFMA_H(PAF(3),VFR(7),o[1],0,0,0), C1,12); \
    }while(0)
  int t=1;
  #undef CMASK
  #define CMASK(P0,P1,t) do{}while(0)
  for(;t+5<NT;t+=2){
    STEP(pB0,pB1,pA0,pA1,t,true,true,true);     WAIT_BAR(2); RESC(); ROT();
    STEP(pA0,pA1,pB0,pB1,t+1,true,true,true);   WAIT_BAR(2); RESC(); ROT();
  }
  #undef CMASK
  #define CMASK(P0,P1,t) do{int jb_=(t)-(NT-4); if(jb_>=0)cmask(P0,P1,jb_,qrel,hi);}while(0)
  #define ENDW(tt) do{ if((tt)+3<NT){WAIT_BAR(2);} else if((tt)+2<NT){WAIT_BAR(1);} else {WAIT_BAR(0);} }while(0)
  for(;t+1<NT;t+=2){
    STEP(pB0,pB1,pA0,pA1,t,(t+3<NT),(t+1<NT),(t+1<NT));       ENDW(t);   RESC(); ROT();
    STEP(pA0,pA1,pB0,pB1,t+1,(t+4<NT),(t+2<NT),(t+2<NT));     ENDW(t+1); RESC(); ROT();
  }
  STEP(pB0,pB1,pA0,pA1,NT-1,false,false,false); RESC();
  { float sacc=pB0[0]+pB0[1]; _Pragma("unroll") for(int r=2;r<16;++r)sacc+=pB0[r]; _Pragma("unroll") for(int r=0;r<16;++r)sacc+=pB1[r]; l_reg+=sacc;
    pw0=(u32x4){PKW(pB0,0),PKW(pB0,2),PKW(pB0,4),PKW(pB0,6)};pw1=(u32x4){PKW(pB0,8),PKW(pB0,10),PKW(pB0,12),PKW(pB0,14)};pw2=(u32x4){PKW(pB1,0),PKW(pB1,2),PKW(pB1,4),PKW(pB1,6)};pw3=(u32x4){PKW(pB1,8),PKW(pB1,10),PKW(pB1,12),PKW(pB1,14)};
    SBAR(); pv(o,vb0+sl_cur,PAF(0),PAF(1),PAF(2),PAF(3)); }
  #undef PKW
  #undef PAF
  #undef VFR
  #undef PIN
  #undef MX3
  #undef GAPA
  #undef GAPB
  #undef EX
  #undef VRD
  #undef KRD
  #undef STEP
  #undef ENDW
  {auto rr=__builtin_amdgcn_permlane32_swap(__float_as_uint(l_reg),__float_as_uint(l_reg),false,false);l_reg=__uint_as_float(rr[0])+__uint_as_float(rr[1]);}
  if(hi==0)wsf[32+r32]=l_reg;asm volatile("s_waitcnt lgkmcnt(0)":::"memory");
  int tide=(wv_in<<6)|lane_id_v();
  const int lane_e=tide&63,r32_e=lane_e&31,hi_e=lane_e>>5;
  float rli[16];
  #pragma unroll
  for(int r=0;r<16;++r)rli[r]=__builtin_amdgcn_rcpf(wsf[32+crow(r,hi_e)]);
  bf16*Ow=O+(rowbase+q0+wid*QBLK)*DM+h*D;
  { bf16*stg=(bf16*)(shm+LDS_OST)+wid*2048;
    #pragma unroll
    for(int r=0;r<16;++r){const int orow=crow(r,hi_e);
      #pragma unroll
      for(int d0=0;d0<2;++d0)stg[orow*64+d0*32+r32_e]=(bf16)(o[d0][r]*rli[r]);}
    asm volatile("s_waitcnt lgkmcnt(0)":::"memory");
    #pragma unroll
    for(int i=0;i<4;++i){const int row=i*8+(lane_e>>3),ch=lane_e&7; const u32x4 v=*(const u32x4*)(stg+row*64+ch*8); ATTN_STORE16(Ow+(long)row*DM+ch*8,v);} }
  asm volatile("s_waitcnt lgkmcnt(0)\n\ts_barrier":::"memory");
  #undef DMA_K
  #undef DMA_V
  #undef CMASK
  #undef START
  #undef RESC
  #undef ROT
}
constexpr int ATTN_LDS_BYTES=LDS_BYTES;
struct AttnTensors { const bf16* Q; const bf16* K; const bf16* V; bf16* O; };
struct AttnUnit { int bh; int qb; };
struct StaticOrder {
  int vcu;
  __device__ __forceinline__ explicit StaticOrder(int grid,int block):vcu((block%8)*(grid/8)+block/8){}
  __device__ __forceinline__ bool next(int i,AttnUnit&u)const{ if(i>=4)return false; const int s=vcu&15; u.bh=vcu>>4; u.qb=(i==0)?s:(i==1)?31-s:(i==2)?32+s:63-s; return true; }
  __device__ __forceinline__ void a_ready(const AttnUnit&)const{}
  __device__ __forceinline__ void done(const AttnUnit&)const{}
};
template<class Sched,int THRL=8> __device__ __forceinline__ void attn_phase(char*lds,const AttnTensors&T,const Sched&S,const int wv_in,const int vhalf){
  AttnUnit u;
  for(int i=0;S.next(i,u);++i){ S.a_ready(u); attn_unit<THRL>(u.bh/NHEAD,u.bh%NHEAD,u.qb,T.Q,T.K,T.V,T.O,lds,wv_in,vhalf); S.done(u); }
}
#undef SBAR
#undef WAIT_BAR
}
namespace attn128 {
using namespace attn_body;
#define SBAR() __builtin_amdgcn_sched_barrier(0)
#define WAIT_BAR(N) asm volatile("s_waitcnt vmcnt(" #N ") lgkmcnt(0)\n\ts_barrier":::"memory")
constexpr int VSLOTB=16384, OPITCH=2048;
constexpr int L_K=0, L_V=NSLOT*SLOTB, L_WS=L_V+NSLOT*VSLOTB, L_OST=L_WS+NW*64*4, L_BYTES=L_OST+NW*4096;
typedef __attribute__((address_space(3))) char* lds_ptr;
__device__ __forceinline__ void pv128(f32x16*o,int vb,bf16x8 pa0,bf16x8 pa1,bf16x8 pa2,bf16x8 pa3){
  #pragma unroll
  for(int d0=0;d0<4;++d0){s16x4 lo[4],hi[4];
    #pragma unroll
    for(int ks=0;ks<4;++ks){
      asm volatile("ds_read_b64_tr_b16 %0,%1 offset:%c2":"=&v"(lo[ks]):"v"(vb),"i"(d0*4096+ks*1024):"memory");
      asm volatile("ds_read_b64_tr_b16 %0,%1 offset:%c2":"=&v"(hi[ks]):"v"(vb),"i"(d0*4096+ks*1024+512):"memory");}
    asm volatile("s_waitcnt lgkmcnt(0)":::"memory");SBAR();
    #define PK(k) (bf16x8){lo[k][0],lo[k][1],lo[k][2],lo[k][3],hi[k][0],hi[k][1],hi[k][2],hi[k][3]}
    o[d0]=MFMA_H(pa0,PK(0),o[d0],0,0,0);
    o[d0]=MFMA_H(pa1,PK(1),o[d0],0,0,0);
    o[d0]=MFMA_H(pa2,PK(2),o[d0],0,0,0);
    o[d0]=MFMA_H(pa3,PK(3),o[d0],0,0,0);
    #undef PK
  }
}
template<int THRL> __device__ __forceinline__ void attn_unit(int h,int qb,const bf16*Q,const bf16*__restrict__ K,const bf16*__restrict__ V,bf16*O,char*shm,const int wv_in){
  int tid=(wv_in<<6)|lane_id_v();
  const int lane=tid&63,r32=lane&31,hi=lane>>5; const int wid=__builtin_amdgcn_readfirstlane(tid>>6);
  const int q0=qb*QB;
  const bf16*Qw=Q+(long)(q0+wid*QBLK)*DM+h*D;
  const bf16*Kh=K+h*D,*Vh=V+(h>>1)*128;
  const unsigned lds0=(unsigned)(uintptr_t)shm;
  float*wsf=(float*)(shm+L_WS)+wid*64;
  const bf16*ksrc=Kh+(long)lane*DM+wid*8;
  const bf16*vsrc=Vh+(long)(16*(wid&3)+(lane>>2))*DM+(wid>>2)*32+(lane&3)*8;
  const unsigned kdst=lds0+L_K+wid*1024, vdst=lds0+L_V+wid*1024;
  #define DMA_K(t,slot) glds16(ksrc+(long)(t)*KVBLK*DM,(unsigned)__builtin_amdgcn_readfirstlane(kdst+(slot)))
  #define DMA_V(t,slot) do{ glds16(vsrc+(long)(t)*KVBLK*DM,(unsigned)__builtin_amdgcn_readfirstlane(vdst+2*(slot))); glds16(vsrc+(long)(t)*KVBLK*DM+64,(unsigned)__builtin_amdgcn_readfirstlane(vdst+2*(slot)+8192)); }while(0)
  const int vb0=(int)(lds0+L_V)+((lane>>4)&1)*32+(lane&3)*8+(4*hi+((lane&15)>>2))*64;
  const char*Kbase=shm+L_K; bf16x8 kf[8];
  const lds_cptr shm3=(lds_cptr)shm; const lds_cptr kp0=shm3+L_K+hi*1024+r32*16; const lds_cptr vp0=shm3+L_V+((lane>>4)&1)*32+(lane&3)*8+(4*hi+((lane&15)>>2))*64;
  const lds_cptr qp=shm3+L_OST+wid*4096+lane*16;
  #define QLD(d0) (*(const __attribute__((address_space(3))) bf16x8*)(qp+(d0)*1024))
  const int NT=(q0+QB)/KVBLK;
  DMA_K(0,0);DMA_V(0,0);DMA_K(1,SLOTB);
  float mhat=0.f,l_reg=0.f;f32x16 o[4];o[0]=f32x16{};o[1]=f32x16{};o[2]=f32x16{};o[3]=f32x16{};
  const f32x16 zero16=f32x16{}; f32x16 negm=f32x16{};asm volatile("":"+v"(negm));
  const int qrel=wid*QBLK+r32;
  #define CMASK(P0,P1,t) do{int jb_=(t)-(NT-4); if(jb_>=0)cmask(P0,P1,jb_,qrel,hi);}while(0)
  bool resc=false;
  #define START(P0,P1) do{ const float rm=rowmax(P0,P1); resc=false; \
    { const float dl=rm; mhat=fadd_s(mhat,dl); \
      _Pragma("unroll") for(int r=0;r<16;++r){P0[r]=fsub_s(P0[r],dl);P1[r]=fsub_s(P1[r],dl);} \
      _Pragma("unroll") for(int r=0;r<16;++r)negm[r]=-mhat; asm volatile("":"+v"(negm)); } \
    _Pragma("unroll") for(int r=0;r<16;++r)P0[r]=__builtin_amdgcn_exp2f(P0[r]); }while(0)
  #define RESC() do{ if(resc){ asm volatile("s_waitcnt lgkmcnt(0)":::"memory"); \
      _Pragma("unroll") for(int d_=0;d_<4;++d_) _Pragma("unroll") for(int r=0;r<16;++r)o[d_][r]*=wsf[crow(r,hi)]; } }while(0)
  f32x16 pA0,pA1,pB0,pB1;
  int sl_prev=0,sl_cur=0,sl_next=SLOTB;
  #define ROT() do{sl_prev=sl_cur;sl_cur=sl_next;sl_next=(sl_next==(NSLOT-1)*SLOTB)?0:sl_next+SLOTB;}while(0)
  {
    bf16x8 qr[4];
    #pragma unroll
    for(int d0=0;d0<4;++d0)qr[d0]=*reinterpret_cast<const bf16x8*>(&Qw[(long)r32*DM+d0*16+hi*8]);
    DMA_K(2,2*SLOTB);
    WAIT_BAR(4);
    qkt(pA0,pA1,Kbase,qr,zero16,r32,hi);asm volatile("s_nop 15\n\ts_nop 7":"+v"(pA0),"+v"(pA1));CMASK(pA0,pA1,0);
    #pragma unroll
    for(int d0=0;d0<4;++d0)*(__attribute__((address_space(3))) bf16x8*)((lds_ptr)qp+d0*1024)=qr[d0];
  }
  START(pA0,pA1);
  _Pragma("unroll") for(int r=0;r<16;++r)pA1[r]=__builtin_amdgcn_exp2f(pA1[r]);
  WAIT_BAR(0);
  DMA_K(3,0);DMA_V(1,SLOTB);
  ROT();
  kload8(kf,kp0+sl_cur);
  WAIT_BAR(3);
  s16x4 vlo[8],vhi[8]; u32x4 pw0,pw1,pw2,pw3;
  #define PKW(P,B) cvtpk_s(P[B],P[B+1])
  #define PAF(k) __builtin_bit_cast(bf16x8,pw##k)
  #define VFR(i) (bf16x8){vlo[i][0],vlo[i][1],vlo[i][2],vlo[i][3],vhi[i][0],vhi[i][1],vhi[i][2],vhi[i][3]}
  #define PIN(x) asm volatile("":"+v"(x))
  #define MX3(a,b,c) __builtin_fmaxf(__builtin_fmaxf((a),(b)),(c))
  #define GAPA(MF,A0,A1,A2,A3,W0,W1,PW) do{ MF; sacc+=A0; sacc+=A1; sacc+=A2; sacc+=A3; PIN(sacc); W0; W1; PIN(PW); SBAR(); }while(0)
  #define EX(v) __builtin_amdgcn_exp2f(v)
  #define GAPB(MF,X,B) do{ MF; X[B]=EX(X[B]); X[B+1]=EX(X[B+1]); PIN(X); SBAR(); }while(0)
  #define VRD(i) do{ vlo[i]=vtr(vp_+(((i)>>2)*4096+((i)&3)*1024)); vhi[i]=vtr(vp_+(((i)>>2)*4096+((i)&3)*1024+512)); }while(0)
  #define VRD2(i) do{ vlo[i]=vtr(vp_+((2+((i)>>2))*4096+((i)&3)*1024)); vhi[i]=vtr(vp_+((2+((i)>>2))*4096+((i)&3)*1024+512)); SBAR(); }while(0)
  #define KRD(G,j) do{ if(G){ kload2(kf,kp0+sl_next,j); SBAR(); } }while(0)
  #define STEP(C0,C1,P0,P1,t,GK,GV,GL) do{ SBAR(); \
    const lds_cptr vp_=vp0+2*sl_prev; \
    const bf16x8 q0_=QLD(0),q1_=QLD(1),q2_=QLD(2),q3_=QLD(3); \
    VRD(0); SBAR(); float sacc=(P0[0]+P0[1]); \
    GAPA(C0=MFMA_H(kf[0],q0_,negm,0,0,0), P0[2],P0[3],P0[4],P0[5],     pw0[0]=PKW(P0,0), pw0[1]=PKW(P0,2), pw0); \
    VRD(4); SBAR(); GAPA(C1=MFMA_H(kf[1],q0_,negm,0,0,0), P0[6],P0[7],P0[8],P0[9],     pw0[2]=PKW(P0,4), pw0[3]=PKW(P0,6), pw0); \
    VRD(1); SBAR(); GAPA(C0=MFMA_H(kf[2],q1_,C0,0,0,0),   P0[10],P0[11],P0[12],P0[13], pw1[0]=PKW(P0,8), pw1[1]=PKW(P0,10), pw1); \
    VRD(5); SBAR(); GAPA(C1=MFMA_H(kf[3],q1_,C1,0,0,0),   P0[14],P0[15],P1[0],P1[1],   pw1[2]=PKW(P0,12),pw1[3]=PKW(P0,14), pw1); \
    VRD(2); SBAR(); GAPA(C0=MFMA_H(kf[4],q2_,C0,0,0,0),   P1[2],P1[3],P1[4],P1[5],     pw2[0]=PKW(P1,0), pw2[1]=PKW(P1,2), pw2); \
    VRD(6); SBAR(); GAPA(C1=MFMA_H(kf[5],q2_,C1,0,0,0),   P1[6],P1[7],P1[8],P1[9],     pw2[2]=PKW(P1,4), pw2[3]=PKW(P1,6), pw2); \
    VRD(3); SBAR(); GAPA(C0=MFMA_H(kf[6],q3_,C0,0,0,0),   P1[10],P1[11],P1[12],P1[13], pw3[0]=PKW(P1,8), pw3[1]=PKW(P1,10), pw3); \
    VRD(7); SBAR(); GAPA(C1=MFMA_H(kf[7],q3_,C1,0,0,0),   P1[14],P1[15],0.f,0.f,       pw3[2]=PKW(P1,12),pw3[3]=PKW(P1,14), pw3); \
    l_reg+=sacc; \
    if(GK){DMA_K((t)+3,sl_cur);} if(GV){DMA_V((t)+1,sl_next);} \
    CMASK(C0,C1,t); \
    { float a=MX3(C0[0],C0[1],C1[0]),b=MX3(C0[2],C0[3],C1[1]); a=MX3(a,C1[2],C1[3]); \
      _Pragma("unroll") for(int r=4;r<16;r+=4){a=MX3(a,C0[r],C0[r+1]);b=MX3(b,C0[r+2],C0[r+3]);a=MX3(a,C1[r],C1[r+1]);b=MX3(b,C1[r+2],C1[r+3]);} \
      float rm=__builtin_fmaxf(a,b); { auto rr=__builtin_amdgcn_permlane32_swap(__float_as_uint(rm),__float_as_uint(rm),false,false); rm=__builtin_fmaxf(__uint_as_float(rr[0]),__uint_as_float(rr[1])); } \
      resc=false; \
      if(__builtin_expect(__any(rm>(float)THRL),0)){ const float dl=__builtin_fmaxf(rm,0.f); mhat+=dl; \
        _Pragma("unroll") for(int r=0;r<16;++r){C0[r]-=dl;C1[r]-=dl;} \
        _Pragma("unroll") for(int r=0;r<16;++r)negm[r]=-mhat; asm volatile("":"+v"(negm)); \
        const float f=__builtin_amdgcn_exp2f(-dl); l_reg*=f; { const int le_=lane_id_v(); if(le_<32)wsf[le_]=f; } resc=true; } } \
    SBAR(); \
    GAPB(o[0]=MFMA_H(PAF(0),VFR(0),o[0],0,0,0), C0,0);  VRD2(0); \
    GAPB(o[1]=MFMA_H(PAF(0),VFR(4),o[1],0,0,0), C0,2);  VRD2(4); \
    KRD(GL,0); GAPB(o[0]=MFMA_H(PAF(1),VFR(1),o[0],0,0,0), C0,4);  VRD2(1); \
    KRD(GL,1); GAPB(o[1]=MFMA_H(PAF(1),VFR(5),o[1],0,0,0), C0,6);  VRD2(5); \
    KRD(GL,2); GAPB(o[0]=MFMA_H(PAF(2),VFR(2),o[0],0,0,0), C0,8);  VRD2(2); \
    KRD(GL,3); GAPB(o[1]=MFMA_H(PAF(2),VFR(6),o[1],0,0,0), C0,10); VRD2(6); \
    GAPB(o[0]=MFMA_H(PAF(3),VFR(3),o[0],0,0,0), C0,12); VRD2(3); \
    GAPB(o[1]=MFMA_H(PAF(3),VFR(7),o[1],0,0,0), C0,14); VRD2(7); \
    GAPB(o[2]=MFMA_H(PAF(0),VFR(0),o[2],0,0,0), C1,0); \
    GAPB(o[3]=MFMA_H(PAF(0),VFR(4),o[3],0,0,0), C1,2); \
    GAPB(o[2]=MFMA_H(PAF(1),VFR(1),o[2],0,0,0), C1,4); \
    GAPB(o[3]=MFMA_H(PAF(1),VFR(5),o[3],0,0,0), C1,6); \
    GAPB(o[2]=MFMA_H(PAF(2),VFR(2),o[2],0,0,0), C1,8); \
    GAPB(o[3]=MFMA_H(PAF(2),VFR(6),o[3],0,0,0), C1,10); \
    GAPB(o[2]=MFMA_H(PAF(3),VFR(3),o[2],0,0,0), C1,12); \
    GAPB(o[3]=MFMA_H(PAF(3),VFR(7),o[3],0,0,0), C1,14); \
    }while(0)
  int t=1;
  #undef CMASK
  #define CMASK(P0,P1,t) do{}while(0)
  for(;t+5<NT;t+=2){
    STEP(pB0,pB1,pA0,pA1,t,true,true,true);     WAIT_BAR(3); RESC(); ROT();
    STEP(pA0,pA1,pB0,pB1,t+1,true,true,true);   WAIT_BAR(3); RESC(); ROT();
  }
  #undef CMASK
  #define CMASK(P0,P1,t) do{int jb_=(t)-(NT-4); if(jb_>=0)cmask(P0,P1,jb_,qrel,hi);}while(0)
  #define ENDW(tt) do{ if((tt)+3<NT){WAIT_BAR(3);} else if((tt)+2<NT){WAIT_BAR(2);} else {WAIT_BAR(0);} }while(0)
  for(;t+1<NT;t+=2){
    STEP(pB0,pB1,pA0,pA1,t,(t+3<NT),(t+1<NT),(t+1<NT));       ENDW(t);   RESC(); ROT();
    STEP(pA0,pA1,pB0,pB1,t+1,(t+4<NT),(t+2<NT),(t+2<NT));     ENDW(t+1); RESC(); ROT();
  }
  STEP(pB0,pB1,pA0,pA1,NT-1,false,false,false); RESC();
  { float sacc=pB0[0]+pB0[1]; _Pragma("unroll") for(int r=2;r<16;++r)sacc+=pB0[r]; _Pragma("unroll") for(int r=0;r<16;++r)sacc+=pB1[r]; l_reg+=sacc;
    pw0=(u32x4){PKW(pB0,0),PKW(pB0,2),PKW(pB0,4),PKW(pB0,6)};pw1=(u32x4){PKW(pB0,8),PKW(pB0,10),PKW(pB0,12),PKW(pB0,14)};pw2=(u32x4){PKW(pB1,0),PKW(pB1,2),PKW(pB1,4),PKW(pB1,6)};pw3=(u32x4){PKW(pB1,8),PKW(pB1,10),PKW(pB1,12),PKW(pB1,14)};
    SBAR(); pv128(o,vb0+2*sl_cur,PAF(0),PAF(1),PAF(2),PAF(3)); }
  #undef PKW
  #undef PAF
  #undef VFR
  #undef PIN
  #undef MX3
  #undef GAPA
  #undef GAPB
  #undef EX
  #undef VRD
  #undef VRD2
  #undef KRD
  #undef STEP
  #undef ENDW
  #undef QLD
  {auto rr=__builtin_amdgcn_permlane32_swap(__float_as_uint(l_reg),__float_as_uint(l_reg),false,false);l_reg=__uint_as_float(rr[0])+__uint_as_float(rr[1]);}
  if(hi==0)wsf[32+r32]=l_reg;asm volatile("s_waitcnt lgkmcnt(0)":::"memory");
  int tide=(wv_in<<6)|lane_id_v();
  const int lane_e=tide&63,r32_e=lane_e&31,hi_e=lane_e>>5;
  float rli[16];
  #pragma unroll
  for(int r=0;r<16;++r)rli[r]=__builtin_amdgcn_rcpf(wsf[32+crow(r,hi_e)]);
  bf16*Ow=O+(long)(q0+wid*QBLK)*OPITCH+h*128;
  { bf16*stg=(bf16*)(shm+L_OST)+wid*2048;
    #pragma unroll
    for(int ch=0;ch<2;++ch){
      #pragma unroll
      for(int r=0;r<16;++r){const int orow=crow(r,hi_e);
        #pragma unroll
        for(int d0=0;d0<2;++d0)stg[orow*64+d0*32+r32_e]=(bf16)(o[2*ch+d0][r]*rli[r]);}
      asm volatile("s_waitcnt lgkmcnt(0)":::"memory");
      #pragma unroll
      for(int i=0;i<4;++i){const int row=i*8+(lane_e>>3),c8=lane_e&7; const u32x4 v=*(const u32x4*)(stg+row*64+c8*8); ATTN_STORE16(Ow+(long)row*OPITCH+ch*64+c8*8,v);}
      asm volatile("s_waitcnt lgkmcnt(0)":::"memory"); } }
  asm volatile("s_waitcnt lgkmcnt(0)\n\ts_barrier":::"memory");
  #undef DMA_K
  #undef DMA_V
  #undef CMASK
  #undef START
  #undef RESC
  #undef ROT
}
struct AttnTensors { const bf16* Q; const bf16* K; const bf16* V; bf16* O; };
template<class Sched,int THRL=8> __device__ __forceinline__ void attn_phase(char*lds,const AttnTensors&T,const Sched&S,const int wv_in){
  AttnUnit u;
  for(int i=0;S.next(i,u);++i){ attn_unit<THRL>(u.bh,u.qb,T.Q,T.K,T.V,T.O,lds,wv_in); }
}
#undef SBAR
#undef WAIT_BAR
}

DEV void ph_attn(const Params& p, LAS char* lds, int wv) {
    TID_DECL
    char* ws = p.ws;
    const attn128::AttnTensors T{(const half_t*)(ws + OFF_QA), (const half_t*)(ws + OFF_KA), (const half_t*)(ws + OFF_VAT), (half_t*)(ws + OFF_OA0)};
    const attn_body::StaticOrder S(nblk, bidx);
    attn128::attn_phase<attn_body::StaticOrder>((char*)lds, T, S, ls(wv));
}
DEV void ph_attn_comb(const Params& p, int l, int wv) {
    TID_DECL
    char* ws = p.ws; const int lane = tidx & 63, wid = tidx >> 6;
    const float* lp = p.da_lambda + l * 256;
    const float a = wave_sum(lane, lp[lane] * lp[64 + lane]), bq = wave_sum(lane, lp[128 + lane] * lp[192 + lane]);
    const float lam_init = 0.8f - 0.6f * expf(-0.3f * (float)l); const float lam = expf(a) - expf(bq) + lam_init;
    const int h = lane >> 3, part = lane & 7, dv0 = part * 16;
    const half_t* OA = (const half_t*)(ws + OFF_OA0);
    const half_t* ZA = (const half_t*)(ws + OFF_ZA); half_t* YA = (half_t*)(ws + OFF_QA);
    const float* ng = p.da_norm_g + l * 128;
    for (int t = bidx * NWAVE + wid; t < TB; t += nblk * NWAVE) {
        const half_t* o1p = OA + (size_t)t * 2048 + (2 * h) * 128 + dv0; const half_t* o2p = o1p + 128;
        const h8 a0 = *(const h8*)o1p, a1 = *(const h8*)(o1p + 8), b0 = *(const h8*)o2p, b1 = *(const h8*)(o2p + 8);
        float d[16]; float ss = 0.f;
#pragma unroll
        for (int e = 0; e < 8; ++e) { d[e] = (float)a0[e] - lam * (float)b0[e]; d[8 + e] = (float)a1[e] - lam * (float)b1[e]; ss += d[e] * d[e] + d[8 + e] * d[8 + e]; }
        ss += shx(lane, ss, 1); ss += shx(lane, ss, 2); ss += shx(lane, ss, 4);
        const float rs = rsqrtf(ss * (1.f / 128.f) + NORM_EPS) * (1.f - lam_init);
        const size_t off = (size_t)t * 1024 + h * 128 + dv0; const h8 z0 = *(const h8*)(ZA + off), z1 = *(const h8*)(ZA + off + 8); h8 y0, y1;
#pragma unroll
        for (int e = 0; e < 8; ++e) { y0[e] = (half_t)(d[e] * rs * ng[dv0 + e] * (float)z0[e]); y1[e] = (half_t)(d[8 + e] * rs * ng[dv0 + 8 + e] * (float)z1[e]); }
        *(h8*)(YA + off) = y0; *(h8*)(YA + off + 8) = y1;
    }
}


template <int ROFF> DEV void tr_rd8(h4 (&lo)[4], h4 (&hi)[4], unsigned a0) {
    asm volatile("ds_read_b64_tr_b16 %0, %8\n\tds_read_b64_tr_b16 %1, %8 offset:32\n\tds_read_b64_tr_b16 %2, %8 offset:64\n\tds_read_b64_tr_b16 %3, %8 offset:96\n\t"
                 "ds_read_b64_tr_b16 %4, %8 offset:%c9\n\tds_read_b64_tr_b16 %5, %8 offset:%c10\n\tds_read_b64_tr_b16 %6, %8 offset:%c11\n\tds_read_b64_tr_b16 %7, %8 offset:%c12\n\ts_waitcnt lgkmcnt(0)"
                 : "=&v"(lo[0]), "=&v"(lo[1]), "=&v"(lo[2]), "=&v"(lo[3]), "=&v"(hi[0]), "=&v"(hi[1]), "=&v"(hi[2]), "=&v"(hi[3])
                 : "v"(a0), "i"(ROFF), "i"(ROFF + 32), "i"(ROFF + 64), "i"(ROFF + 96) : "memory");
}
DEV float chunk_scan(const float* MG, int hh, int c, float& ig, int lane) {
    const int t = c * 64 + lane;
    ig = MG[(size_t)t * 8 + hh]; float a = MG[(size_t)t * 8 + 4 + hh];
#pragma unroll
    for (int o = 1; o < 64; o <<= 1) { const float u = shi(a, lane - o); if (lane >= o) a += u; }
    return a;
}
constexpr int LDV = 264, LDK = 136;
constexpr int ML_VT_BYTES = 64 * LDV * 2, ML_KT_BYTES = 64 * LDK * 2;
DEV void ph_ml_state(const Params& p, LAS char* lds, int wv) { TID_DECL
    char* ws = p.ws; const int lane = tidx & 63, wid = tidx >> 6, r = lane & 15, g = lane >> 4;
    const float* MG = (const float*)(ws + OFF_MG); const half_t* MV = (const half_t*)(ws + OFF_MVT); const half_t* MQKC = (const half_t*)(ws + OFF_MQKC);
    float* ST = (float*)(ws + OFF_ST); float* NV = (float*)(ws + OFF_NV); float* DEC = (float*)(ws + OFF_DEC);
    LAS half_t* Vt = (LAS half_t*)lds; LAS half_t* Kt = (LAS half_t*)(lds + ML_VT_BYTES);
    const unsigned vt_addr = (unsigned)(uintptr_t)Vt, kt_addr = (unsigned)(uintptr_t)Kt;
    for (int u = bidx; u < 1024; u += nblk) {
        const int hh = u >> 8, c = u & 255; float ig; const float a = chunk_scan(MG, hh, c, ig, lane); const float a63 = shi(a, 63); const float w = __expf(a63 - a + ig);
        __syncthreads();
        { h8 x[4];
#pragma unroll
          for (int i = 0; i < 4; ++i) { const int ch = tidx + 512 * i, row = ch >> 5, c16 = ch & 31; x[i] = *(const h8*)(MV + (size_t)(c * 64 + row) * 1024 + hh * 256 + c16 * 8); }
          h8 y[2];
#pragma unroll
          for (int i = 0; i < 2; ++i) { const int ch = tidx + 512 * i, row = ch >> 4, c16 = ch & 15; y[i] = *(const h8*)(MQKC + (size_t)(c * 64 + row) * 1024 + 512 + hh * 128 + c16 * 8); }
#pragma unroll
          for (int i = 0; i < 4; ++i) { const int ch = tidx + 512 * i, row = ch >> 5, c16 = ch & 31; const float wr = shi(w, row); h8 z;
#pragma unroll
              for (int e = 0; e < 8; ++e) z[e] = (half_t)((float)x[i][e] * wr);
              *(LAS h8*)(Vt + row * LDV + c16 * 8) = z; }
#pragma unroll
          for (int i = 0; i < 2; ++i) { const int ch = tidx + 512 * i, row = ch >> 4, c16 = ch & 15; *(LAS h8*)(Kt + row * LDK + c16 * 8) = y[i]; } }
        __syncthreads();
        f4 acc[2][8];
#pragma unroll
        for (int i = 0; i < 2; ++i)
#pragma unroll
            for (int j = 0; j < 8; ++j) acc[i][j] = (f4){0.f, 0.f, 0.f, 0.f};
#pragma unroll
        for (int ks = 0; ks < 2; ++ks) {
            const int frow = 32 * ks + 8 * g + (r >> 2);
            h4 vlo[4], vhi[4]; tr_rd8<4 * LDV * 2>(vlo, vhi, vt_addr + (unsigned)((frow * LDV + wid * 32 + 4 * (r & 3)) * 2));
            h4 klo[4], khi[4], klo2[4], khi2[4];
            tr_rd8<4 * LDK * 2>(klo, khi, kt_addr + (unsigned)((frow * LDK + 4 * (r & 3)) * 2));
            tr_rd8<4 * LDK * 2>(klo2, khi2, kt_addr + (unsigned)((frow * LDK + 64 + 4 * (r & 3)) * 2));
            const h8 va0 = cat44(vlo[0], vhi[0]), va1 = cat44(vlo[1], vhi[1]);
#pragma unroll
            for (int dt = 0; dt < 4; ++dt) { const h8 kb = cat44(klo[dt], khi[dt]); acc[0][dt] = MFMA16(va0, kb, acc[0][dt]); acc[1][dt] = MFMA16(va1, kb, acc[1][dt]); }
#pragma unroll
            for (int dt = 0; dt < 4; ++dt) { const h8 kb = cat44(klo2[dt], khi2[dt]); acc[0][4 + dt] = MFMA16(va0, kb, acc[0][4 + dt]); acc[1][4 + dt] = MFMA16(va1, kb, acc[1][4 + dt]); }
        }
#pragma unroll
        for (int vt = 0; vt < 2; ++vt)
#pragma unroll
            for (int dt = 0; dt < 8; ++dt)
#pragma unroll
                for (int e = 0; e < 4; ++e) ST[((size_t)(hh * 256 + c) * 256 + wid * 32 + vt * 16 + 4 * g + e) * 128 + dt * 16 + r] = acc[vt][dt][e];
        { const int d = wid * 16 + r; float s = 0.f;
#pragma unroll
          for (int e = 0; e < 16; ++e) s += (float)Kt[(16 * g + e) * LDK + d] * shi(w, 16 * g + e);
          s = gsum(lane, s); if (g == 0) NV[(size_t)(hh * 256 + c) * 128 + d] = s; }
        if (tidx == 0) DEC[hh * 256 + c] = __expf(a63);
    }
    __syncthreads();
}
DEV void ph_ml_scan(const Params& p, int wv) { TID_DECL
    char* ws = p.ws; float* ST = (float*)(ws + OFF_ST); float* NV = (float*)(ws + OFF_NV); const float* DEC = (const float*)(ws + OFF_DEC);
    const int nthr = nblk * NTHREADS;
    for (int e0 = bidx * NTHREADS + tidx; e0 < 4 * 32768 + 512; e0 += nthr) {
        float* base; size_t stride; int hh;
        half_t* b16 = nullptr;
        if (e0 < 4 * 32768) { hh = e0 >> 15; base = ST + (size_t)hh * 256 * 32768 + (e0 & 32767); stride = 32768; b16 = (half_t*)(ws + OFF_ST16) + (size_t)hh * 256 * 32768 + (e0 & 32767); }
        else { const int q = e0 - 4 * 32768; hh = q >> 7; base = NV + (size_t)hh * 256 * 128 + (q & 127); stride = 128; }
        float S = 0.f;
        for (int c0 = 0; c0 < 256; c0 += 8) { float tmp[8];
#pragma unroll
            for (int i = 0; i < 8; ++i) tmp[i] = base[(size_t)(c0 + i) * stride];
#pragma unroll
            for (int i = 0; i < 8; ++i) { if (b16) b16[(size_t)(c0 + i) * stride] = (half_t)S; else base[(size_t)(c0 + i) * stride] = S; S = DEC[hh * 256 + c0 + i] * S + tmp[i]; } }
    }
}
DEV void ph_ml_out(const Params& p, int l, LAS char* lds, int wv) { TID_DECL
    char* ws = p.ws; const int lane = tidx & 63, wid = tidx >> 6, r = lane & 15, g = lane >> 4;
    const float* MG = (const float*)(ws + OFF_MG); const half_t* MV = (const half_t*)(ws + OFF_MVT); const half_t* MQKC = (const half_t*)(ws + OFF_MQKC);
    const half_t* ST16 = (const half_t*)(ws + OFF_ST16); const float* NV = (const float*)(ws + OFF_NV);
    const half_t* MO = (const half_t*)(ws + OFF_MO); const half_t* MZ = (const half_t*)(ws + OFF_MZ); half_t* YB = (half_t*)(ws + OFF_YB);
    const float* ng = p.ml_norm_g + l * 256;
    const int ci = wid >> 2, j = wid & 3;
    LAS half_t* Vt = (LAS half_t*)(lds + ci * ML_VT_BYTES); const unsigned vt_addr = (unsigned)(uintptr_t)Vt;
    for (int bu = bidx; bu < 512; bu += nblk) {
        const int cu = 2 * bu + ci, hh = cu >> 8, c = cu & 255; const int t = c * 64 + 16 * j + r;
        __syncthreads();
        { h8 x[8];
#pragma unroll
          for (int i = 0; i < 8; ++i) { const int ch = tidx + 512 * i, row = ch >> 5, c16 = ch & 31; x[i] = *(const h8*)(MV + (size_t)(((2 * bu) & 255) * 64 + row) * 1024 + ((2 * bu) >> 8) * 256 + c16 * 8); }
#pragma unroll
          for (int i = 0; i < 8; ++i) { const int ch = tidx + 512 * i, row = ch >> 5, c16 = ch & 31; *(LAS h8*)((LAS half_t*)lds + (row >> 6) * (ML_VT_BYTES / 2) + (row & 63) * LDV + c16 * 8) = x[i]; } }
        __syncthreads();
        float ig; const float a = chunk_scan(MG, hh, c, ig, lane); const float a_t = shi(a, 16 * j + r); const float ea = __expf(a_t);
        h8 qf[4];
#pragma unroll
        for (int ks = 0; ks < 4; ++ks) qf[ks] = *(const h8*)(MQKC + (size_t)t * 1024 + hh * 128 + 32 * ks + 8 * g);
        f4 acc[16];
#pragma unroll
        for (int vb = 0; vb < 16; vb += 4) { h8 sa[4][4];
#pragma unroll
            for (int v4 = 0; v4 < 4; ++v4)
#pragma unroll
                for (int ks = 0; ks < 4; ++ks) sa[v4][ks] = *(const h8*)(ST16 + ((size_t)cu * 256 + (vb + v4) * 16 + r) * 128 + 32 * ks + 8 * g);
#pragma unroll
            for (int v4 = 0; v4 < 4; ++v4) { const int vt = vb + v4; acc[vt] = (f4){0.f, 0.f, 0.f, 0.f};
#pragma unroll
                for (int ks = 0; ks < 4; ++ks) acc[vt] = MFMA16(sa[v4][ks], qf[ks], acc[vt]);
                acc[vt] *= ea; } }
        float den = 0.f;
        { const float* np = NV + (size_t)cu * 128 + 32 * g; const half_t* qp = MQKC + (size_t)t * 1024 + hh * 128 + 32 * g;
#pragma unroll
          for (int m = 0; m < 4; ++m) { const h8 q8 = *(const h8*)(qp + 8 * m);
#pragma unroll
              for (int e = 0; e < 8; ++e) den += (float)q8[e] * np[8 * m + e]; }
          den *= ea; }
        for (int kb = 0; kb <= (j >> 1); ++kb) {
            h8 kfr[2][4];
#pragma unroll
            for (int st = 0; st < 2; ++st)
#pragma unroll
                for (int ks = 0; ks < 4; ++ks) kfr[st][ks] = *(const h8*)(MQKC + (size_t)(c * 64 + 32 * kb + 16 * st + r) * 1024 + 512 + hh * 128 + 32 * ks + 8 * g);
            f4 wv[2];
#pragma unroll
            for (int st = 0; st < 2; ++st) { f4 gacc = (f4){0.f, 0.f, 0.f, 0.f};
#pragma unroll
                for (int ks = 0; ks < 4; ++ks) gacc = MFMA16(kfr[st][ks], qf[ks], gacc);
#pragma unroll
                for (int e = 0; e < 4; ++e) { const int si = 32 * kb + 16 * st + 4 * g + e; const float a_s = shi(a, si), ig_s = shi(ig, si);
                    wv[st][e] = (si <= 16 * j + r) ? gacc[e] * __expf(a_t - a_s + ig_s) : 0.f; den += wv[st][e]; } }
            const h8 pb = cat44(toh4(wv[0]), toh4(wv[1]));
            const unsigned a0 = vt_addr + (unsigned)((((32 * kb + 4 * g + (r >> 2)) * LDV) + 4 * (r & 3)) * 2);
            asm volatile("s_waitcnt lgkmcnt(0)" ::: "memory");
#pragma unroll
            for (int c4 = 0; c4 < 4; ++c4) { h4 lo[4], hi4[4]; tr_rd8<16 * LDV * 2>(lo, hi4, a0 + c4 * 128);
#pragma unroll
                for (int i = 0; i < 4; ++i) acc[c4 * 4 + i] = MFMA16(cat44(lo[i], hi4[i]), pb, acc[c4 * 4 + i]); }
        }
        den = gsum(lane, den); const float inv = 1.f / fmaxf(fabsf(den), 1.f); float ss = 0.f;
#pragma unroll
        for (int vt = 0; vt < 16; ++vt) { acc[vt] *= inv; ss += acc[vt][0] * acc[vt][0] + acc[vt][1] * acc[vt][1] + acc[vt][2] * acc[vt][2] + acc[vt][3] * acc[vt][3]; }
        ss = gsum(lane, ss); const float rs = rsqrtf(ss * (1.f / 256.f) + NORM_EPS);
#pragma unroll
        for (int vb = 0; vb < 16; vb += 8) {
            f4 gg[8]; h4 o4[8], z4[8];
#pragma unroll
            for (int i = 0; i < 8; ++i) { const int v = (vb + i) * 16 + 4 * g; const size_t off = (size_t)t * 1024 + hh * 256 + v; gg[i] = *(const f4*)(ng + v); o4[i] = *(const h4*)(MO + off); z4[i] = *(const h4*)(MZ + off); }
#pragma unroll
            for (int i = 0; i < 8; ++i) { const int vt = vb + i; const size_t off = (size_t)t * 1024 + hh * 256 + vt * 16 + 4 * g;
                *(h4*)(YB + off) = toh4((f4){acc[vt][0] * rs * gg[i][0] * (float)o4[i][0] * (float)z4[i][0], acc[vt][1] * rs * gg[i][1] * (float)o4[i][1] * (float)z4[i][1],
                                             acc[vt][2] * rs * gg[i][2] * (float)o4[i][2] * (float)z4[i][2], acc[vt][3] * rs * gg[i][3] * (float)o4[i][3] * (float)z4[i][3]}); } }
    }
    __syncthreads();
}

constexpr int CAP = 704, NPL = CAP / 64;
constexpr int IDX_WAVE_LDS = 4 * CAP * 4 + 4 * CAP * 2 + 256 * 4;
DEV unsigned f2key(float v) { const unsigned b = __float_as_uint(v); return b ^ ((b >> 31) ? 0xffffffffu : 0x80000000u); }
DEV float key2f(unsigned u) { const unsigned b = (u >> 31) ? (u ^ 0x80000000u) : ~u; return __uint_as_float(b); }
template <int PASSES> DEV float prune(LAS float* val, LAS u16* idx, LAS unsigned* hist, int n, int lane, int& kept_out) {
    unsigned u[NPL]; u16 id[NPL];
#pragma unroll
    for (int i = 0; i < NPL; ++i) { const int e = lane + 64 * i; const bool ok = e < n; u[i] = ok ? f2key(val[e]) : 0u; id[i] = ok ? idx[e] : (u16)0; }
    unsigned prefix = 0u, mask = 0u; int want = TOPK;
#pragma unroll 1
    for (int ps = 0; ps < PASSES; ++ps) { const int shift = 24 - 8 * ps;
#pragma unroll
        for (int i = 0; i < 4; ++i) hist[lane + 64 * i] = 0u;
        __builtin_amdgcn_fence(__ATOMIC_RELEASE, "wavefront"); __builtin_amdgcn_wave_barrier();
#pragma unroll
        for (int i = 0; i < NPL; ++i) { const int e = lane + 64 * i; if (e < n && (u[i] & mask) == prefix) __hip_atomic_fetch_add(&hist[(u[i] >> shift) & 255u], 1u, __ATOMIC_RELAXED, __HIP_MEMORY_SCOPE_WORKGROUP); }
        __builtin_amdgcn_fence(__ATOMIC_ACQ_REL, "wavefront"); __builtin_amdgcn_wave_barrier();
        const unsigned c0 = hist[4 * lane], c1 = hist[4 * lane + 1], c2 = hist[4 * lane + 2], c3 = hist[4 * lane + 3];
        const unsigned mine = c0 + c1 + c2 + c3; unsigned above = mine;
#pragma unroll
        for (int o = 1; o < 64; o <<= 1) { const unsigned t = shi(above, lane + o); if (lane + o < 64) above += t; }
        above -= mine;
        const bool here = (above < (unsigned)want) && (above + mine >= (unsigned)want);
        int bsel = 0; unsigned cab = 0;
        if (here) { unsigned cum = above; if (cum + c3 >= (unsigned)want) { bsel = 4 * lane + 3; cab = cum; } else { cum += c3; if (cum + c2 >= (unsigned)want) { bsel = 4 * lane + 2; cab = cum; } else { cum += c2; if (cum + c1 >= (unsigned)want) { bsel = 4 * lane + 1; cab = cum; } else { cum += c1; bsel = 4 * lane; cab = cum; } } } }
        const unsigned long long bal = __ballot(here); const int src = __ffsll((long long)bal) - 1;
        bsel = shi(bsel, src); cab = shi(cab, src);
        prefix |= ((unsigned)bsel) << shift; mask |= 0xffu << shift; want -= (int)cab;
        __builtin_amdgcn_wave_barrier();
    }
    int kept = 0, eqseen = 0;
#pragma unroll
    for (int i = 0; i < NPL; ++i) { const int e = lane + 64 * i; const bool ok = e < n; const unsigned um = u[i] & mask; const bool gt = ok && um > prefix, eq = ok && um == prefix;
        const unsigned long long lt = (1ull << lane) - 1ull; bool keep;
        if (PASSES == 4) { const unsigned long long beq = __ballot(eq); const int erank = eqseen + __popcll(beq & lt); keep = gt || (eq && erank < want); eqseen += __popcll(beq); }
        else keep = gt || eq;
        const unsigned long long bk = __ballot(keep); const int pos = kept + __popcll(bk & lt); kept += __popcll(bk);
        if (keep) { val[pos] = key2f(u[i]); idx[pos] = id[i]; } }
    __builtin_amdgcn_fence(__ATOMIC_ACQ_REL, "wavefront"); __builtin_amdgcn_wave_barrier();
    kept_out = kept;
    return key2f(prefix);
}
DEV void ph_index(const Params& p, LAS char* lds, int wv, int qslot) {
    TID_DECL
    char* ws = p.ws; const int lane = tidx & 63, wid = tidx >> 6, c32 = lane & 31, hi = lane >> 5;
    const half_t* IQ = (const half_t*)(ws + OFF_IQ); const half_t* IK = (const half_t*)(ws + OFF_IK); const float* IW = (const float*)(ws + OFF_IW);
    u16* IDX = (u16*)(ws + OFF_IDX); int* CNT = (int*)(ws + OFF_CNT);
    LAS char* my = lds + wid * IDX_WAVE_LDS; LAS float* val = (LAS float*)my; LAS u16* idxb = (LAS u16*)(my + 4 * CAP * 4); LAS unsigned* hist = (LAS unsigned*)(my + 4 * CAP * 4 + 4 * CAP * 2);
    const unsigned ltm = (1u << c32) - 1u;
    unsigned* qctr = (unsigned*)(ws + OFF_CTRL) + 8192 + 64 * qslot;
    for (;;) {
        {
            int uq = 0; if (lane == 0) uq = (int)__hip_atomic_fetch_add(qctr, 1u, __ATOMIC_RELAXED, __HIP_MEMORY_SCOPE_AGENT);
            uq = __builtin_amdgcn_readfirstlane(uq); if (uq >= 4096) break;
            uq = 4095 - uq;
            const int tq0 = uq * 4;
            const int asel = (c32 >> 2) & 1, ah = (c32 & 3) + 4 * (c32 >> 3);
            h8 af[2][4]; float iw[2][16];
#pragma unroll
            for (int T = 0; T < 2; ++T) {
#pragma unroll
                for (int s = 0; s < 4; ++s) af[T][s] = *(const h8*)(IQ + (size_t)(tq0 + 2 * T + asel) * 1024 + ah * 64 + 16 * s + 8 * hi);
#pragma unroll
                for (int e = 0; e < 16; e += 4) { const f4 w4 = *(const f4*)(IW + (size_t)(tq0 + 2 * T + hi) * 16 + e); iw[T][e] = w4[0]; iw[T][e + 1] = w4[1]; iw[T][e + 2] = w4[2]; iw[T][e + 3] = w4[3]; } }
            float tau[2] = {-INFINITY, -INFINITY}; int cnt[2] = {0, 0};
#pragma unroll
            for (int T = 0; T < 2; ++T) { asm volatile("" :: "v"(af[T][0]), "v"(af[T][1]), "v"(af[T][2]), "v"(af[T][3]));
#pragma unroll
                for (int e = 0; e < 16; e += 4) asm volatile("" :: "v"(iw[T][e]), "v"(iw[T][e + 1]), "v"(iw[T][e + 2]), "v"(iw[T][e + 3])); }
            const int nkt = (tq0 + 3) / 32 + 1;
            h8 B0[4], B1[4], B2[4];
            const int ktl = nkt - 1;
#define IDX_GLD(dst, tile_, s_) asm volatile("global_load_dwordx4 %0, %1, %2 offset:%c3" : "=v"(dst) : "v"(lane16), "s"((const char*)IK + (size_t)(tile_) * 4096), "i"((s_) * 1024) : "memory")
#define IDX_WAIT(n, b) asm volatile("s_waitcnt vmcnt(" #n ")" : "+v"(b[0]), "+v"(b[1]), "+v"(b[2]), "+v"(b[3]) :: "memory")
            const unsigned lane16 = (unsigned)lane * 16u;
#pragma unroll
            for (int s = 0; s < 4; ++s) { IDX_GLD(B0[s], 0, s); }
#pragma unroll
            for (int s = 0; s < 4; ++s) { IDX_GLD(B1[s], (ktl < 1 ? ktl : 1), s); }
            auto tile = [&](h8 (&bu)[4], h8 (&bl)[4], const int kt) {
                const int key = kt * 32 + c32; const int ktn = (kt + 2 < ktl) ? kt + 2 : ktl;
#pragma unroll
                for (int s = 0; s < 4; ++s) { IDX_GLD(bl[s], ktn, s); }
                IDX_WAIT(8, bu);
                f16v acc[2];
#pragma unroll
                for (int T = 0; T < 2; ++T) { acc[T] = (f16v){0.f, 0.f, 0.f, 0.f, 0.f, 0.f, 0.f, 0.f, 0.f, 0.f, 0.f, 0.f, 0.f, 0.f, 0.f, 0.f};
#pragma unroll
                    for (int s = 0; s < 4; ++s) acc[T] = MFMA32(af[T][s], bu[s], acc[T]); }
#pragma unroll
                for (int T = 0; T < 2; ++T) { float v = 0.f;
#pragma unroll
                    for (int e = 0; e < 16; ++e)
                        v = __builtin_fmaf(__int_as_float(max(__float_as_int(acc[T][e]), 0)), iw[T][e], v);
                    const bool cand = (key <= tq0 + 2 * T + hi) && (v > tau[T]);
                    const unsigned long long bal = __builtin_amdgcn_ballot_w64(cand);
                    if (bal) { const unsigned m32 = hi ? (unsigned)(bal >> 32) : (unsigned)bal; const int pos = cnt[T] + __popc(m32 & ltm);
                        if (cand) { val[(2 * T + hi) * CAP + pos] = v; idxb[(2 * T + hi) * CAP + pos] = (u16)key; }
                        cnt[T] += __popc(m32); } }
            };
            for (int kt = 0; kt < nkt;) {
                for (; kt < nkt; kt += 3) { tile(B0, B2, kt); tile(B1, B0, kt + 1); tile(B2, B1, kt + 2);
                    if (__ballot(cnt[0] > CAP - 96 || cnt[1] > CAP - 96)) { kt += 3; break; } }
                IDX_WAIT(0, B0); IDX_WAIT(0, B1); IDX_WAIT(0, B2);
                __builtin_amdgcn_fence(__ATOMIC_ACQ_REL, "wavefront"); __builtin_amdgcn_wave_barrier();
#pragma unroll
                for (int T = 0; T < 2; ++T)
#pragma unroll
                    for (int hh = 0; hh < 2; ++hh) { const int nq = __builtin_amdgcn_readlane(cnt[T], 32 * hh);
                        if (nq > CAP - 96) { const int q = 2 * T + hh; int kept; float tn = prune<2>(val + q * CAP, idxb + q * CAP, hist, nq, lane, kept);
                            if (kept > CAP - 128) tn = prune<4>(val + q * CAP, idxb + q * CAP, hist, kept, lane, kept);
                            if (hi == hh) { tau[T] = tn; cnt[T] = kept; } } }
            }
            __builtin_amdgcn_fence(__ATOMIC_ACQ_REL, "wavefront"); __builtin_amdgcn_wave_barrier();
#undef IDX_GLD
#undef IDX_WAIT
#pragma unroll
            for (int T = 0; T < 2; ++T)
#pragma unroll
                for (int hh = 0; hh < 2; ++hh) { const int q = 2 * T + hh; int nq = __builtin_amdgcn_readlane(cnt[T], 32 * hh);
                    if (nq > TOPK) { int kept; prune<4>(val + q * CAP, idxb + q * CAP, hist, nq, lane, kept); nq = kept; }
#pragma unroll
                    for (int i = 0; i < 4; ++i) { const int e = lane + 64 * i; IDX[(size_t)(tq0 + q) * 256 + e] = (e < nq) ? idxb[q * CAP + e] : (u16)0; }
                    if (lane == 0) CNT[tq0 + q] = nq; }
            __builtin_amdgcn_fence(__ATOMIC_ACQ_REL, "wavefront"); __builtin_amdgcn_wave_barrier();
        }
    }
}

constexpr int SP_LD = 264;
constexpr int SP_WAVE_LDS = 32 * SP_LD * 2 + 512;
DEV void tr_read8(h4 (&lo)[4], h4 (&hi)[4], unsigned a0) {
    asm volatile("ds_read_b64_tr_b16 %0, %8\n\tds_read_b64_tr_b16 %1, %8 offset:32\n\tds_read_b64_tr_b16 %2, %8 offset:64\n\tds_read_b64_tr_b16 %3, %8 offset:96\n\t"
                 "ds_read_b64_tr_b16 %4, %8 offset:%c9\n\tds_read_b64_tr_b16 %5, %8 offset:%c10\n\tds_read_b64_tr_b16 %6, %8 offset:%c11\n\tds_read_b64_tr_b16 %7, %8 offset:%c12\n\ts_waitcnt lgkmcnt(0)"
                 : "=&v"(lo[0]), "=&v"(lo[1]), "=&v"(lo[2]), "=&v"(lo[3]), "=&v"(hi[0]), "=&v"(hi[1]), "=&v"(hi[2]), "=&v"(hi[3])
                 : "v"(a0), "i"(16 * SP_LD * 2), "i"(16 * SP_LD * 2 + 32), "i"(16 * SP_LD * 2 + 64), "i"(16 * SP_LD * 2 + 96) : "memory");
}
DEV void ph_sparse(const Params& p, LAS char* lds, int wv, int qslot) {
    TID_DECL
    char* ws = p.ws; const int lane = tidx & 63, wid = tidx >> 6, r = lane & 15, g = lane >> 4;
    half_t* DQ = (half_t*)(ws + OFF_DQ); const half_t* C = (const half_t*)(ws + OFF_C); const u16* IDX = (const u16*)(ws + OFF_IDX); const int* CNT = (const int*)(ws + OFF_CNT);
    LAS half_t* tile = (LAS half_t*)(lds + wid * SP_WAVE_LDS); const unsigned tile_addr = (unsigned)(uintptr_t)tile;
    LAS u16* idl = (LAS u16*)(lds + wid * SP_WAVE_LDS + 32 * SP_LD * 2);
    const int grow = lane >> 5, gc = (lane & 31) * 8;
    unsigned* qctr = (unsigned*)(ws + OFF_CTRL) + 8192 + 64 * (4 + qslot);
    for (;;) {
      int qb4 = 0; if (lane == 0) qb4 = (int)__hip_atomic_fetch_add(qctr, 1u, __ATOMIC_RELAXED, __HIP_MEMORY_SCOPE_AGENT);
      qb4 = __builtin_amdgcn_readfirstlane(qb4); if (qb4 >= TB / 4) break;
      for (int t = 4 * qb4; t < 4 * qb4 + 4; ++t) {
        const int n = CNT[t];
        { typedef unsigned u32x2_t __attribute__((ext_vector_type(2))); *(LAS u32x2_t*)(idl + lane * 4) = *(const u32x2_t*)(IDX + (size_t)t * 256 + lane * 4); }
        h8 qf[8];
#pragma unroll
        for (int ks = 0; ks < 8; ++ks) qf[ks] = (r < 8) ? *(const h8*)(DQ + (size_t)t * 2048 + r * 256 + 32 * ks + 8 * g) : zero8();
        f4 ob[16];
#pragma unroll
        for (int ct = 0; ct < 16; ++ct) ob[ct] = (f4){0.f, 0.f, 0.f, 0.f};
        float mrun = -INFINITY, lpart = 0.f;
        const int nkb = (n + 31) >> 5;
        __builtin_amdgcn_fence(__ATOMIC_ACQ_REL, "wavefront"); __builtin_amdgcn_wave_barrier();
        h8 pre[16];
#pragma unroll
        for (int i = 0; i < 16; ++i) pre[i] = *(const h8*)(C + (size_t)idl[grow + 2 * i] * 256 + gc);
        for (int kb = 0; kb < nkb; ++kb) {
#pragma unroll
            for (int i = 0; i < 16; ++i) *(LAS h8*)(tile + (grow + 2 * i) * SP_LD + gc) = pre[i];
            if (kb + 1 < nkb) {
#pragma unroll
                for (int i = 0; i < 16; ++i) pre[i] = *(const h8*)(C + (size_t)idl[32 * (kb + 1) + grow + 2 * i] * 256 + gc); }
            __builtin_amdgcn_fence(__ATOMIC_ACQ_REL, "wavefront"); __builtin_amdgcn_wave_barrier();
            f4 s[2];
#pragma unroll
            for (int st = 0; st < 2; ++st) { s[st] = (f4){0.f, 0.f, 0.f, 0.f};
#pragma unroll
                for (int ks = 0; ks < 8; ++ks) { const h8 a = *(const LAS h8*)(tile + (16 * st + r) * SP_LD + 32 * ks + 8 * g); s[st] = MFMA16(a, qf[ks], s[st]); }
#pragma unroll
                for (int e = 0; e < 4; ++e) if (32 * kb + 16 * st + 4 * g + e >= n) s[st][e] = -INFINITY; }
            float mx = fmaxf(fmaxf(fmaxf(s[0][0], s[0][1]), fmaxf(s[0][2], s[0][3])), fmaxf(fmaxf(s[1][0], s[1][1]), fmaxf(s[1][2], s[1][3])));
            mx = gmax(lane, mx); const float mn = fmaxf(mrun, mx); const float sc = exp2f(mrun - mn); mrun = mn;
            float ps = 0.f; f4 pp[2];
#pragma unroll
            for (int st = 0; st < 2; ++st)
#pragma unroll
                for (int e = 0; e < 4; ++e) { pp[st][e] = exp2f(s[st][e] - mn); ps += pp[st][e]; }
            lpart = lpart * sc + ps;
            const h8 pb = cat44(toh4(pp[0]), toh4(pp[1]));
            const unsigned a0 = tile_addr + (unsigned)(((4 * g + (r >> 2)) * SP_LD + 4 * (r & 3)) * 2);
            asm volatile("s_waitcnt lgkmcnt(0)" ::: "memory");
#pragma unroll
            for (int c4 = 0; c4 < 4; ++c4) { h4 lo[4], hi4[4]; tr_read8(lo, hi4, a0 + c4 * 128);
#pragma unroll
                for (int j = 0; j < 4; ++j) { const int ct = c4 * 4 + j; ob[ct] = ob[ct] * sc; ob[ct] = MFMA16(cat44(lo[j], hi4[j]), pb, ob[ct]); } }
        }
        const float inv = 1.f / gsum(lane, lpart);
        __builtin_amdgcn_fence(__ATOMIC_ACQ_REL, "wavefront"); __builtin_amdgcn_wave_barrier();
        if (r < 8) {
#pragma unroll
            for (int ct = 0; ct < 16; ++ct) *(LAS h4*)(tile + r * 256 + 16 * ct + 4 * g) = toh4(ob[ct] * inv); }
        __builtin_amdgcn_fence(__ATOMIC_ACQ_REL, "wavefront"); __builtin_amdgcn_wave_barrier();
#pragma unroll
        for (int i = 0; i < 4; ++i) { const int ch = lane + 64 * i; *(h8*)(DQ + (size_t)t * 2048 + ch * 8) = *(const LAS h8*)(tile + ch * 8); }
        __builtin_amdgcn_fence(__ATOMIC_ACQ_REL, "wavefront"); __builtin_amdgcn_wave_barrier();
      }
    }
}

DEV void ph_final(const Params& p, int l, int b, int wv) {
    TID_DECL
    const float* X = p.x + (size_t)b * TB * 2048; float* O = p.out + (size_t)b * TB * 2048; half_t* XH = (half_t*)(p.ws + OFF_X1H) + (size_t)b * TB * 2048;
    const half_t* OUTP = (const half_t*)(p.ws + OFF_OUTP); const float* g = p.post_g + l * 2048;
    const int lane = tidx & 63, wid = tidx >> 6;
    for (int t = bidx * NWAVE + wid; t < TB; t += nblk * NWAVE) {
        f4 ov[8], xv[8]; float ss = 0.f;
#pragma unroll
        for (int i = 0; i < 8; ++i) { const size_t off = (size_t)t * 2048 + i * 256 + lane * 4; const h4 oh = *(const h4*)(OUTP + off);
            if (l == 0) xv[i] = *(const f4*)(X + off); else { const h4 xh = *(const h4*)(XH + off); xv[i] = (f4){(float)xh[0], (float)xh[1], (float)xh[2], (float)xh[3]}; }
            ov[i] = (f4){(float)oh[0], (float)oh[1], (float)oh[2], (float)oh[3]}; ss += ov[i][0] * ov[i][0] + ov[i][1] * ov[i][1] + ov[i][2] * ov[i][2] + ov[i][3] * ov[i][3]; }
        ss = wave_sum(lane, ss); const float rs = rsqrtf(ss * (1.f / 2048.f) + NORM_EPS);
#pragma unroll
        for (int i = 0; i < 8; ++i) { const size_t off = (size_t)t * 2048 + i * 256 + lane * 4; const f4 gg = *(const f4*)(g + i * 256 + lane * 4); const f4 r = xv[i] + ov[i] * rs * gg;
            if (l == DEPTH - 1) *(f4*)(O + off) = r; else *(h4*)(XH + off) = toh4(r); }
    }
}

#define XB_TMO      128
#define XB_XCNT(j)  (256  + 64 * (j))
#define XB_XSUB(j)  (1280 + 64 * (j))
#define XB_XGEN(j)  (2304 + 64 * (j))
#define XB_TOP      3328
#define XB_TOPGEN   3392
#define XCD_BAR_WORDS 3456
#define XB_SPIN_CAP (1u << 22)

__device__ __forceinline__ unsigned xb_ld(unsigned* p)              { return __hip_atomic_load(p, __ATOMIC_RELAXED, __HIP_MEMORY_SCOPE_AGENT); }
__device__ __forceinline__ unsigned xb_add(unsigned* p, unsigned v) { return __hip_atomic_fetch_add(p, v, __ATOMIC_RELAXED, __HIP_MEMORY_SCOPE_AGENT); }
__device__ __forceinline__ unsigned xb_xcc_id() { return (unsigned)__builtin_amdgcn_s_getreg((3 << 11) | 20) & 0xFu; }
#define XB_SPIN(cond, bar) do { unsigned _sp = 0; while (cond) { __builtin_amdgcn_s_sleep(1); \
    if ((++_sp & 255u) == 0u) { if (xb_ld(&(bar)[XB_TMO])) break; if (_sp > XB_SPIN_CAP) { atomicAdd(&(bar)[XB_TMO], 1u); break; } } } } while (0)

struct XcdBarrier {
    unsigned* bar; unsigned x;
    volatile LAS unsigned* st;
};

__device__ __forceinline__ XcdBarrier xcd_barrier_post(unsigned* bar, volatile LAS unsigned* st, const bool t0) {
    XcdBarrier b; b.bar = bar; b.x = xb_xcc_id(); b.st = st;
    if (t0) (void)xb_add(&bar[XB_XCNT(b.x)], 1u);
    return b;
}
__device__ __forceinline__ void xcd_barrier_complete(unsigned* bar, unsigned x, unsigned& nloc, unsigned& nx) {
    const unsigned G = gridDim.x * gridDim.y * gridDim.z;
    unsigned sum, cnt, mine, sp = 0u;
    for (;;) {
        sum = 0u; cnt = 0u; mine = 0u;
#pragma unroll
        for (unsigned j = 0; j < 16; ++j) { const unsigned c = xb_ld(&bar[XB_XCNT(j)]); sum += c; cnt += (c > 0u) ? 1u : 0u; mine = (j == x) ? c : mine; }
        if (sum == G) break;
        __builtin_amdgcn_s_sleep(1);
        if ((++sp & 255u) == 0u) { if (xb_ld(&bar[XB_TMO])) break; if (sp > XB_SPIN_CAP) { atomicAdd(&bar[XB_TMO], 1u); break; } }
    }
    nloc = mine > 0u ? mine : 1u; nx = cnt > 0u ? cnt : 1u;
}

__device__ __forceinline__ void xcd_barrier(const XcdBarrier& b, const bool t0) {
    asm volatile("s_waitcnt vmcnt(0)" ::: "memory");
    __syncthreads();
    if (t0) {
        unsigned* bar = b.bar;
        __builtin_amdgcn_s_waitcnt(0);
        unsigned nloc = b.st[0], nx = b.st[1];
        if (nloc == 0u) { xcd_barrier_complete(bar, b.x, nloc, nx); b.st[0] = nloc; b.st[1] = nx; }
        const unsigned old = xb_add(&bar[XB_XSUB(b.x)], 1u);
        const unsigned gen = old / nloc;
        if (old + 1u == (gen + 1u) * nloc) {
            __builtin_amdgcn_fence(__ATOMIC_RELEASE, "agent");
            asm volatile("s_waitcnt vmcnt(0)" ::: "memory");
            const unsigned og = xb_add(&bar[XB_TOP], 1u);
            const unsigned tg = og / nx;
            if (og + 1u == (tg + 1u) * nx) xb_add(&bar[XB_TOPGEN], 1u);
            else XB_SPIN(xb_ld(&bar[XB_TOPGEN]) == tg, bar);
            __builtin_amdgcn_fence(__ATOMIC_ACQUIRE, "agent");
            xb_add(&bar[XB_XGEN(b.x)], 1u);
            asm volatile("s_waitcnt vmcnt(0)" ::: "memory");
        } else {
            XB_SPIN(xb_ld(&bar[XB_XGEN(b.x)]) == gen, bar);
            __builtin_amdgcn_fence(__ATOMIC_ACQUIRE, "agent");
            asm volatile("s_waitcnt vmcnt(0)" ::: "memory");
        }
    }
    __syncthreads();
}

constexpr int LDS_BYTES = 147456;
constexpr int LDS_HDR_OFF = LDS_BYTES - 256;
static_assert(8 * SP_WAVE_LDS <= LDS_HDR_OFF && pg8::STAGE_BYTES <= LDS_HDR_OFF && 8 * IDX_WAVE_LDS <= LDS_HDR_OFF, "LDS map");
constexpr int PH_PER_B = 9, PH_PER_L = 1 + NB * PH_PER_B, PH_TOTAL = DEPTH * PH_PER_L;
template <class T> DEV T* ldptr(const LAS unsigned* w) {
    const unsigned lo = __builtin_amdgcn_readfirstlane(w[0]), hi = __builtin_amdgcn_readfirstlane(w[1]);
    const unsigned long long v = ((unsigned long long)hi << 32) | lo;
    return (T*)(__attribute__((address_space(1))) T*)v;
}
DEV Params ldp(const LAS unsigned* w_in) { Params q;
    const LAS unsigned* w = (const LAS unsigned*)(size_t)(unsigned)ls((int)(unsigned)(size_t)w_in);
    q.x = ldptr<const float>(w + 0); q.pre_g = ldptr<const float>(w + 2); q.w_in = ldptr<const float>(w + 4); q.da_lambda = ldptr<const float>(w + 6); q.da_norm_g = ldptr<const float>(w + 8);
    q.ml_conv_w = ldptr<const float>(w + 10); q.ml_conv_b = ldptr<const float>(w + 12); q.ml_gate_b = ldptr<const float>(w + 14); q.ml_norm_g = ldptr<const float>(w + 16);
    q.kv_norm_g = ldptr<const float>(w + 18); q.ik_norm_g = ldptr<const float>(w + 20); q.w_uv = ldptr<const float>(w + 22); q.w_branch = ldptr<const float>(w + 24); q.w_out = ldptr<const float>(w + 26);
    q.post_g = ldptr<const float>(w + 28); q.out = ldptr<float>(w + 30); q.ws = ldptr<char>(w + 32); q.ph_lo = 0; q.ph_hi = 0; return q; }
DEV void stptr(LAS unsigned* w, const void* ptr) { const unsigned long long v = (unsigned long long)ptr; w[0] = (unsigned)v; w[1] = (unsigned)(v >> 32); }
__global__ void __launch_bounds__(NTHREADS, 2) fwd(Params p0) {
    extern __shared__ __attribute__((aligned(16))) char lds_raw[];
    LAS char* lds = (LAS char*)lds_raw; LAS char* lds0 = lds + LDS_HDR_OFF;
    const int wv = __builtin_amdgcn_readfirstlane((int)threadIdx.x >> 6);
    LAS unsigned* pw = (LAS unsigned*)(lds0 + 64);
    if (threadIdx.x == 0) { LAS unsigned* z = (LAS unsigned*)lds0; z[0] = 0u; z[1] = 0u; z[2] = 0u; z[3] = 0u;
        stptr(pw + 0, p0.x); stptr(pw + 2, p0.pre_g); stptr(pw + 4, p0.w_in); stptr(pw + 6, p0.da_lambda); stptr(pw + 8, p0.da_norm_g); stptr(pw + 10, p0.ml_conv_w); stptr(pw + 12, p0.ml_conv_b);
        stptr(pw + 14, p0.ml_gate_b); stptr(pw + 16, p0.ml_norm_g); stptr(pw + 18, p0.kv_norm_g); stptr(pw + 20, p0.ik_norm_g); stptr(pw + 22, p0.w_uv); stptr(pw + 24, p0.w_branch); stptr(pw + 26, p0.w_out);
        stptr(pw + 28, p0.post_g); stptr(pw + 30, p0.out); stptr(pw + 32, p0.ws); }
    __syncthreads();
    { XcdBarrier bar0 = xcd_barrier_post((unsigned*)(p0.ws + OFF_CTRL), (volatile LAS unsigned*)lds0, threadIdx.x == 0); (void)bar0; }
#define SEAM(id) if ((id) + 1 < PH_TOTAL) { XcdBarrier bar; bar.bar = (unsigned*)(ldptr<char>((const LAS unsigned*)(size_t)(unsigned)ls((int)(unsigned)(size_t)(pw + 32))) + OFF_CTRL); bar.x = xb_xcc_id(); bar.st = (volatile LAS unsigned*)lds0; \
        xcd_barrier(bar, ls(wv) == 0 && lane_id_v() == 0); }
#define RUN(id) true
    for (int l_ = 0; l_ < DEPTH; ++l_) {
        const int b_ = 0;
        { const int id = l_ * PH_PER_L; if (RUN(id)) { const Params p = ldp(pw); const int l = ls(l_), b = ls(b_); (void)l; (void)b; ph_weights(p, l, lds, wv); } SEAM(id); }
        for (int b_ = 0; b_ < NB; ++b_) {
            const int id0 = l_ * PH_PER_L + 1 + b_ * PH_PER_B;
            if (RUN(id0 + 0)) { const Params p = ldp(pw); const int l = ls(l_), b = ls(b_); (void)l; (void)b; ph_h(p, l, b, wv); }
            SEAM(id0 + 0);
            if (RUN(id0 + 1)) { const Params p = ldp(pw); const int l = ls(l_), b = ls(b_); (void)l; (void)b; char* ws = p.ws; { EpiIn E{ws, 0}; gemm8((const half_t*)(ws + OFF_H), (const half_t*)(ws + OFF_WT), TB, N16, 2048, E, lds, wv); }
                { EpiIn8 E8{ws, 0}; gemm8<EpiIn8, true>((const half_t*)(ws + OFF_H8), (const half_t*)(ws + OFF_WT8), TB, N8 - 512, 1024, E8, lds, wv); } }
            SEAM(id0 + 1);
            if (RUN(id0 + 2)) { const Params p = ldp(pw); const int l = ls(l_), b = ls(b_); (void)l; (void)b; ph_post(p, l, wv); }
            SEAM(id0 + 2);
            if (RUN(id0 + 3)) { const Params p = ldp(pw); const int l = ls(l_), b = ls(b_); (void)l; (void)b; { char* ws = p.ws; EpiIn8 E8{ws, (N8 - 512) / 256}; gemm8<EpiIn8, true>((const half_t*)(ws + OFF_H8), (const half_t*)(ws + OFF_WT8) + (size_t)(N8 - 512) * 1024, TB, 512, 1024, E8, lds, wv); }
                ph_attn(p, lds, wv); ph_ml_state(p, lds, wv); ph_index(p, lds, wv, 2 * l + b); }
            SEAM(id0 + 3);
            if (RUN(id0 + 4)) { const Params p = ldp(pw); const int l = ls(l_), b = ls(b_); (void)l; (void)b; ph_attn_comb(p, l, wv); ph_ml_scan(p, wv); ph_sparse(p, lds, wv, 2 * l + b); }
            SEAM(id0 + 4);
            if (RUN(id0 + 5)) { const Params p = ldp(pw); const int l = ls(l_), b = ls(b_); (void)l; (void)b; ph_ml_out(p, l, lds, wv);
                char* ws = p.ws; EpiMulH E{(half_t*)(ws + OFF_IQ), (const half_t*)(ws + OFF_DZ), 1024}; gemm8((const half_t*)(ws + OFF_DQ), (const half_t*)(ws + OFF_WUVT), TB, 1024, 512, E, lds, wv, 2048, 512); }
            SEAM(id0 + 5);
            if (RUN(id0 + 6)) { const Params p = ldp(pw); const int l = ls(l_), b = ls(b_); (void)l; (void)b; char* ws = p.ws;
                const half_t* Y[3] = {(const half_t*)(ws + OFF_QA), (const half_t*)(ws + OFF_YB), (const half_t*)(ws + OFF_IQ)};
#pragma unroll
                for (int i = 0; i < 3; ++i) { EpiGate E{(half_t*)(ws + OFF_MIX), (const unsigned char*)(ws + OFF_G), i * 2048, i == 0};
                    gemm8(Y[i], (const half_t*)(ws + OFF_WBT) + (size_t)i * 2048 * 1024, TB, 2048, 1024, E, lds, wv); } }
            SEAM(id0 + 6);
            if (RUN(id0 + 7)) { const Params p = ldp(pw); const int l = ls(l_), b = ls(b_); (void)l; (void)b; char* ws = p.ws; EpiOut E{(half_t*)(ws + OFF_OUTP)}; gemm8((const half_t*)(ws + OFF_MIX), (const half_t*)(ws + OFF_WOT), TB, 2048, 2048, E, lds, wv); }
            SEAM(id0 + 7);
            if (RUN(id0 + 8)) { const Params p = ldp(pw); const int l = ls(l_), b = ls(b_); (void)l; (void)b; ph_final(p, l, b, wv); }
            SEAM(id0 + 8);
        }
    }
#undef RUN
#undef SEAM
}

extern "C" void kernel_launch(void* const* d_in, const int* in_sizes, int n_in, void* d_out, int out_size, void* d_ws, size_t ws_size, hipStream_t stream) {
    (void)in_sizes; (void)n_in; (void)out_size;
    if (ws_size < WS_NEED) { fprintf(stderr, "workspace too small: %zu < %zu\n", ws_size, (size_t)WS_NEED); return; }
    static int grid = 0;
    if (!grid) {
        (void)hipFuncSetAttribute((const void*)fwd, hipFuncAttributeMaxDynamicSharedMemorySize, LDS_BYTES);
        int dev = 0, cus = 0, per_cu = 0; (void)hipGetDevice(&dev); (void)hipDeviceGetAttribute(&cus, hipDeviceAttributeMultiprocessorCount, dev);
        (void)hipOccupancyMaxActiveBlocksPerMultiprocessor(&per_cu, fwd, NTHREADS, LDS_BYTES);
        grid = (per_cu >= 1 && cus >= 256) ? 256 : 0;
        if (!grid) { fprintf(stderr, "kernel does not fit a CU\n"); return; }
    }
    Params p{};
    p.x = (const float*)d_in[0]; p.pre_g = (const float*)d_in[1]; p.w_in = (const float*)d_in[2]; p.da_lambda = (const float*)d_in[3]; p.da_norm_g = (const float*)d_in[4];
    p.ml_conv_w = (const float*)d_in[5]; p.ml_conv_b = (const float*)d_in[6]; p.ml_gate_b = (const float*)d_in[7]; p.ml_norm_g = (const float*)d_in[8];
    p.kv_norm_g = (const float*)d_in[9]; p.ik_norm_g = (const float*)d_in[10]; p.w_uv = (const float*)d_in[11]; p.w_branch = (const float*)d_in[12]; p.w_out = (const float*)d_in[13]; p.post_g = (const float*)d_in[14];
    p.out = (float*)d_out; p.ws = (char*)d_ws; p.ph_lo = 0; p.ph_hi = PH_TOTAL;
    (void)hipMemsetAsync((char*)d_ws + OFF_CTRL, 0, 65536, stream);
    hipLaunchKernelGGL(fwd, dim3(grid), dim3(NTHREADS), LDS_BYTES, stream, p);
}
```
